# Optimizing an MI355X kernel written in HIP

```python
import math
import jax
import jax.numpy as jnp
from jax import lax
import numpy as np

D_MODEL = 1024
BATCH = 4
SEQ = 4096
DEPTH = 1
DEC_BATCH = 2
DEC_SEQ = 16384
PAST_LEN = 128

HEAD_DIM = 64
A_HEADS = D_MODEL // 128
A_KV_HEADS = 2
A_GROUP = A_HEADS // A_KV_HEADS
A_WIDTH = A_HEADS * HEAD_DIM
A_KV_WIDTH = A_KV_HEADS * HEAD_DIM
WINDOW = 128
BLOCK = 128
B_HEADS = D_MODEL // 128
Q_LORA = 3 * D_MODEL // 8
KV_LORA = D_MODEL // 4
NOPE_DIM = 64
ROPE_DIM = 32
V_DIM = 64
B_WIDTH = B_HEADS * V_DIM
ROPE_THETA = 10000.0
EPS = 1e-6

IN_WIDTHS = (A_WIDTH, A_KV_WIDTH, A_KV_WIDTH, A_WIDTH, Q_LORA, KV_LORA, ROPE_DIM, B_WIDTH, 2 * D_MODEL)
IN_SPLITS = tuple(sum(IN_WIDTHS[: i + 1]) for i in range(len(IN_WIDTHS) - 1))
D_IN = sum(IN_WIDTHS)

kernel_name = "hybrid_swa_mla_gated_encoder"


def rms_norm(x, gain):
    x32 = x.astype(jnp.float32)
    y = x32 * lax.rsqrt(jnp.mean(x32 * x32, axis=-1, keepdims=True) + EPS)
    return (y * gain.astype(jnp.float32)).astype(x.dtype)


def alibi_slopes(n):
    start = 2.0 ** (-8.0 / n)
    return start ** jnp.arange(1, n + 1, dtype=jnp.float32)


def rope_tables(S, dtype):
    inv = 1.0 / (ROPE_THETA ** (jnp.arange(0, ROPE_DIM, 2, dtype=jnp.float32) / ROPE_DIM))
    ang = jnp.arange(S, dtype=jnp.float32)[:, None] * inv[None, :]
    return jnp.cos(ang).astype(dtype), jnp.sin(ang).astype(dtype)


def apply_rope(x, cos, sin):
    x1, x2 = jnp.split(x, 2, axis=-1)
    return jnp.concatenate([x1 * cos - x2 * sin, x1 * sin + x2 * cos], axis=-1)


def windowed_gqa(q, k, v, sink):
    B, S, _ = q.shape
    nb = S // BLOCK
    q = q.reshape(B, nb, BLOCK, A_KV_HEADS, A_GROUP, HEAD_DIM) * (HEAD_DIM ** -0.5)
    pad = ((0, 0), (BLOCK, BLOCK), (0, 0), (0, 0))
    kp = jnp.pad(k.reshape(B, S, A_KV_HEADS, HEAD_DIM), pad).reshape(B, nb + 2, BLOCK, A_KV_HEADS, HEAD_DIM)
    vp = jnp.pad(v.reshape(B, S, A_KV_HEADS, HEAD_DIM), pad).reshape(B, nb + 2, BLOCK, A_KV_HEADS, HEAD_DIM)
    kb = jnp.concatenate([kp[:, :-2], kp[:, 1:-1], kp[:, 2:]], axis=2)
    vb = jnp.concatenate([vp[:, :-2], vp[:, 1:-1], vp[:, 2:]], axis=2)
    s = jnp.einsum("bnqhgd,bnkhd->bnhgqk", q, kb).astype(jnp.float32)
    qi = jnp.arange(BLOCK)
    kj = jnp.arange(3 * BLOCK)
    rel = kj[None, :] - BLOCK - qi[:, None]
    kpos = jnp.arange(nb)[:, None] * BLOCK - BLOCK + kj[None, :]
    valid = (jnp.abs(rel) <= WINDOW)[None] & ((kpos >= 0) & (kpos < S))[:, None, :]
    dist = jnp.abs(rel).astype(jnp.float32)
    bias = (-alibi_slopes(A_HEADS)[:, None, None] * dist[None]).reshape(A_KV_HEADS, A_GROUP, BLOCK, 3 * BLOCK)
    s = jnp.where(valid[None, :, None, None], s + bias[None, None], -1e30)
    sink_l = sink.astype(jnp.float32).reshape(A_KV_HEADS, A_GROUP)[None, None, :, :, None, None]
    m = jnp.maximum(jnp.max(s, axis=-1, keepdims=True), sink_l)
    p = jnp.exp(s - m)
    denom = jnp.sum(p, axis=-1, keepdims=True) + jnp.exp(sink_l - m)
    p = (p / denom).astype(vb.dtype)
    o = jnp.einsum("bnhgqk,bnkhd->bnqhgd", p, vb)
    return o.reshape(B, S, A_WIDTH)


def mla(cq, ckv, kr, g_q, w_uq, g_kv, w_ukv):
    B, S, _ = cq.shape
    nb = S // BLOCK
    q = (rms_norm(cq, g_q) @ w_uq).reshape(B, S, B_HEADS, NOPE_DIM + ROPE_DIM)
    q_nope, q_rope = q[..., :NOPE_DIM], q[..., NOPE_DIM:]
    kv = (rms_norm(ckv, g_kv) @ w_ukv).reshape(B, S, B_HEADS, NOPE_DIM + V_DIM)
    k_nope, v = kv[..., :NOPE_DIM], kv[..., NOPE_DIM:]
    cos, sin = rope_tables(S, cq.dtype)
    q_rope = apply_rope(q_rope, cos[:, None, :], sin[:, None, :])
    k_rope = apply_rope(kr, cos, sin)
    scale = (NOPE_DIM + ROPE_DIM) ** -0.5
    q = jnp.concatenate([q_nope, q_rope], axis=-1) * scale
    k = jnp.concatenate([k_nope, jnp.broadcast_to(k_rope[:, :, None, :], (B, S, B_HEADS, ROPE_DIM))], axis=-1)
    qb = q.reshape(B, nb, BLOCK, B_HEADS, NOPE_DIM + ROPE_DIM).transpose(1, 0, 2, 3, 4)

    def attend(q_blk):
        s = jnp.einsum("bqhd,bkhd->bhqk", q_blk, k).astype(jnp.float32)
        p = jax.nn.softmax(s, axis=-1).astype(v.dtype)
        return jnp.einsum("bhqk,bkhd->bqhd", p, v)

    o = lax.map(attend, qb)
    return o.transpose(1, 0, 2, 3, 4).reshape(B, S, B_WIDTH)


def encoder_layer(x, c, w_ada, b_ada, g_norm, w_in, g_q, w_uq, g_kv, w_ukv, sink, w_oa, w_ob, w_out):
    mod = jax.nn.silu(c) @ w_ada + b_ada
    shift, scale, gate_res = jnp.split(mod, 3, axis=-1)
    h = rms_norm(x, g_norm) * (1.0 + scale[:, None, :]) + shift[:, None, :]
    proj = h @ w_in
    qa, ka, va, za, cq, ckv, kr, zb, gm = jnp.split(proj, IN_SPLITS, axis=-1)
    ya = windowed_gqa(qa, ka, va, sink) * jax.nn.silu(za)
    yb = mla(cq, ckv, kr, g_q, w_uq, g_kv, w_ukv) * jax.nn.silu(zb)
    ga, gb = jnp.split(jax.nn.sigmoid(gm), 2, axis=-1)
    merged = ga * (ya @ w_oa) + gb * (yb @ w_ob)
    return x + gate_res[:, None, :] * (merged @ w_out)


def setup_inputs(seed: int = 0) -> dict:
    key = jax.random.key(seed)
    ks = jax.random.split(key, 20)
    f32 = jnp.float32
    nrm = lambda k, shape, s: jax.random.normal(k, shape, f32) * s
    return {
        "x_prompt": nrm(ks[0], (BATCH, SEQ, D_MODEL), 1.0),
        "x_sample": nrm(ks[1], (DEC_BATCH, DEC_SEQ, D_MODEL), 1.0),
        "c_prompt": nrm(ks[2], (BATCH, D_MODEL), 1.0),
        "c_sample": nrm(ks[3], (DEC_BATCH, D_MODEL), 1.0),
        "w_ada": nrm(ks[4], (DEPTH, D_MODEL, 3 * D_MODEL), 0.5 * D_MODEL ** -0.5),
        "b_ada": nrm(ks[5], (DEPTH, 3 * D_MODEL), 0.01),
        "g_norm": 1.0 + nrm(ks[6], (DEPTH, D_MODEL), 0.01),
        "w_in": nrm(ks[7], (DEPTH, D_MODEL, D_IN), D_MODEL ** -0.5),
        "g_q": 1.0 + nrm(ks[8], (DEPTH, Q_LORA), 0.01),
        "w_uq": nrm(ks[9], (DEPTH, Q_LORA, B_HEADS * (NOPE_DIM + ROPE_DIM)), Q_LORA ** -0.5),
        "g_kv": 1.0 + nrm(ks[10], (DEPTH, KV_LORA), 0.01),
        "w_ukv": nrm(ks[11], (DEPTH, KV_LORA, B_HEADS * (NOPE_DIM + V_DIM)), KV_LORA ** -0.5),
        "sink": nrm(ks[12], (DEPTH, A_HEADS), 0.5),
        "w_oa": nrm(ks[13], (DEPTH, A_WIDTH, D_MODEL), A_WIDTH ** -0.5),
        "w_ob": nrm(ks[14], (DEPTH, B_WIDTH, D_MODEL), B_WIDTH ** -0.5),
        "w_out": nrm(ks[15], (DEPTH, D_MODEL, D_MODEL), D_MODEL ** -0.5),
        "g_final": 1.0 + nrm(ks[16], (D_MODEL,), 0.01),
    }


def reference(x_prompt, x_sample, c_prompt, c_sample, w_ada, b_ada, g_norm, w_in, g_q, w_uq, g_kv, w_ukv,
              sink, w_oa, w_ob, w_out, g_final):
    def trunk(x, c):
        for l in range(DEPTH):
            x = encoder_layer(x, c, w_ada[l], b_ada[l], g_norm[l], w_in[l], g_q[l], w_uq[l], g_kv[l], w_ukv[l],
                              sink[l], w_oa[l], w_ob[l], w_out[l])
        return rms_norm(x, g_final)

    y_prompt = trunk(x_prompt, c_prompt)
    y_sample = trunk(x_sample, c_sample)
    return (y_prompt, y_sample)
```

```cpp
#include <hip/hip_runtime.h>
#include <hip/hip_cooperative_groups.h>
#include <cstdio>
#include <cstdint>
namespace cg = cooperative_groups;

#ifndef MK_N_LAUNCHES
#define MK_N_LAUNCHES 10
#endif

constexpr int DM = 1024;
constexpr int NB_P = 4, S_P = 4096, NB_S = 2, S_S = 16384;
constexpr int M_P = NB_P * S_P, M_S = NB_S * S_S, M = M_P + M_S;
constexpr int D_IN = 4512, N_IN = 4608;
constexpr int NBATCH = NB_P + NB_S;
constexpr float EPS = 1e-6f;
constexpr float LOG2E = 1.4426950408889634f;
constexpr float QA_SCALE = 0.125f * LOG2E;
constexpr float QB_SCALE = 0.10206207261596575f * LOG2E;

constexpr size_t MiB = 1u << 20;
constexpr size_t WS_MOD = 0;
constexpr size_t MOD_BYTES = (size_t)NBATCH * 3 * DM * 4;
constexpr size_t WS_ROPE = 128 * 1024;
constexpr size_t WS_WIN = WS_ROPE + 2 * MiB;
constexpr size_t WS_WUQ = WS_WIN + (size_t)N_IN * DM * 2;
constexpr size_t WS_WUKV = WS_WUQ + (size_t)768 * 384 * 2;
constexpr size_t WS_WOA = WS_WUKV + (size_t)1024 * 256 * 2;
constexpr size_t WS_WOB = WS_WOA + (size_t)1024 * 512 * 2;
constexpr size_t WS_WOUT = WS_WOB + (size_t)1024 * 512 * 2;
constexpr size_t WS_RSQ = WS_WOUT + (size_t)1024 * 1024 * 2;
constexpr size_t WS_RSKV = WS_RSQ + (size_t)M * 4;
static_assert(WS_RSKV + (size_t)M * 4 <= 20 * MiB, "small region");
constexpr size_t WS_R1 = 20 * MiB;
constexpr size_t WS_R2 = WS_R1 + 96 * MiB;
constexpr size_t WS_R3 = WS_R2 + 72 * MiB;
constexpr size_t WS_R4 = WS_R3 + 96 * MiB;
constexpr size_t WS_KN = WS_R4 + 72 * MiB;
constexpr size_t WS_VB = WS_KN + 48 * MiB;
constexpr size_t WS_KR = WS_VB + 48 * MiB;
constexpr size_t WS_END = WS_KR + 3 * MiB;

typedef unsigned short bf16_t;
typedef short bf16x8 __attribute__((ext_vector_type(8)));
typedef short s16x4 __attribute__((ext_vector_type(4)));
typedef float f32x4 __attribute__((ext_vector_type(4)));
typedef float f32x2 __attribute__((ext_vector_type(2)));
typedef float f32x16 __attribute__((ext_vector_type(16)));
typedef unsigned u32x4 __attribute__((ext_vector_type(4)));
typedef unsigned u32x2 __attribute__((ext_vector_type(2)));
#define LAS __attribute__((address_space(3)))

__device__ __forceinline__ unsigned cvt_pk_bf16(float lo, float hi) { unsigned r; asm volatile("v_cvt_pk_bf16_f32 %0, %1, %2" : "=v"(r) : "v"(lo), "v"(hi)); return r; }
__device__ __forceinline__ float bf_lo(unsigned w) { return __uint_as_float(w << 16); }
__device__ __forceinline__ float bf_hi(unsigned w) { return __uint_as_float(w & 0xffff0000u); }
__device__ __forceinline__ float sigmoidf_fast(float v) { return __builtin_amdgcn_rcpf(1.0f + __builtin_amdgcn_exp2f(-v * LOG2E)); }
__device__ __forceinline__ float wave_sum(float v) {
#pragma unroll
    for (int o = 1; o < 64; o <<= 1) v += __shfl_xor(v, o);
    return v;
}
__device__ __forceinline__ int batch_of_row(int row) { return row < M_P ? (row >> 12) : NB_P + ((row - M_P) >> 14); }
__device__ __forceinline__ int pos_of_row(int row) { return row < M_P ? (row & (S_P - 1)) : ((row - M_P) & (S_S - 1)); }

namespace pg8 {
constexpr int BM = 256, BK = 64, HALF = 128, HTB = HALF * BK * 2, STAGE_BYTES = 8 * HTB, NXCD = 8, WGM = 8;
__host__ __device__ __forceinline__ int lds_byte(int r, int c) { const int st = (r >> 4) * 2 + (c >> 5), rr = r & 15, cc = c & 31, ob = rr * 64 + cc * 2; return st * 1024 + (ob ^ (((ob >> 9) & 1) << 5)); }
__host__ __device__ __forceinline__ void stage_rc(int b, int& R, int& C) { const int st = b / 1024, sb = b % 1024, swz = sb ^ (((sb >> 9) & 1) << 5); R = (st >> 1) * 16 + swz / 64; C = (st & 1) * 32 + (swz % 64) / 2; }
__host__ __device__ __forceinline__ int perm32(int rho) { const int n = rho >> 4, i = rho & 15; return 8 * (i >> 2) + 4 * n + (i & 3); }

struct Unit { int pm, pn; };
struct Gemm { const bf16_t* A; const bf16_t* Bt; int M, N, K, lda; };

struct StaticOrder {
    int nM, nN, nwg, G, c;
    __device__ void init(int M_, int N_, int G_, int c_) { nM = M_ / BM; nN = N_ / BM; nwg = nM * nN; G = G_; c = c_; }
    __device__ bool next(int i, Unit& u) const {
        const long L = (long)i * G + c; if (L >= nwg) return false;
        int wgid = (int)L; { const int q = nwg / NXCD, r = nwg % NXCD, xcd = wgid % NXCD, off = wgid / NXCD; wgid = (xcd < r ? xcd * (q + 1) : r * (q + 1) + (xcd - r) * q) + off; }
        const int nig = WGM * nN, gid = wgid / nig, fm = gid * WGM, gsz = (nM - fm) < WGM ? (nM - fm) : WGM;
        u.pm = fm + ((wgid % nig) % gsz); u.pn = (wgid % nig) / gsz; return true;
    }
};

template <class Epi, int K, int LDA, bool ALIGN_EPI = true>
__device__ __forceinline__ void gemm_phase(LAS unsigned char* lds, const Gemm g, const StaticOrder& S, const Epi& E) {
    const int tid = threadIdx.x, wid = __builtin_amdgcn_readfirstlane(tid >> 6), lane = tid & 63, wr = wid >> 2, wc = wid & 3, fr = lane & 15, fq = lane >> 4;
    constexpr int nt = K / BK, lda = LDA;
    unsigned voffA[2], voffB[2];
#pragma unroll
    for (int i = 0; i < 2; ++i) { int R, C; stage_rc(tid * 16 + i * 8192, R, C); const int Rb = (R & ~31) + perm32(R & 31);
        voffA[i] = (unsigned)(R * lda + C) * 2u; voffB[i] = (unsigned)(Rb * K + C) * 2u; }
    const size_t kstep = (size_t)(BK * 2);
    const size_t hstepA = (size_t)HALF * lda * 2, tstepA = 2 * hstepA;
    const size_t hstepB = (size_t)HALF * K * 2, tstepB = 2 * hstepB;
    const unsigned ldsw = (unsigned)wid * 1024u;
    const int aoff = lds_byte(wr * 64 + fr, fq * 8), boff = lds_byte(wc * 32 + fr, fq * 8);
#define PG8_SA(b, h) (((b) * 2 + (h)) * HTB)
#define PG8_SB(b, h) ((4 + (b) * 2 + (h)) * HTB)
#define PG8_STAGE(bufoff, gbase, voff) do { _Pragma("unroll") for (int _i = 0; _i < 2; ++_i) \
        __builtin_amdgcn_global_load_lds((const unsigned*)((const char*)(gbase) + (voff)[_i]), (LAS unsigned*)(lds + (bufoff) + ldsw + _i * 8192), 16, 0, 0); } while (0)
#define PG8_LDA(dst, b, h) do { _Pragma("unroll") for (int m = 0; m < 4; ++m) _Pragma("unroll") for (int k = 0; k < 2; ++k) dst[m][k] = *(const LAS bf16x8*)(lds + PG8_SA(b, h) + aoff + m * 2048 + k * 1024); } while (0)
#define PG8_LDB(dst, b, h) do { _Pragma("unroll") for (int n = 0; n < 2; ++n) _Pragma("unroll") for (int k = 0; k < 2; ++k) dst[n][k] = *(const LAS bf16x8*)(lds + PG8_SB(b, h) + boff + n * 2048 + k * 1024); } while (0)
#define PG8_MMA(ai, bj, At, Bt) do { __builtin_amdgcn_s_setprio(1); _Pragma("unroll") for (int m = 0; m < 4; ++m) _Pragma("unroll") for (int n = 0; n < 2; ++n) _Pragma("unroll") for (int k = 0; k < 2; ++k) \
        acc[ai][bj][m][n] = __builtin_amdgcn_mfma_f32_16x16x32_bf16(Bt[n][k], At[m][k], acc[ai][bj][m][n], 0, 0, 0); __builtin_amdgcn_s_setprio(0); } while (0)
#define PG8_WAIT_V(n) asm volatile("s_waitcnt vmcnt(" #n ")" ::: "memory")
#define PG8_WAIT_L(n) asm volatile("s_waitcnt lgkmcnt(" #n ")" ::: "memory")
#define PG8_BAR __builtin_amdgcn_s_barrier()
#define PG8_SCHED __builtin_amdgcn_sched_barrier(0)
    Unit cur, nxt; int ui = 0;
    if (!S.next(0, cur)) return;
    f32x4 acc[2][2][4][2];
#pragma unroll
    for (int a = 0; a < 2; ++a)
#pragma unroll
        for (int b = 0; b < 2; ++b)
#pragma unroll
            for (int m = 0; m < 4; ++m)
#pragma unroll
                for (int n = 0; n < 2; ++n) acc[a][b][m][n] = (f32x4){0.f, 0.f, 0.f, 0.f};
    bf16x8 At[4][2], B0[2][2], B1[2][2];
    const char* cA = (const char*)g.A + (size_t)cur.pm * tstepA; const char* cB = (const char*)g.Bt + (size_t)cur.pn * tstepB;
    PG8_STAGE(PG8_SB(0, 0), cB, voffB); PG8_STAGE(PG8_SB(0, 1), cB + hstepB, voffB); PG8_STAGE(PG8_SA(0, 0), cA, voffA); PG8_STAGE(PG8_SA(0, 1), cA + hstepA, voffA);
    if (wr == 1) PG8_BAR;
    PG8_WAIT_V(2); PG8_BAR;
    PG8_STAGE(PG8_SB(1, 0), cB + kstep, voffB); PG8_STAGE(PG8_SA(1, 0), cA + kstep, voffA); PG8_STAGE(PG8_SB(1, 1), cB + hstepB + kstep, voffB);
    PG8_WAIT_V(6); PG8_BAR;
    for (;;) {
        const bool has_next = S.next(ui + 1, nxt);
        const char* nA = has_next ? (const char*)g.A + (size_t)nxt.pm * tstepA : cA; const char* nB = has_next ? (const char*)g.Bt + (size_t)nxt.pn * tstepB : cB;
#pragma unroll 1
        for (int t = 0; t < nt; t += 2) {
            const bool last = (t == nt - 2);
            const char* a1 = cA + (size_t)(t + 1) * kstep;
            const char* a2 = last ? nA : cA + (size_t)(t + 2) * kstep; const char* b2 = last ? nB : cB + (size_t)(t + 2) * kstep;
            const char* a3 = a2 + kstep; const char* b3 = b2 + kstep;
            PG8_LDB(B0, 0, 0); PG8_LDB(B1, 0, 1); PG8_SCHED; PG8_LDA(At, 0, 0); PG8_STAGE(PG8_SA(1, 1), a1 + hstepA, voffA);
            PG8_WAIT_V(8); PG8_WAIT_L(0); PG8_BAR; PG8_MMA(0, 0, At, B0); PG8_MMA(0, 1, At, B1); PG8_BAR; PG8_SCHED;
            PG8_LDA(At, 0, 1); PG8_STAGE(PG8_SB(0, 0), b2, voffB); PG8_STAGE(PG8_SB(0, 1), b2 + hstepB, voffB); PG8_STAGE(PG8_SA(0, 0), a2, voffA);
            PG8_WAIT_V(8); PG8_WAIT_L(0); PG8_BAR; PG8_MMA(1, 0, At, B0); PG8_MMA(1, 1, At, B1); PG8_BAR; PG8_SCHED;
            PG8_LDB(B0, 1, 0); PG8_LDB(B1, 1, 1); PG8_SCHED; PG8_LDA(At, 1, 0); PG8_STAGE(PG8_SA(0, 1), a2 + hstepA, voffA);
            PG8_WAIT_V(8); PG8_WAIT_L(0); PG8_BAR; PG8_MMA(0, 0, At, B0); PG8_MMA(0, 1, At, B1); PG8_BAR; PG8_SCHED;
            PG8_LDA(At, 1, 1); PG8_STAGE(PG8_SB(1, 0), b3, voffB); PG8_STAGE(PG8_SB(1, 1), b3 + hstepB, voffB); PG8_STAGE(PG8_SA(1, 0), a3, voffA);
            PG8_WAIT_V(8); PG8_WAIT_L(0); PG8_BAR; PG8_MMA(1, 0, At, B0); PG8_MMA(1, 1, At, B1); PG8_BAR; PG8_SCHED;
        }
        if constexpr (ALIGN_EPI) { if (wr == 0) PG8_BAR; }
        E(acc, cur, wr, wc, fr, fq);
        if (!has_next) break;
#pragma unroll
        for (int a = 0; a < 2; ++a)
#pragma unroll
            for (int b = 0; b < 2; ++b)
#pragma unroll
                for (int m = 0; m < 4; ++m)
#pragma unroll
                    for (int n = 0; n < 2; ++n) acc[a][b][m][n] = (f32x4){0.f, 0.f, 0.f, 0.f};
        cur = nxt; cA = nA; cB = nB; ++ui;
        if constexpr (ALIGN_EPI) { if (wr == 1) PG8_BAR; }
    }
    PG8_WAIT_V(0);
    if constexpr (!ALIGN_EPI) { if (wr == 0) PG8_BAR; }
    PG8_BAR;
#undef PG8_SA
#undef PG8_SB
#undef PG8_STAGE
#undef PG8_LDA
#undef PG8_LDB
#undef PG8_MMA
#undef PG8_WAIT_V
#undef PG8_WAIT_L
#undef PG8_BAR
#undef PG8_SCHED
}

typedef const f32x4 (&AccRef)[2][2][4][2];
__device__ __forceinline__ u32x4 pack8(f32x4 v0, f32x4 v1) { u32x4 w; w.x = cvt_pk_bf16(v0[0], v0[1]); w.y = cvt_pk_bf16(v0[2], v0[3]); w.z = cvt_pk_bf16(v1[0], v1[1]); w.w = cvt_pk_bf16(v1[2], v1[3]); return w; }

struct EpiProj {
    bf16_t *PA, *PZ, *PC, *PG;
    __device__ __forceinline__ void operator()(AccRef acc, const Unit& u, int wr, int wc, int fr, int fq) const {
        bf16_t* base; int ldc, colt, act;
        if (u.pn < 3) { base = PA; ldc = 768; colt = u.pn * 256; act = 0; }
        else if (u.pn < 7) { base = PZ; ldc = 1024; colt = (u.pn - 3) * 256; act = 1; }
        else if (u.pn < 10) { base = PC; ldc = 768; colt = (u.pn - 7) * 256; act = 0; }
        else { base = PG; ldc = 2048; colt = (u.pn - 10) * 256; act = 2; }
        const int row0 = u.pm * BM + wr * 64 + fr, col0 = colt + wc * 32 + 8 * fq;
#pragma unroll
        for (int ai = 0; ai < 2; ++ai)
#pragma unroll
            for (int m = 0; m < 4; ++m) { bf16_t* rowp = base + (size_t)(row0 + ai * HALF + m * 16) * ldc + col0;
#pragma unroll
                for (int bj = 0; bj < 2; ++bj) { f32x4 v0 = acc[ai][bj][m][0], v1 = acc[ai][bj][m][1];
                    if (act != 0) {
#pragma unroll
                        for (int e = 0; e < 4; ++e) { const float s0 = sigmoidf_fast(v0[e]), s1 = sigmoidf_fast(v1[e]); v0[e] = (act == 1) ? v0[e] * s0 : s0; v1[e] = (act == 1) ? v1[e] * s1 : s1; }
                    }
                    *(u32x4*)(rowp + bj * HALF) = pack8(v0, v1); } }
    }
};
struct EpiQ {
    bf16_t* QB; const float* rs; const f32x2* rope;
    __device__ __forceinline__ void operator()(AccRef acc, const Unit& u, int wr, int wc, int fr, int fq) const {
        const int row0 = u.pm * BM + wr * 64 + fr; const int colb = u.pn * BM + wc * 32 + 8 * fq;
        const int dp0 = colb % 96, dp1 = (colb + HALF) % 96;
#pragma unroll
        for (int ai = 0; ai < 2; ++ai)
#pragma unroll
            for (int m = 0; m < 4; ++m) { const int row = row0 + ai * HALF + m * 16; const float r = rs[row]; const f32x2* tr = rope + (size_t)pos_of_row(row) * 16;
#pragma unroll
                for (int bj = 0; bj < 2; ++bj) { const int dp = bj ? dp1 : dp0;
                    f32x4 v0 = acc[ai][bj][m][0] * r, v1 = acc[ai][bj][m][1] * r;
                    if (dp >= 64) { const f32x4* tp = (const f32x4*)(tr + ((dp - 64) >> 1)); const f32x4 c0 = tp[0], c1 = tp[1];
                        f32x4 w0, w1;
                        w0[0] = v0[0] * c0[0] - v0[1] * c0[1]; w0[1] = v0[0] * c0[1] + v0[1] * c0[0];
                        w0[2] = v0[2] * c0[2] - v0[3] * c0[3]; w0[3] = v0[2] * c0[3] + v0[3] * c0[2];
                        w1[0] = v1[0] * c1[0] - v1[1] * c1[1]; w1[1] = v1[0] * c1[1] + v1[1] * c1[0];
                        w1[2] = v1[2] * c1[2] - v1[3] * c1[3]; w1[3] = v1[2] * c1[3] + v1[3] * c1[2];
                        v0 = w0; v1 = w1; }
                    *(u32x4*)(QB + (size_t)row * 768 + colb + bj * HALF) = pack8(v0, v1); }
                asm volatile("" ::: "memory"); }
    }
};
struct EpiKV {
    bf16_t *KN, *VB; const float* rs;
    __device__ __forceinline__ void operator()(AccRef acc, const Unit& u, int wr, int wc, int fr, int fq) const {
        bf16_t* base = (u.pn < 2) ? KN : VB; const int colt = (u.pn & 1) * 256;
        const int row0 = u.pm * BM + wr * 64 + fr, col0 = colt + wc * 32 + 8 * fq;
#pragma unroll
        for (int ai = 0; ai < 2; ++ai)
#pragma unroll
            for (int m = 0; m < 4; ++m) { const int row = row0 + ai * HALF + m * 16; const float r = rs[row]; bf16_t* rowp = base + (size_t)row * 512 + col0;
#pragma unroll
                for (int bj = 0; bj < 2; ++bj) *(u32x4*)(rowp + bj * HALF) = pack8(acc[ai][bj][m][0] * r, acc[ai][bj][m][1] * r); }
    }
};
template <bool FIRST> struct EpiGate {
    bf16_t* T; const bf16_t* PG; int goff;
    __device__ __forceinline__ void operator()(AccRef acc, const Unit& u, int wr, int wc, int fr, int fq) const {
        const int row0 = u.pm * BM + wr * 64 + fr, col0 = u.pn * BM + wc * 32 + 8 * fq;
#pragma unroll
        for (int ai = 0; ai < 2; ++ai)
#pragma unroll
            for (int m = 0; m < 4; ++m) { const int row = row0 + ai * HALF + m * 16;
#pragma unroll
                for (int bj = 0; bj < 2; ++bj) { const int col = col0 + bj * HALF;
                    const u32x4 gw = *(const u32x4*)(PG + (size_t)row * 2048 + goff + col);
                    f32x4 v0 = acc[ai][bj][m][0], v1 = acc[ai][bj][m][1];
                    v0[0] *= bf_lo(gw.x); v0[1] *= bf_hi(gw.x); v0[2] *= bf_lo(gw.y); v0[3] *= bf_hi(gw.y);
                    v1[0] *= bf_lo(gw.z); v1[1] *= bf_hi(gw.z); v1[2] *= bf_lo(gw.w); v1[3] *= bf_hi(gw.w);
                    bf16_t* tp = T + (size_t)row * 1024 + col;
                    if (!FIRST) { const u32x4 tw = *(const u32x4*)tp;
                        v0[0] += bf_lo(tw.x); v0[1] += bf_hi(tw.x); v0[2] += bf_lo(tw.y); v0[3] += bf_hi(tw.y);
                        v1[0] += bf_lo(tw.z); v1[1] += bf_hi(tw.z); v1[2] += bf_lo(tw.w); v1[3] += bf_hi(tw.w); }
                    *(u32x4*)tp = pack8(v0, v1); } }
    }
};
struct EpiOut {
    const float *xp, *xs; float* out; const float* mod; const float* b_ada;
    __device__ __forceinline__ void operator()(AccRef acc, const Unit& u, int wr, int wc, int fr, int fq) const {
        const int rowt = u.pm * BM; const int b = batch_of_row(rowt);
        const float* xbase = rowt < M_P ? xp + (size_t)rowt * DM : xs + (size_t)(rowt - M_P) * DM;
        float* obase = out + (size_t)rowt * DM;
        const int col0 = u.pn * BM + wc * 32 + 8 * fq;
        f32x4 g[2][2];
#pragma unroll
        for (int bj = 0; bj < 2; ++bj)
#pragma unroll
            for (int n = 0; n < 2; ++n) g[bj][n] = *(const f32x4*)(mod + (size_t)b * 3 * DM + 2 * DM + col0 + bj * HALF + 4 * n) + *(const f32x4*)(b_ada + 2 * DM + col0 + bj * HALF + 4 * n);
#pragma unroll
        for (int ai = 0; ai < 2; ++ai)
#pragma unroll
            for (int m = 0; m < 4; ++m) { const size_t off = (size_t)(wr * 64 + fr + ai * HALF + m * 16) * DM + col0;
#pragma unroll
                for (int bj = 0; bj < 2; ++bj)
#pragma unroll
                    for (int n = 0; n < 2; ++n) { const f32x4 xv = *(const f32x4*)(xbase + off + bj * HALF + 4 * n);
                        *(f32x4*)(obase + off + bj * HALF + 4 * n) = xv + g[bj][n] * acc[ai][bj][m][n]; } }
    }
};
}

namespace att {
constexpr int NW = 8, QBLK = 32, KVBLK = 64;
constexpr int SHM_V = 8192, SHM_KN = 8192, SHM_KR = 4096;
constexpr int OFF_V = 0, OFF_KN = 2 * SHM_V, OFF_KR = OFF_KN + 2 * SHM_KN, OFF_WS = OFF_KR + 2 * SHM_KR, LDS_BYTES = OFF_WS + NW * 64 * 4;
constexpr float THR2 = 8.0f;
#define SBAR() __builtin_amdgcn_sched_barrier(0)
__device__ __forceinline__ int crow(int r, int hi) { return (r & 3) + 8 * (r >> 2) + 4 * hi; }
__device__ __forceinline__ int v_st(int k, int c) { const int kk = (k & ~0xC) | ((k & 4) << 1) | ((k & 8) >> 1); return ((kk >> 3) * 2 + (c >> 5)) * 512 + ((kk & 7) * 32 + (c & 31)) * 2; }
__device__ __forceinline__ int v_rd_base(int lane) { return ((lane & 3) << 3) | (((lane >> 2) & 3) << 6) | (((lane >> 4) & 1) << 5) | (((lane >> 5) & 1) << 8); }
constexpr int v_rd_off(int d0, int ks, int half) { return d0 * 512 + ks * 2048 + half * 1024; }
template <int OFF> __device__ __forceinline__ s16x4 tr_read(int vb) { s16x4 r; asm volatile("ds_read_b64_tr_b16 %0, %1 offset:%2" : "=&v"(r) : "v"(vb), "i"(OFF) : "memory"); return r; }
template <int D0> __device__ __forceinline__ void pv_one(f32x16& od, int vb, bf16x8 pa0, bf16x8 pa1, bf16x8 pa2, bf16x8 pa3) {
    const s16x4 l0 = tr_read<v_rd_off(D0, 0, 0)>(vb), h0 = tr_read<v_rd_off(D0, 0, 1)>(vb), l1 = tr_read<v_rd_off(D0, 1, 0)>(vb), h1 = tr_read<v_rd_off(D0, 1, 1)>(vb);
    const s16x4 l2 = tr_read<v_rd_off(D0, 2, 0)>(vb), h2 = tr_read<v_rd_off(D0, 2, 1)>(vb), l3 = tr_read<v_rd_off(D0, 3, 0)>(vb), h3 = tr_read<v_rd_off(D0, 3, 1)>(vb);
    asm volatile("s_waitcnt lgkmcnt(0)" ::: "memory"); SBAR();
#define PK(L, H) (bf16x8){L[0], L[1], L[2], L[3], H[0], H[1], H[2], H[3]}
    od = __builtin_amdgcn_mfma_f32_32x32x16_bf16(pa0, PK(l0, h0), od, 0, 0, 0);
    od = __builtin_amdgcn_mfma_f32_32x32x16_bf16(pa1, PK(l1, h1), od, 0, 0, 0);
    od = __builtin_amdgcn_mfma_f32_32x32x16_bf16(pa2, PK(l2, h2), od, 0, 0, 0);
    od = __builtin_amdgcn_mfma_f32_32x32x16_bf16(pa3, PK(l3, h3), od, 0, 0, 0);
#undef PK
}
__device__ __forceinline__ void pv_d0(f32x16* o, int vb, bf16x8 pa0, bf16x8 pa1, bf16x8 pa2, bf16x8 pa3) { pv_one<0>(o[0], vb, pa0, pa1, pa2, pa3); pv_one<1>(o[1], vb, pa0, pa1, pa2, pa3); }

template <int DQK> __device__ __forceinline__ void qkt(f32x16& p0, f32x16& p1, const char* Kn_s, const char* Kr_s, const bf16x8* qr, int r32, int hi) {
    p0 = f32x16{}; p1 = f32x16{};
    const int keyn = (r32 >> 1) & 7, keyr = (r32 >> 2) & 3;
#pragma unroll
    for (int d0 = 0; d0 < 4; ++d0) { const int off = r32 * 128 + (((2 * d0 + hi) ^ keyn) << 4);
        const bf16x8 b0 = *reinterpret_cast<const bf16x8*>(Kn_s + off), b1 = *reinterpret_cast<const bf16x8*>(Kn_s + off + 32 * 128);
        p0 = __builtin_amdgcn_mfma_f32_32x32x16_bf16(b0, qr[d0], p0, 0, 0, 0);
        p1 = __builtin_amdgcn_mfma_f32_32x32x16_bf16(b1, qr[d0], p1, 0, 0, 0); }
    if constexpr (DQK == 96) {
#pragma unroll
        for (int d0 = 0; d0 < 2; ++d0) { const int off = r32 * 64 + (((2 * d0 + hi) ^ keyr) << 4);
            const bf16x8 b0 = *reinterpret_cast<const bf16x8*>(Kr_s + off), b1 = *reinterpret_cast<const bf16x8*>(Kr_s + off + 32 * 64);
            p0 = __builtin_amdgcn_mfma_f32_32x32x16_bf16(b0, qr[4 + d0], p0, 0, 0, 0);
            p1 = __builtin_amdgcn_mfma_f32_32x32x16_bf16(b1, qr[4 + d0], p1, 0, 0, 0); }
    }
}
template <bool WIN> __device__ __forceinline__ void partialSM(f32x16& p0, f32x16& p1, float& m_reg, float& alpha, int drel, float slope2, int hi) {
    if constexpr (WIN) {
#pragma unroll
        for (int r = 0; r < 16; ++r) { const int d0_ = drel + crow(r, hi), d1_ = d0_ + 32; const float a0 = fabsf((float)d0_), a1 = fabsf((float)d1_);
            p0[r] = (a0 <= 128.f) ? p0[r] - slope2 * a0 : -1e30f; p1[r] = (a1 <= 128.f) ? p1[r] - slope2 * a1 : -1e30f; }
    }
    float pmax = p0[0];
#pragma unroll
    for (int r = 1; r < 16; ++r) pmax = fmaxf(pmax, p0[r]);
#pragma unroll
    for (int r = 0; r < 16; ++r) pmax = fmaxf(pmax, p1[r]);
    { auto rr = __builtin_amdgcn_permlane32_swap(__float_as_uint(pmax), __float_as_uint(pmax), false, false); pmax = fmaxf(__uint_as_float(rr[0]), __uint_as_float(rr[1])); }
    float mn;
    if (__builtin_expect(__all(pmax - m_reg <= THR2), 1)) { mn = m_reg; alpha = 1.f; }
    else { mn = fmaxf(m_reg, pmax); alpha = __builtin_amdgcn_exp2f(m_reg - mn); m_reg = mn; }
#pragma unroll
    for (int r = 0; r < 16; ++r) { p0[r] = p0[r] - mn; p1[r] = p1[r] - mn; }
#pragma unroll
    for (int r = 0; r < 16; ++r) p0[r] = __builtin_amdgcn_exp2f(p0[r]);
}
__device__ __forceinline__ void finishSM(f32x16& p0, f32x16& p1, float alpha, float& l_reg, bf16x8& pa0, bf16x8& pa1, bf16x8& pa2, bf16x8& pa3) {
#pragma unroll
    for (int r = 0; r < 16; ++r) p1[r] = __builtin_amdgcn_exp2f(p1[r]);
    float ps = 0;
#pragma unroll
    for (int r = 0; r < 16; ++r) ps += p0[r];
#pragma unroll
    for (int r = 0; r < 16; ++r) ps += p1[r];
    { auto rr = __builtin_amdgcn_permlane32_swap(__float_as_uint(ps), __float_as_uint(ps), false, false); ps = __uint_as_float(rr[0]) + __uint_as_float(rr[1]); }
    l_reg = l_reg * alpha + ps;
#define PK4(P, BASE, OUT) do { unsigned a0 = cvt_pk_bf16(P[BASE + 0], P[BASE + 1]), a1 = cvt_pk_bf16(P[BASE + 2], P[BASE + 3]);   \
    unsigned b0 = cvt_pk_bf16(P[BASE + 4], P[BASE + 5]), b1 = cvt_pk_bf16(P[BASE + 6], P[BASE + 7]);                              \
    auto r0 = __builtin_amdgcn_permlane32_swap(a0, b0, false, false); auto r1 = __builtin_amdgcn_permlane32_swap(a1, b1, false, false); \
    u32x4 w = {r0[0], r1[0], r0[1], r1[1]}; OUT = *reinterpret_cast<bf16x8*>(&w); } while (0)
    PK4(p0, 0, pa0); PK4(p0, 8, pa1); PK4(p1, 0, pa2); PK4(p1, 8, pa3);
#undef PK4
}

template <int DQK, bool WIN>
__device__ __forceinline__ void attn_unit(const bf16_t* __restrict__ Qb, int ldq, const bf16_t* __restrict__ Kn, int ldk, const bf16_t* __restrict__ Kr,
                                          const bf16_t* __restrict__ Vh, int ldv, const bf16_t* __restrict__ Zb, int ldz, bf16_t* __restrict__ Ob, int ldo,
                                          int t0, int NT, int qpos0, float slope2, float sink2, char* lds) {
    constexpr int ND0 = DQK / 16;
    const int tid = threadIdx.x, wid = __builtin_amdgcn_readfirstlane(tid >> 6), lane = tid & 63, r32 = lane & 31, hi = lane >> 5;
    char* V_lds = lds + OFF_V; char* Kn_lds = lds + OFF_KN; char* Kr_lds = lds + OFF_KR;
    float* ws = (float*)(lds + OFF_WS) + wid * 64; float* li_l = ws; float* al_l = ws + 32;
    float m_reg = WIN ? sink2 : -1e30f, l_reg = WIN ? 1.f : 0.f; f32x16 o[2] = {}; bf16x8 qr[ND0];
    const bf16_t* Qw = Qb + (size_t)(wid * QBLK + r32) * ldq + hi * 8;
#pragma unroll
    for (int d0 = 0; d0 < ND0; ++d0) qr[d0] = *reinterpret_cast<const bf16x8*>(Qw + d0 * 16);
    const int sr = tid >> 3, sc = (tid & 7) * 8;
    const int vst = v_st(sr, sc), knst = sr * 128 + (((tid & 7) ^ ((sr >> 1) & 7)) << 4);
    const int rr_ = (tid >> 2) & 63, rc_ = tid & 3, krst = rr_ * 64 + ((rc_ ^ ((rr_ >> 2) & 3)) << 4);
    const bool do_kr = (DQK == 96) && (wid < 4);
    const int vb0 = (int)(uintptr_t)V_lds + v_rd_base(lane);
    const int qposl = qpos0 + wid * QBLK + r32;
    struct { bf16x8 vs, ks, rs; } st_[2];
    const bf16_t* Vp = Vh + (size_t)t0 * KVBLK * ldv + (size_t)sr * ldv + sc;
    const bf16_t* Kp = Kn + (size_t)t0 * KVBLK * ldk + (size_t)sr * ldk + sc;
    const bf16_t* Rp = Kr + (size_t)t0 * KVBLK * 32 + (size_t)rr_ * 32 + rc_ * 8;
#define SLOAD(i, t) do { st_[i].vs = *reinterpret_cast<const bf16x8*>(Vp + (size_t)(t) * KVBLK * ldv); st_[i].ks = *reinterpret_cast<const bf16x8*>(Kp + (size_t)(t) * KVBLK * ldk); \
        if (do_kr) st_[i].rs = *reinterpret_cast<const bf16x8*>(Rp + (size_t)(t) * KVBLK * 32); } while (0)
#define SWRITE(b, i) do { *(bf16x8*)(V_lds + (b) * SHM_V + vst) = st_[i].vs; *(bf16x8*)(Kn_lds + (b) * SHM_KN + knst) = st_[i].ks; \
        if (do_kr) *(bf16x8*)(Kr_lds + (b) * SHM_KR + krst) = st_[i].rs; } while (0)
#define SWAIT() do { if (do_kr) asm volatile("s_waitcnt vmcnt(3)" ::: "memory"); else asm volatile("s_waitcnt vmcnt(2)" ::: "memory"); } while (0)
#define RESC(a) do { if (__any((a) < 1.f)) { if (hi == 0) al_l[r32] = (a); asm volatile("s_waitcnt lgkmcnt(0)" ::: "memory"); \
        _Pragma("unroll") for (int d = 0; d < 2; ++d) _Pragma("unroll") for (int r = 0; r < 16; ++r) o[d][r] *= al_l[crow(r, hi)]; } } while (0)
#define DREL(t) ((t0 + (t)) * KVBLK - qposl)
    f32x16 pA0, pA1, pB0, pB1; float alA, alB; bf16x8 pa0, pa1, pa2, pa3;
    SLOAD(0, 0); asm volatile("s_waitcnt vmcnt(0)" ::: "memory"); SWRITE(0, 0); __syncthreads();
    qkt<DQK>(pA0, pA1, Kn_lds, Kr_lds, qr, r32, hi); partialSM<WIN>(pA0, pA1, m_reg, alA, DREL(0), slope2, hi);
    SLOAD(1, 1); if (2 < NT) SLOAD(0, 2);
    SWAIT(); SWRITE(1, 1); __syncthreads();
    for (int j = 1; j + 1 < NT; j += 2) {
        SBAR(); qkt<DQK>(pB0, pB1, Kn_lds + SHM_KN, Kr_lds + SHM_KR, qr, r32, hi);
        finishSM(pA0, pA1, alA, l_reg, pa0, pa1, pa2, pa3); SBAR();
        SLOAD(1, j + 2); SBAR();
        pv_d0(o, vb0, pa0, pa1, pa2, pa3); partialSM<WIN>(pB0, pB1, m_reg, alB, DREL(j), slope2, hi);
        __syncthreads(); SWAIT(); SWRITE(0, 0);
        RESC(alB); __syncthreads();
        SBAR(); qkt<DQK>(pA0, pA1, Kn_lds, Kr_lds, qr, r32, hi);
        finishSM(pB0, pB1, alB, l_reg, pa0, pa1, pa2, pa3); SBAR();
        if (j + 3 < NT) SLOAD(0, j + 3); SBAR();
        pv_d0(o, vb0 + SHM_V, pa0, pa1, pa2, pa3); partialSM<WIN>(pA0, pA1, m_reg, alA, DREL(j + 1), slope2, hi);
        __syncthreads(); SWAIT(); SWRITE(1, 1);
        RESC(alA); __syncthreads();
    }
    SBAR(); qkt<DQK>(pB0, pB1, Kn_lds + SHM_KN, Kr_lds + SHM_KR, qr, r32, hi);
    finishSM(pA0, pA1, alA, l_reg, pa0, pa1, pa2, pa3); SBAR();
    pv_d0(o, vb0, pa0, pa1, pa2, pa3); partialSM<WIN>(pB0, pB1, m_reg, alB, DREL(NT - 1), slope2, hi);
    __syncthreads(); RESC(alB);
    finishSM(pB0, pB1, alB, l_reg, pa0, pa1, pa2, pa3); SBAR();
    pv_d0(o, vb0 + SHM_V, pa0, pa1, pa2, pa3);
    if (hi == 0) li_l[r32] = l_reg; asm volatile("s_waitcnt lgkmcnt(0)" ::: "memory");
#pragma unroll
    for (int r = 0; r < 16; ++r) { const int orow = wid * QBLK + crow(r, hi); const float rl = __builtin_amdgcn_rcpf(li_l[crow(r, hi)]);
#pragma unroll
        for (int d0 = 0; d0 < 2; ++d0) { const float z = __uint_as_float((unsigned)Zb[(size_t)orow * ldz + d0 * 32 + r32] << 16);
            const unsigned w = cvt_pk_bf16(o[d0][r] * rl * z, 0.f); Ob[(size_t)orow * ldo + d0 * 32 + r32] = (bf16_t)(w & 0xffffu); } }
    __syncthreads();
#undef SLOAD
#undef SWRITE
#undef SWAIT
#undef RESC
#undef DREL
}
#undef SBAR
}

constexpr int NWAVES = 8;
constexpr int LDS_BYTES = 147456;
static_assert(pg8::STAGE_BYTES <= 131072 && att::LDS_BYTES <= 131072, "LDS map");

struct Params { const float* in[17]; float* out; unsigned char* ws; int ph_lo, ph_hi; };

__device__ const double ROPE_INV[16] = {1.0, 0.5623413251903491, 0.31622776601683794, 0.1778279410038923, 0.1, 0.05623413251903491, 0.03162277660168379, 0.01778279410038923,
                                        0.01, 0.005623413251903491, 0.0031622776601683794, 0.0017782794100389228, 0.001, 0.0005623413251903491, 0.00031622776601683794, 0.00017782794100389227};

__device__ __forceinline__ unsigned f2bf(float f) { unsigned u = __builtin_bit_cast(unsigned, f); return (u + 0x7fffu + ((u >> 16) & 1u)) >> 16; }
__device__ __forceinline__ unsigned pk2(float lo, float hi) { return f2bf(lo) | (f2bf(hi) << 16); }

__device__ __forceinline__ int wsrc_col(int kind, int n, float& cs) {
    cs = 1.f;
    if (kind == 0) {
        if (n < 1280) { if (n < 512) cs = QA_SCALE; return n; }
        if (n < 1792) return n - 1280 + 1952;
        if (n < 2432) return n - 1792 + 1280;
        if (n < 2464) { const int j = n - 2432; return 1920 + (j >> 1) + 16 * (j & 1); }
        if (n < 2560) return -1;
        return n - 2560 + 2464;
    } else if (kind == 1) {
        cs = QB_SCALE; const int h = n / 96, d = n % 96;
        if (d < 64) return h * 96 + d;
        const int j = d - 64; return h * 96 + 64 + (j >> 1) + 16 * (j & 1);
    } else if (kind == 2) {
        if (n < 512) return (n >> 6) * 128 + (n & 63);
        const int q = n - 512; return (q >> 6) * 128 + 64 + (q & 63);
    }
    return n;
}
__device__ __forceinline__ void transpose_item(const float* W, int K, int Nsrc, int Ndst, int kind, const float* kgain, bf16_t* WT, LAS float* scr, int item, int lane) {
    const int nblk = Ndst / 32, kb = item / nblk, nb = item % nblk, k0 = 64 * kb, n0 = 32 * nb;
    float cs; const int src = wsrc_col(kind, n0 + (lane & 31), cs);
#pragma unroll 8
    for (int i = 0; i < 32; ++i) { const int kk = 2 * i + (lane >> 5); float v = 0.f;
        if (src >= 0) { v = W[(size_t)(k0 + kk) * Nsrc + src] * cs; if (kgain) v *= kgain[k0 + kk]; }
        scr[kk * 33 + (lane & 31)] = v; }
    asm volatile("s_waitcnt lgkmcnt(0)" ::: "memory");
    const int c = lane & 7;
#pragma unroll
    for (int j = 0; j < 4; ++j) { const int n = (lane >> 3) + 8 * j; const LAS float* s = scr + (8 * c) * 33 + n;
        u32x4 o; o.x = pk2(s[0 * 33], s[1 * 33]); o.y = pk2(s[2 * 33], s[3 * 33]); o.z = pk2(s[4 * 33], s[5 * 33]); o.w = pk2(s[6 * 33], s[7 * 33]);
        *(u32x4*)(WT + (size_t)(n0 + n) * K + k0 + 8 * c) = o; }
    asm volatile("s_waitcnt lgkmcnt(0)" ::: "memory");
}

__global__ void __launch_bounds__(NWAVES * 64, 2) mk_fwd(Params p) {
    extern __shared__ __attribute__((aligned(16))) unsigned char lds[];
    cg::grid_group grid = cg::this_grid();
    const int tid = threadIdx.x, lane = tid & 63, wave = __builtin_amdgcn_readfirstlane(tid >> 6);
    const int G = gridDim.x, bx = blockIdx.x;
    const int vcu = (G % 8 == 0) ? (bx % 8) * (G / 8) + bx / 8 : bx;
    const int gw = vcu * NWAVES + wave, NGW = G * NWAVES;
    unsigned char* ws = p.ws;
    const float *x_p = p.in[0], *x_s = p.in[1], *c_p = p.in[2], *c_s = p.in[3], *w_ada = p.in[4], *b_ada = p.in[5], *g_norm = p.in[6], *w_in = p.in[7], *g_q = p.in[8], *w_uq = p.in[9],
                *g_kv = p.in[10], *w_ukv = p.in[11], *sink = p.in[12], *w_oa = p.in[13], *w_ob = p.in[14], *w_out = p.in[15], *g_final = p.in[16];
    float* mod = (float*)(ws + WS_MOD); f32x2* rope = (f32x2*)(ws + WS_ROPE);
    bf16_t *Win_t = (bf16_t*)(ws + WS_WIN), *Wuq_t = (bf16_t*)(ws + WS_WUQ), *Wukv_t = (bf16_t*)(ws + WS_WUKV), *Woa_t = (bf16_t*)(ws + WS_WOA), *Wob_t = (bf16_t*)(ws + WS_WOB), *Wout_t = (bf16_t*)(ws + WS_WOUT);
    float *RSQ = (float*)(ws + WS_RSQ), *RSKV = (float*)(ws + WS_RSKV);
    bf16_t *HB = (bf16_t*)(ws + WS_R1), *YA = (bf16_t*)(ws + WS_R1), *YB = (bf16_t*)(ws + WS_R1 + 48 * MiB);
    bf16_t *PA = (bf16_t*)(ws + WS_R2), *QB = (bf16_t*)(ws + WS_R2);
    bf16_t *PZ = (bf16_t*)(ws + WS_R3), *TM = (bf16_t*)(ws + WS_R3);
    bf16_t *PC = (bf16_t*)(ws + WS_R4), *KN = (bf16_t*)(ws + WS_KN), *VB = (bf16_t*)(ws + WS_VB), *KR = (bf16_t*)(ws + WS_KR);
    bf16_t* PG = (bf16_t*)p.out;
    const int lo = p.ph_lo, hi = p.ph_hi;
#ifndef PH_MASK
#define PH_MASK 0x3ff
#endif
#define IN(k) (((PH_MASK >> (k)) & 1) && lo <= (k) && (k) < hi)
#define SEAM(k) do { if (IN(k) && IN((k) + 1)) grid.sync(); } while (0)

    if (IN(0)) {
        LAS float* scr = (LAS float*)((LAS unsigned char*)lds + wave * 16384);
        constexpr int I_IN = (DM / 64) * (N_IN / 32), I_UQ = (384 / 64) * (768 / 32), I_UKV = (256 / 64) * (1024 / 32), I_OA = (512 / 64) * (1024 / 32), I_OUT = (1024 / 64) * (1024 / 32);
        constexpr int NITEMS = I_IN + I_UQ + I_UKV + 2 * I_OA + I_OUT;
        for (int it = gw; it < NITEMS; it += NGW) {
            int r = it;
            if (r < I_IN) { transpose_item(w_in, DM, D_IN, N_IN, 0, nullptr, Win_t, scr, r, lane); continue; } r -= I_IN;
            if (r < I_UQ) { transpose_item(w_uq, 384, 768, 768, 1, g_q, Wuq_t, scr, r, lane); continue; } r -= I_UQ;
            if (r < I_UKV) { transpose_item(w_ukv, 256, 1024, 1024, 2, g_kv, Wukv_t, scr, r, lane); continue; } r -= I_UKV;
            if (r < I_OA) { transpose_item(w_oa, 512, 1024, 1024, 3, nullptr, Woa_t, scr, r, lane); continue; } r -= I_OA;
            if (r < I_OA) { transpose_item(w_ob, 512, 1024, 1024, 3, nullptr, Wob_t, scr, r, lane); continue; } r -= I_OA;
            transpose_item(w_out, 1024, 1024, 1024, 3, nullptr, Wout_t, scr, r, lane);
        }
        for (int it = gw; it < 16 * 48; it += NGW) { const int ks = it / 48, cgp = it % 48, col = cgp * 64 + lane; float a[NBATCH];
#pragma unroll
            for (int b = 0; b < NBATCH; ++b) a[b] = 0.f;
            for (int k = ks * 64; k < ks * 64 + 64; ++k) { const float w = w_ada[(size_t)k * 3 * DM + col];
#pragma unroll
                for (int b = 0; b < NBATCH; ++b) { const float c = (b < NB_P) ? c_p[b * DM + k] : c_s[(b - NB_P) * DM + k]; a[b] += c * sigmoidf_fast(c) * w; } }
#pragma unroll
            for (int b = 0; b < NBATCH; ++b) atomicAdd(mod + b * 3 * DM + col, a[b]);
        }
        for (int e = gw * 64 + lane; e < S_S * 16; e += NGW * 64) { const int pos = e >> 4, i = e & 15;
            const double ang = (double)pos * ROPE_INV[i]; const double n = rint(ang * 0.6366197723675814);
            const double r = (ang - n * 1.5707963267948966) - n * 6.123233995736766e-17; const double r2 = r * r;
            const double sn = r * (1.0 + r2 * (-1.0 / 6 + r2 * (1.0 / 120 + r2 * (-1.0 / 5040 + r2 * (1.0 / 362880 + r2 * (-1.0 / 39916800 + r2 * (1.0 / 6227020800.0)))))));
            const double cn = 1.0 + r2 * (-0.5 + r2 * (1.0 / 24 + r2 * (-1.0 / 720 + r2 * (1.0 / 40320 + r2 * (-1.0 / 3628800 + r2 * (1.0 / 479001600.0))))));
            const int q = (int)((long long)n & 3); double cs_, sn_;
            if (q == 0) { cs_ = cn; sn_ = sn; } else if (q == 1) { cs_ = -sn; sn_ = cn; } else if (q == 2) { cs_ = -cn; sn_ = -sn; } else { cs_ = sn; sn_ = -cn; }
            rope[e] = (f32x2){(float)cs_, (float)sn_}; }
    }
    SEAM(0);
    if (IN(1)) {
        constexpr int RPW = 24;
        for (int base = gw * RPW; base < M; base += NGW * RPW) {
            int cb = -1; f32x4 ga[4], sh[4];
            for (int row = base; row < base + RPW && row < M; ++row) {
                const int b = batch_of_row(row);
                if (b != cb) { cb = b;
#pragma unroll
                    for (int j = 0; j < 4; ++j) { const int c = 4 * lane + 256 * j;
                        const f32x4 sc = *(const f32x4*)(mod + b * 3 * DM + DM + c) + *(const f32x4*)(b_ada + DM + c);
                        sh[j] = *(const f32x4*)(mod + b * 3 * DM + c) + *(const f32x4*)(b_ada + c);
                        ga[j] = *(const f32x4*)(g_norm + c) * (sc + 1.0f); } }
                const float* xr = row < M_P ? x_p + (size_t)row * DM : x_s + (size_t)(row - M_P) * DM;
                f32x4 v[4]; float s = 0.f;
#pragma unroll
                for (int j = 0; j < 4; ++j) { v[j] = *(const f32x4*)(xr + 4 * lane + 256 * j); s += (v[j].x * v[j].x + v[j].y * v[j].y) + (v[j].z * v[j].z + v[j].w * v[j].w); }
                const float rstd = 1.0f / sqrtf(wave_sum(s) * (1.f / DM) + EPS);
#pragma unroll
                for (int j = 0; j < 4; ++j) { const f32x4 h = v[j] * rstd * ga[j] + sh[j]; u32x2 w; w.x = cvt_pk_bf16(h.x, h.y); w.y = cvt_pk_bf16(h.z, h.w);
                    *(u32x2*)(HB + (size_t)row * DM + 4 * lane + 256 * j) = w; }
            }
        }
    }
    SEAM(1);
    if (IN(2)) {
        pg8::Gemm g{HB, Win_t, M, N_IN, DM, DM}; pg8::StaticOrder S; S.init(M, N_IN, G, bx);
        pg8::EpiProj E{PA, PZ, PC, PG};
        pg8::gemm_phase<pg8::EpiProj, 1024, 1024>((LAS unsigned char*)lds, g, S, E);
    }
    SEAM(2);
    if (IN(3)) {
        for (int row = gw; row < M; row += NGW) {
            const bf16_t* pr = PC + (size_t)row * 768;
            const u32x4 a = *(const u32x4*)(pr + lane * 8); u32x4 b = (u32x4){0u, 0u, 0u, 0u};
            if (lane < 20) b = *(const u32x4*)(pr + 512 + lane * 8);
            float sa = 0.f, sb = 0.f;
#pragma unroll
            for (int e = 0; e < 4; ++e) { const float l0 = bf_lo(a[e]), h0 = bf_hi(a[e]); sa += l0 * l0 + h0 * h0; }
            if (lane < 16) {
#pragma unroll
                for (int e = 0; e < 4; ++e) { const float l0 = bf_lo(b[e]), h0 = bf_hi(b[e]); sb += l0 * l0 + h0 * h0; } }
            float sq = (lane < 48) ? sa : 0.f, skv = (lane < 48) ? 0.f : sa; skv += sb;
            sq = wave_sum(sq); skv = wave_sum(skv);
            if (lane == 0) { RSQ[row] = 1.0f / sqrtf(sq * (1.f / 384.f) + EPS); RSKV[row] = 1.0f / sqrtf(skv * (1.f / 256.f) + EPS); }
            if (lane >= 16 && lane < 20) { const int i0 = (lane - 16) * 4; const f32x4* tp = (const f32x4*)(rope + (size_t)pos_of_row(row) * 16 + i0); const f32x4 c0 = tp[0], c1 = tp[1];
                const float x0 = bf_lo(b.x), y0 = bf_hi(b.x), x1 = bf_lo(b.y), y1 = bf_hi(b.y), x2 = bf_lo(b.z), y2 = bf_hi(b.z), x3 = bf_lo(b.w), y3 = bf_hi(b.w);
                u32x4 w; w.x = cvt_pk_bf16(x0 * c0[0] - y0 * c0[1], x0 * c0[1] + y0 * c0[0]); w.y = cvt_pk_bf16(x1 * c0[2] - y1 * c0[3], x1 * c0[3] + y1 * c0[2]);
                w.z = cvt_pk_bf16(x2 * c1[0] - y2 * c1[1], x2 * c1[1] + y2 * c1[0]); w.w = cvt_pk_bf16(x3 * c1[2] - y3 * c1[3], x3 * c1[3] + y3 * c1[2]);
                *(u32x4*)(KR + (size_t)row * 32 + (lane - 16) * 8) = w; }
        }
        for (int U = vcu; U < (M / 256) * 8; U += G) { const int rb = U >> 3, h = U & 7, kvh = h >> 2; const int row0 = rb * 256;
            const int S = row0 < M_P ? S_P : S_S; const int qpos0 = pos_of_row(row0); const int seq0 = row0 - qpos0;
            const int ks = qpos0 - 128 < 0 ? 0 : qpos0 - 128, ke = qpos0 + 384 > S ? S : qpos0 + 384;
            const float slope2 = exp2f(-(float)(h + 1)) * LOG2E, sink2 = sink[h] * LOG2E;
            att::attn_unit<64, true>(PA + (size_t)row0 * 768 + h * 64, 768, PA + (size_t)seq0 * 768 + 512 + kvh * 64, 768, nullptr, PA + (size_t)seq0 * 768 + 640 + kvh * 64, 768,
                                     PZ + (size_t)row0 * 1024 + h * 64, 1024, YA + (size_t)row0 * 512 + h * 64, 512, ks / 64, (ke - ks) / 64, qpos0, slope2, sink2, (char*)lds);
        }
    }
    SEAM(3);
    if (IN(4)) {
#ifndef NO_Q
        { pg8::Gemm g{PC, Wuq_t, M, 768, 384, 768}; pg8::StaticOrder S; S.init(M, 768, G, bx); pg8::EpiQ E{QB, RSQ, rope};
          pg8::gemm_phase<pg8::EpiQ, 384, 768>((LAS unsigned char*)lds, g, S, E); }
#endif
#ifndef NO_KV
        { pg8::Gemm g{PC + 384, Wukv_t, M, 1024, 256, 768}; pg8::StaticOrder S; S.init(M, 1024, G, bx); pg8::EpiKV E{KN, VB, RSKV};
          pg8::gemm_phase<pg8::EpiKV, 256, 768>((LAS unsigned char*)lds, g, S, E); }
#endif
    }
    SEAM(4);
    if (IN(5)) {
        for (int U = vcu; U < 1536; U += G) {
            int row0, seq0, S, h;
            if (U < 1024) { const int i = U >> 8, v = U & 255, xcd = v >> 5, c = v & 31; const int bh = 2 * xcd + (i >> 1), qb = (i & 1) * 32 + c; const int b = bh >> 3; h = bh & 7;
                S = S_S; seq0 = M_P + b * S_S; row0 = seq0 + qb * 256; }
            else { const int U2 = U - 1024; const int j = U2 >> 8, v = U2 & 255, xcd = v >> 5, c = v & 31; const int bh = 4 * xcd + 2 * j + (c >> 4), qb = c & 15; const int b = bh >> 3; h = bh & 7;
                S = S_P; seq0 = b * S_P; row0 = seq0 + qb * 256; }
            att::attn_unit<96, false>(QB + (size_t)row0 * 768 + h * 96, 768, KN + (size_t)seq0 * 512 + h * 64, 512, KR + (size_t)seq0 * 32, VB + (size_t)seq0 * 512 + h * 64, 512,
                                      PZ + (size_t)row0 * 1024 + 512 + h * 64, 1024, YB + (size_t)row0 * 512 + h * 64, 512, 0, S / 64, 0, 0.f, 0.f, (char*)lds);
        }
    }
    SEAM(5);
    if (IN(6)) { pg8::Gemm g{YA, Woa_t, M, 1024, 512, 512}; pg8::StaticOrder S; S.init(M, 1024, G, bx); pg8::EpiGate<true> E{TM, PG, 0};
        pg8::gemm_phase<pg8::EpiGate<true>, 512, 512>((LAS unsigned char*)lds, g, S, E); }
    SEAM(6);
    if (IN(7)) { pg8::Gemm g{YB, Wob_t, M, 1024, 512, 512}; pg8::StaticOrder S; S.init(M, 1024, G, bx); pg8::EpiGate<false> E{TM, PG, 1024};
        pg8::gemm_phase<pg8::EpiGate<false>, 512, 512>((LAS unsigned char*)lds, g, S, E); }
    SEAM(7);
    if (IN(8)) { pg8::Gemm g{TM, Wout_t, M, 1024, 1024, 1024}; pg8::StaticOrder S; S.init(M, 1024, G, bx); pg8::EpiOut E{x_p, x_s, p.out, mod, b_ada};
        pg8::gemm_phase<pg8::EpiOut, 1024, 1024>((LAS unsigned char*)lds, g, S, E); }
    SEAM(8);
    if (IN(9)) {
        f32x4 gf[4];
#pragma unroll
        for (int j = 0; j < 4; ++j) gf[j] = *(const f32x4*)(g_final + 4 * lane + 256 * j);
        for (int row = gw; row < M; row += NGW) { float* orow = p.out + (size_t)row * DM; f32x4 v[4]; float s = 0.f;
#pragma unroll
            for (int j = 0; j < 4; ++j) { v[j] = *(const f32x4*)(orow + 4 * lane + 256 * j); s += (v[j].x * v[j].x + v[j].y * v[j].y) + (v[j].z * v[j].z + v[j].w * v[j].w); }
            const float rstd = 1.0f / sqrtf(wave_sum(s) * (1.f / DM) + EPS);
#pragma unroll
            for (int j = 0; j < 4; ++j) *(f32x4*)(orow + 4 * lane + 256 * j) = v[j] * rstd * gf[j];
        }
    }
#undef IN
#undef SEAM
}

extern "C" void kernel_launch(void* const* d_in, const int* in_sizes, int n_in, void* d_out, int out_size, void* d_ws, size_t ws_size, hipStream_t stream) {
    static int grid = 0;
    if (grid == 0) {
        if (n_in != 17 || out_size != M * DM || ws_size < WS_END) { fprintf(stderr, "kernel_launch: unexpected shapes: n_in %d out %d ws %zu (need %zu)\n", n_in, out_size, ws_size, (size_t)WS_END); grid = -1; return; }
        int dev = 0, cus = 0, per_cu = 0;
        hipGetDevice(&dev); hipDeviceGetAttribute(&cus, hipDeviceAttributeMultiprocessorCount, dev);
        if (hipFuncSetAttribute((const void*)mk_fwd, hipFuncAttributeMaxDynamicSharedMemorySize, LDS_BYTES) != hipSuccess) { fprintf(stderr, "kernel_launch: hipFuncSetAttribute failed\n"); grid = -1; return; }
        if (hipOccupancyMaxActiveBlocksPerMultiprocessor(&per_cu, (const void*)mk_fwd, NWAVES * 64, LDS_BYTES) != hipSuccess || per_cu < 1) { fprintf(stderr, "kernel_launch: occupancy query says %d\n", per_cu); per_cu = 1; }
        (void)hipGetLastError();
        grid = cus;
    }
    if (grid < 0) return;
    hipMemsetAsync((char*)d_ws + WS_MOD, 0, MOD_BYTES, stream);
    Params p{};
    for (int i = 0; i < 17; ++i) p.in[i] = (const float*)d_in[i];
    p.out = (float*)d_out; p.ws = (unsigned char*)d_ws;
#if MK_N_LAUNCHES == 1
    p.ph_lo = 0; p.ph_hi = 10;
    void* args[] = {&p};
    hipError_t e = hipLaunchCooperativeKernel((const void*)mk_fwd, dim3(grid), dim3(NWAVES * 64), args, LDS_BYTES, stream);
    if (e != hipSuccess) fprintf(stderr, "cooperative launch failed: %s (grid %d)\n", hipGetErrorString(e), grid);
#else
    for (int ph = 0; ph < 10; ++ph) { p.ph_lo = ph; p.ph_hi = ph + 1; hipLaunchKernelGGL(mk_fwd, dim3(grid), dim3(NWAVES * 64), LDS_BYTES, stream, p); }
#endif
}
```

```cpp
#include <hip/hip_runtime.h>
#include <hip/hip_cooperative_groups.h>
#include <cstdio>
#include <cstdint>
namespace cg = cooperative_groups;

#ifndef MK_N_LAUNCHES
#define MK_N_LAUNCHES 1
#endif

constexpr int DM = 1024;
constexpr int NB_P = 4, S_P = 4096, NB_S = 2, S_S = 16384;
constexpr int M_P = NB_P * S_P, M_S = NB_S * S_S, M = M_P + M_S;
constexpr int D_IN = 4512, N_IN = 4608;
constexpr int NBATCH = NB_P + NB_S;
constexpr float EPS = 1e-6f;
constexpr float LOG2E = 1.4426950408889634f;
constexpr float QA_SCALE = 0.125f * LOG2E;
constexpr float QB_SCALE = 0.10206207261596575f * LOG2E;

constexpr size_t MiB = 1u << 20;
constexpr size_t WS_MOD = 0;
constexpr size_t MOD_BYTES = (size_t)NBATCH * 3 * DM * 4;
constexpr size_t WS_ROPE = 128 * 1024;
constexpr size_t WS_WIN = WS_ROPE + 2 * MiB;
constexpr size_t WS_WUQ = WS_WIN + (size_t)N_IN * DM * 2;
constexpr size_t WS_WUKV = WS_WUQ + (size_t)768 * 384 * 2;
constexpr size_t WS_WOA = WS_WUKV + (size_t)1024 * 256 * 2;
constexpr size_t WS_WOB = WS_WOA + (size_t)1024 * 512 * 2;
constexpr size_t WS_WOUT = WS_WOB + (size_t)1024 * 512 * 2;
constexpr size_t WS_RSQ = WS_WOUT + (size_t)1024 * 1024 * 2;
constexpr size_t WS_RSKV = WS_RSQ + (size_t)M * 4;
static_assert(WS_RSKV + (size_t)M * 4 <= 20 * MiB, "small region");
constexpr size_t WS_R1 = 20 * MiB;
constexpr size_t WS_R2 = WS_R1 + 96 * MiB;
constexpr size_t WS_R3 = WS_R2 + 72 * MiB;
constexpr size_t WS_R4 = WS_R3 + 96 * MiB;
constexpr size_t WS_KN = WS_R4 + 72 * MiB;
constexpr size_t WS_VB = WS_KN + 48 * MiB;
constexpr size_t WS_KR = WS_VB + 48 * MiB;
constexpr size_t WS_END = WS_KR + 3 * MiB;

typedef unsigned short bf16_t;
typedef short bf16x8 __attribute__((ext_vector_type(8)));
typedef short s16x4 __attribute__((ext_vector_type(4)));
typedef float f32x4 __attribute__((ext_vector_type(4)));
typedef float f32x2 __attribute__((ext_vector_type(2)));
typedef float f32x16 __attribute__((ext_vector_type(16)));
typedef unsigned u32x4 __attribute__((ext_vector_type(4)));
typedef unsigned u32x2 __attribute__((ext_vector_type(2)));
#define LAS __attribute__((address_space(3)))

__device__ __forceinline__ unsigned cvt_pk_bf16(float lo, float hi) { unsigned r; asm volatile("v_cvt_pk_bf16_f32 %0, %1, %2" : "=v"(r) : "v"(lo), "v"(hi)); return r; }
__device__ __forceinline__ float bf_lo(unsigned w) { return __uint_as_float(w << 16); }
__device__ __forceinline__ float bf_hi(unsigned w) { return __uint_as_float(w & 0xffff0000u); }
__device__ __forceinline__ float sigmoidf_fast(float v) { return __builtin_amdgcn_rcpf(1.0f + __builtin_amdgcn_exp2f(-v * LOG2E)); }
__device__ __forceinline__ float wave_sum(float v) {
#pragma unroll
    for (int o = 1; o < 64; o <<= 1) v += __shfl_xor(v, o);
    return v;
}
__device__ __forceinline__ int batch_of_row(int row) { return row < M_P ? (row >> 12) : NB_P + ((row - M_P) >> 14); }
__device__ __forceinline__ int pos_of_row(int row) { return row < M_P ? (row & (S_P - 1)) : ((row - M_P) & (S_S - 1)); }

namespace pg8 {
constexpr int BM = 256, BK = 64, HALF = 128, HTB = HALF * BK * 2, STAGE_BYTES = 8 * HTB, NXCD = 8, WGM = 8;
__host__ __device__ __forceinline__ int lds_byte(int r, int c) { const int st = (r >> 4) * 2 + (c >> 5), rr = r & 15, cc = c & 31, ob = rr * 64 + cc * 2; return st * 1024 + (ob ^ (((ob >> 9) & 1) << 5)); }
__host__ __device__ __forceinline__ void stage_rc(int b, int& R, int& C) { const int st = b / 1024, sb = b % 1024, swz = sb ^ (((sb >> 9) & 1) << 5); R = (st >> 1) * 16 + swz / 64; C = (st & 1) * 32 + (swz % 64) / 2; }
__host__ __device__ __forceinline__ int perm32(int rho) { const int n = rho >> 4, i = rho & 15; return 8 * (i >> 2) + 4 * n + (i & 3); }

struct Unit { int pm, pn; };
struct Gemm { const bf16_t* A; const bf16_t* Bt; int M, N, K, lda; };

struct StaticOrder {
    int nM, nN, nwg, G, c;
    __device__ void init(int M_, int N_, int G_, int c_) { nM = M_ / BM; nN = N_ / BM; nwg = nM * nN; G = G_; c = c_; }
    __device__ bool next(int i, Unit& u) const {
        const long L = (long)i * G + c; if (L >= nwg) return false;
        int wgid = (int)L; { const int q = nwg / NXCD, r = nwg % NXCD, xcd = wgid % NXCD, off = wgid / NXCD; wgid = (xcd < r ? xcd * (q + 1) : r * (q + 1) + (xcd - r) * q) + off; }
        const int nig = WGM * nN, gid = wgid / nig, fm = gid * WGM, gsz = (nM - fm) < WGM ? (nM - fm) : WGM;
        u.pm = fm + ((wgid % nig) % gsz); u.pn = (wgid % nig) / gsz; return true;
    }
};

template <class Epi, int K, int LDA, bool ALIGN_EPI = true>
__device__ __forceinline__ void gemm_phase(LAS unsigned char* lds, const Gemm g, const StaticOrder& S, const Epi& E) {
    const int tid = threadIdx.x, wid = __builtin_amdgcn_readfirstlane(tid >> 6), lane = tid & 63, wr = wid >> 2, wc = wid & 3, fr = lane & 15, fq = lane >> 4;
    constexpr int nt = K / BK, lda = LDA;
    unsigned voffA[2], voffB[2];
#pragma unroll
    for (int i = 0; i < 2; ++i) { int R, C; stage_rc(tid * 16 + i * 8192, R, C); const int Rb = (R & ~31) + perm32(R & 31);
        voffA[i] = (unsigned)(R * lda + C) * 2u; voffB[i] = (unsigned)(Rb * K + C) * 2u; }
    const size_t kstep = (size_t)(BK * 2);
    const size_t hstepA = (size_t)HALF * lda * 2, tstepA = 2 * hstepA;
    const size_t hstepB = (size_t)HALF * K * 2, tstepB = 2 * hstepB;
    const unsigned ldsw = (unsigned)wid * 1024u;
    const int aoff = lds_byte(wr * 64 + fr, fq * 8), boff = lds_byte(wc * 32 + fr, fq * 8);
#define PG8_SA(b, h) (((b) * 2 + (h)) * HTB)
#define PG8_SB(b, h) ((4 + (b) * 2 + (h)) * HTB)
#define PG8_STAGE(bufoff, gbase, voff) do { _Pragma("unroll") for (int _i = 0; _i < 2; ++_i) \
        __builtin_amdgcn_global_load_lds((const unsigned*)((const char*)(gbase) + (voff)[_i]), (LAS unsigned*)(lds + (bufoff) + ldsw + _i * 8192), 16, 0, 0); } while (0)
#define PG8_LDA(dst, b, h) do { _Pragma("unroll") for (int m = 0; m < 4; ++m) _Pragma("unroll") for (int k = 0; k < 2; ++k) dst[m][k] = *(const LAS bf16x8*)(lds + PG8_SA(b, h) + aoff + m * 2048 + k * 1024); } while (0)
#define PG8_LDB(dst, b, h) do { _Pragma("unroll") for (int n = 0; n < 2; ++n) _Pragma("unroll") for (int k = 0; k < 2; ++k) dst[n][k] = *(const LAS bf16x8*)(lds + PG8_SB(b, h) + boff + n * 2048 + k * 1024); } while (0)
#define PG8_MMA(ai, bj, At, Bt) do { __builtin_amdgcn_s_setprio(1); _Pragma("unroll") for (int m = 0; m < 4; ++m) _Pragma("unroll") for (int n = 0; n < 2; ++n) _Pragma("unroll") for (int k = 0; k < 2; ++k) \
        acc[ai][bj][m][n] = __builtin_amdgcn_mfma_f32_16x16x32_bf16(Bt[n][k], At[m][k], acc[ai][bj][m][n], 0, 0, 0); __builtin_amdgcn_s_setprio(0); } while (0)
#define PG8_WAIT_V(n) asm volatile("s_waitcnt vmcnt(" #n ")" ::: "memory")
#define PG8_WAIT_L(n) asm volatile("s_waitcnt lgkmcnt(" #n ")" ::: "memory")
#define PG8_BAR __builtin_amdgcn_s_barrier()
#define PG8_SCHED __builtin_amdgcn_sched_barrier(0)
    Unit cur, nxt; int ui = 0;
    if (!S.next(0, cur)) return;
    f32x4 acc[2][2][4][2];
#pragma unroll
    for (int a = 0; a < 2; ++a)
#pragma unroll
        for (int b = 0; b < 2; ++b)
#pragma unroll
            for (int m = 0; m < 4; ++m)
#pragma unroll
                for (int n = 0; n < 2; ++n) acc[a][b][m][n] = (f32x4){0.f, 0.f, 0.f, 0.f};
    bf16x8 At[4][2], B0[2][2], B1[2][2];
    const char* cA = (const char*)g.A + (size_t)cur.pm * tstepA; const char* cB = (const char*)g.Bt + (size_t)cur.pn * tstepB;
    PG8_STAGE(PG8_SB(0, 0), cB, voffB); PG8_STAGE(PG8_SB(0, 1), cB + hstepB, voffB); PG8_STAGE(PG8_SA(0, 0), cA, voffA); PG8_STAGE(PG8_SA(0, 1), cA + hstepA, voffA);
    if (wr == 1) PG8_BAR;
    PG8_WAIT_V(2); PG8_BAR;
    PG8_STAGE(PG8_SB(1, 0), cB + kstep, voffB); PG8_STAGE(PG8_SA(1, 0), cA + kstep, voffA); PG8_STAGE(PG8_SB(1, 1), cB + hstepB + kstep, voffB);
    PG8_WAIT_V(6); PG8_BAR;
    for (;;) {
        const bool has_next = S.next(ui + 1, nxt);
        const char* nA = has_next ? (const char*)g.A + (size_t)nxt.pm * tstepA : cA; const char* nB = has_next ? (const char*)g.Bt + (size_t)nxt.pn * tstepB : cB;
#pragma unroll 1
        for (int t = 0; t < nt; t += 2) {
            const bool last = (t == nt - 2);
            const char* a1 = cA + (size_t)(t + 1) * kstep;
            const char* a2 = last ? nA : cA + (size_t)(t + 2) * kstep; const char* b2 = last ? nB : cB + (size_t)(t + 2) * kstep;
            const char* a3 = a2 + kstep; const char* b3 = b2 + kstep;
            PG8_LDB(B0, 0, 0); PG8_LDB(B1, 0, 1); PG8_SCHED; PG8_LDA(At, 0, 0); PG8_STAGE(PG8_SA(1, 1), a1 + hstepA, voffA);
            PG8_WAIT_V(8); PG8_WAIT_L(0); PG8_BAR; PG8_MMA(0, 0, At, B0); PG8_MMA(0, 1, At, B1); PG8_BAR; PG8_SCHED;
            PG8_LDA(At, 0, 1); PG8_STAGE(PG8_SB(0, 0), b2, voffB); PG8_STAGE(PG8_SB(0, 1), b2 + hstepB, voffB); PG8_STAGE(PG8_SA(0, 0), a2, voffA);
            PG8_WAIT_V(8); PG8_WAIT_L(0); PG8_BAR; PG8_MMA(1, 0, At, B0); PG8_MMA(1, 1, At, B1); PG8_BAR; PG8_SCHED;
            PG8_LDB(B0, 1, 0); PG8_LDB(B1, 1, 1); PG8_SCHED; PG8_LDA(At, 1, 0); PG8_STAGE(PG8_SA(0, 1), a2 + hstepA, voffA);
            PG8_WAIT_V(8); PG8_WAIT_L(0); PG8_BAR; PG8_MMA(0, 0, At, B0); PG8_MMA(0, 1, At, B1); PG8_BAR; PG8_SCHED;
            PG8_LDA(At, 1, 1); PG8_STAGE(PG8_SB(1, 0), b3, voffB); PG8_STAGE(PG8_SB(1, 1), b3 + hstepB, voffB); PG8_STAGE(PG8_SA(1, 0), a3, voffA);
            PG8_WAIT_V(8); PG8_WAIT_L(0); PG8_BAR; PG8_MMA(1, 0, At, B0); PG8_MMA(1, 1, At, B1); PG8_BAR; PG8_SCHED;
        }
        if constexpr (ALIGN_EPI) { if (wr == 0) PG8_BAR; }
        E(acc, cur, wr, wc, fr, fq);
        if (!has_next) break;
#pragma unroll
        for (int a = 0; a < 2; ++a)
#pragma unroll
            for (int b = 0; b < 2; ++b)
#pragma unroll
                for (int m = 0; m < 4; ++m)
#pragma unroll
                    for (int n = 0; n < 2; ++n) acc[a][b][m][n] = (f32x4){0.f, 0.f, 0.f, 0.f};
        cur = nxt; cA = nA; cB = nB; ++ui;
        if constexpr (ALIGN_EPI) { if (wr == 1) PG8_BAR; }
    }
    PG8_WAIT_V(0);
    if constexpr (!ALIGN_EPI) { if (wr == 0) PG8_BAR; }
    PG8_BAR;
#undef PG8_SA
#undef PG8_SB
#undef PG8_STAGE
#undef PG8_LDA
#undef PG8_LDB
#undef PG8_MMA
#undef PG8_WAIT_V
#undef PG8_WAIT_L
#undef PG8_BAR
#undef PG8_SCHED
}

typedef const f32x4 (&AccRef)[2][2][4][2];
__device__ __forceinline__ u32x4 pack8(f32x4 v0, f32x4 v1) { u32x4 w; w.x = cvt_pk_bf16(v0[0], v0[1]); w.y = cvt_pk_bf16(v0[2], v0[3]); w.z = cvt_pk_bf16(v1[0], v1[1]); w.w = cvt_pk_bf16(v1[2], v1[3]); return w; }

struct EpiProj {
    bf16_t *PA, *PZ, *PC, *PG;
    __device__ __forceinline__ void operator()(AccRef acc, const Unit& u, int wr, int wc, int fr, int fq) const {
        bf16_t* base; int ldc, colt, act;
        if (u.pn < 3) { base = PA; ldc = 768; colt = u.pn * 256; act = 0; }
        else if (u.pn < 7) { base = PZ; ldc = 1024; colt = (u.pn - 3) * 256; act = 1; }
        else if (u.pn < 10) { base = PC; ldc = 768; colt = (u.pn - 7) * 256; act = 0; }
        else { base = PG; ldc = 2048; colt = (u.pn - 10) * 256; act = 2; }
        const int row0 = u.pm * BM + wr * 64 + fr, col0 = colt + wc * 32 + 8 * fq;
#pragma unroll
        for (int ai = 0; ai < 2; ++ai)
#pragma unroll
            for (int m = 0; m < 4; ++m) { bf16_t* rowp = base + (size_t)(row0 + ai * HALF + m * 16) * ldc + col0;
#pragma unroll
                for (int bj = 0; bj < 2; ++bj) { f32x4 v0 = acc[ai][bj][m][0], v1 = acc[ai][bj][m][1];
                    if (act != 0) {
#pragma unroll
                        for (int e = 0; e < 4; ++e) { const float s0 = sigmoidf_fast(v0[e]), s1 = sigmoidf_fast(v1[e]); v0[e] = (act == 1) ? v0[e] * s0 : s0; v1[e] = (act == 1) ? v1[e] * s1 : s1; }
                    }
                    *(u32x4*)(rowp + bj * HALF) = pack8(v0, v1); } }
    }
};
struct EpiQ {
    bf16_t* QB; const float* rs; const f32x2* rope;
    __device__ __forceinline__ void operator()(AccRef acc, const Unit& u, int wr, int wc, int fr, int fq) const {
        const int row0 = u.pm * BM + wr * 64 + fr; const int colb = u.pn * BM + wc * 32 + 8 * fq;
        const int dp0 = colb % 96, dp1 = (colb + HALF) % 96;
#pragma unroll
        for (int ai = 0; ai < 2; ++ai)
#pragma unroll
            for (int m = 0; m < 4; ++m) { const int row = row0 + ai * HALF + m * 16; const float r = rs[row]; const f32x2* tr = rope + (size_t)pos_of_row(row) * 16;
#pragma unroll
                for (int bj = 0; bj < 2; ++bj) { const int dp = bj ? dp1 : dp0;
                    f32x4 v0 = acc[ai][bj][m][0] * r, v1 = acc[ai][bj][m][1] * r;
                    if (dp >= 64) { const f32x4* tp = (const f32x4*)(tr + ((dp - 64) >> 1)); const f32x4 c0 = tp[0], c1 = tp[1];
                        f32x4 w0, w1;
                        w0[0] = v0[0] * c0[0] - v0[1] * c0[1]; w0[1] = v0[0] * c0[1] + v0[1] * c0[0];
                        w0[2] = v0[2] * c0[2] - v0[3] * c0[3]; w0[3] = v0[2] * c0[3] + v0[3] * c0[2];
                        w1[0] = v1[0] * c1[0] - v1[1] * c1[1]; w1[1] = v1[0] * c1[1] + v1[1] * c1[0];
                        w1[2] = v1[2] * c1[2] - v1[3] * c1[3]; w1[3] = v1[2] * c1[3] + v1[3] * c1[2];
                        v0 = w0; v1 = w1; }
                    *(u32x4*)(QB + (size_t)row * 768 + colb + bj * HALF) = pack8(v0, v1); }
                asm volatile("" ::: "memory"); }
    }
};
struct EpiKV {
    bf16_t *KN, *VB; const float* rs;
    __device__ __forceinline__ void operator()(AccRef acc, const Unit& u, int wr, int wc, int fr, int fq) const {
        bf16_t* base = (u.pn < 2) ? KN : VB; const int colt = (u.pn & 1) * 256;
        const int row0 = u.pm * BM + wr * 64 + fr, col0 = colt + wc * 32 + 8 * fq;
#pragma unroll
        for (int ai = 0; ai < 2; ++ai)
#pragma unroll
            for (int m = 0; m < 4; ++m) { const int row = row0 + ai * HALF + m * 16; const float r = rs[row]; bf16_t* rowp = base + (size_t)row * 512 + col0;
#pragma unroll
                for (int bj = 0; bj < 2; ++bj) *(u32x4*)(rowp + bj * HALF) = pack8(acc[ai][bj][m][0] * r, acc[ai][bj][m][1] * r); }
    }
};
template <bool FIRST> struct EpiGate {
    bf16_t* T; const bf16_t* PG; int goff;
    __device__ __forceinline__ void operator()(AccRef acc, const Unit& u, int wr, int wc, int fr, int fq) const {
        const int row0 = u.pm * BM + wr * 64 + fr, col0 = u.pn * BM + wc * 32 + 8 * fq;
#pragma unroll
        for (int ai = 0; ai < 2; ++ai)
#pragma unroll
            for (int m = 0; m < 4; ++m) { const int row = row0 + ai * HALF + m * 16;
#pragma unroll
                for (int bj = 0; bj < 2; ++bj) { const int col = col0 + bj * HALF;
                    const u32x4 gw = *(const u32x4*)(PG + (size_t)row * 2048 + goff + col);
                    f32x4 v0 = acc[ai][bj][m][0], v1 = acc[ai][bj][m][1];
                    v0[0] *= bf_lo(gw.x); v0[1] *= bf_hi(gw.x); v0[2] *= bf_lo(gw.y); v0[3] *= bf_hi(gw.y);
                    v1[0] *= bf_lo(gw.z); v1[1] *= bf_hi(gw.z); v1[2] *= bf_lo(gw.w); v1[3] *= bf_hi(gw.w);
                    bf16_t* tp = T + (size_t)row * 1024 + col;
                    if (!FIRST) { const u32x4 tw = *(const u32x4*)tp;
                        v0[0] += bf_lo(tw.x); v0[1] += bf_hi(tw.x); v0[2] += bf_lo(tw.y); v0[3] += bf_hi(tw.y);
                        v1[0] += bf_lo(tw.z); v1[1] += bf_hi(tw.z); v1[2] += bf_lo(tw.w); v1[3] += bf_hi(tw.w); }
                    *(u32x4*)tp = pack8(v0, v1); } }
    }
};
struct EpiOut {
    const float *xp, *xs; float* out; const float* mod; const float* b_ada;
    __device__ __forceinline__ void operator()(AccRef acc, const Unit& u, int wr, int wc, int fr, int fq) const {
        const int rowt = u.pm * BM; const int b = batch_of_row(rowt);
        const float* xbase = rowt < M_P ? xp + (size_t)rowt * DM : xs + (size_t)(rowt - M_P) * DM;
        float* obase = out + (size_t)rowt * DM;
        const int col0 = u.pn * BM + wc * 32 + 8 * fq;
        f32x4 g[2][2];
#pragma unroll
        for (int bj = 0; bj < 2; ++bj)
#pragma unroll
            for (int n = 0; n < 2; ++n) g[bj][n] = *(const f32x4*)(mod + (size_t)b * 3 * DM + 2 * DM + col0 + bj * HALF + 4 * n) + *(const f32x4*)(b_ada + 2 * DM + col0 + bj * HALF + 4 * n);
#pragma unroll
        for (int ai = 0; ai < 2; ++ai)
#pragma unroll
            for (int m = 0; m < 4; ++m) { const size_t off = (size_t)(wr * 64 + fr + ai * HALF + m * 16) * DM + col0;
#pragma unroll
                for (int bj = 0; bj < 2; ++bj)
#pragma unroll
                    for (int n = 0; n < 2; ++n) { const f32x4 xv = *(const f32x4*)(xbase + off + bj * HALF + 4 * n);
                        *(f32x4*)(obase + off + bj * HALF + 4 * n) = xv + g[bj][n] * acc[ai][bj][m][n]; } }
    }
};
}

namespace att {
constexpr int NW = 8, QBLK = 32, KVBLK = 64;
constexpr int SHM_V = 8192, SHM_KN = 8192, SHM_KR = 4096;
constexpr int OFF_V = 0, OFF_KN = 2 * SHM_V, OFF_KR = OFF_KN + 2 * SHM_KN, OFF_WS = OFF_KR + 2 * SHM_KR, LDS_BYTES = OFF_WS + NW * 64 * 4;
constexpr float THR2 = 8.0f;
#define SBAR() __builtin_amdgcn_sched_barrier(0)
__device__ __forceinline__ int crow(int r, int hi) { return (r & 3) + 8 * (r >> 2) + 4 * hi; }
__device__ __forceinline__ int v_st(int k, int c) { const int kk = (k & ~0xC) | ((k & 4) << 1) | ((k & 8) >> 1); return ((kk >> 3) * 2 + (c >> 5)) * 512 + ((kk & 7) * 32 + (c & 31)) * 2; }
__device__ __forceinline__ int v_rd_base(int lane) { return ((lane & 3) << 3) | (((lane >> 2) & 3) << 6) | (((lane >> 4) & 1) << 5) | (((lane >> 5) & 1) << 8); }
constexpr int v_rd_off(int d0, int ks, int half) { return d0 * 512 + ks * 2048 + half * 1024; }
template <int OFF> __device__ __forceinline__ s16x4 tr_read(int vb) { s16x4 r; asm volatile("ds_read_b64_tr_b16 %0, %1 offset:%2" : "=&v"(r) : "v"(vb), "i"(OFF) : "memory"); return r; }
template <int D0> __device__ __forceinline__ void pv_one(f32x16& od, int vb, bf16x8 pa0, bf16x8 pa1, bf16x8 pa2, bf16x8 pa3) {
    const s16x4 l0 = tr_read<v_rd_off(D0, 0, 0)>(vb), h0 = tr_read<v_rd_off(D0, 0, 1)>(vb), l1 = tr_read<v_rd_off(D0, 1, 0)>(vb), h1 = tr_read<v_rd_off(D0, 1, 1)>(vb);
    const s16x4 l2 = tr_read<v_rd_off(D0, 2, 0)>(vb), h2 = tr_read<v_rd_off(D0, 2, 1)>(vb), l3 = tr_read<v_rd_off(D0, 3, 0)>(vb), h3 = tr_read<v_rd_off(D0, 3, 1)>(vb);
    asm volatile("s_waitcnt lgkmcnt(0)" ::: "memory"); SBAR();
#define PK(L, H) (bf16x8){L[0], L[1], L[2], L[3], H[0], H[1], H[2], H[3]}
    od = __builtin_amdgcn_mfma_f32_32x32x16_bf16(pa0, PK(l0, h0), od, 0, 0, 0);
    od = __builtin_amdgcn_mfma_f32_32x32x16_bf16(pa1, PK(l1, h1), od, 0, 0, 0);
    od = __builtin_amdgcn_mfma_f32_32x32x16_bf16(pa2, PK(l2, h2), od, 0, 0, 0);
    od = __builtin_amdgcn_mfma_f32_32x32x16_bf16(pa3, PK(l3, h3), od, 0, 0, 0);
#undef PK
}
__device__ __forceinline__ void pv_d0(f32x16* o, int vb, bf16x8 pa0, bf16x8 pa1, bf16x8 pa2, bf16x8 pa3) { pv_one<0>(o[0], vb, pa0, pa1, pa2, pa3); pv_one<1>(o[1], vb, pa0, pa1, pa2, pa3); }

template <int DQK> __device__ __forceinline__ void qkt(f32x16& p0, f32x16& p1, const char* Kn_s, const char* Kr_s, const bf16x8* qr, int r32, int hi) {
    p0 = f32x16{}; p1 = f32x16{};
    const int keyn = (r32 >> 1) & 7, keyr = (r32 >> 2) & 3;
#pragma unroll
    for (int d0 = 0; d0 < 4; ++d0) { const int off = r32 * 128 + (((2 * d0 + hi) ^ keyn) << 4);
        const bf16x8 b0 = *reinterpret_cast<const bf16x8*>(Kn_s + off), b1 = *reinterpret_cast<const bf16x8*>(Kn_s + off + 32 * 128);
        p0 = __builtin_amdgcn_mfma_f32_32x32x16_bf16(b0, qr[d0], p0, 0, 0, 0);
        p1 = __builtin_amdgcn_mfma_f32_32x32x16_bf16(b1, qr[d0], p1, 0, 0, 0); }
    if constexpr (DQK == 96) {
#pragma unroll
        for (int d0 = 0; d0 < 2; ++d0) { const int off = r32 * 64 + (((2 * d0 + hi) ^ keyr) << 4);
            const bf16x8 b0 = *reinterpret_cast<const bf16x8*>(Kr_s + off), b1 = *reinterpret_cast<const bf16x8*>(Kr_s + off + 32 * 64);
            p0 = __builtin_amdgcn_mfma_f32_32x32x16_bf16(b0, qr[4 + d0], p0, 0, 0, 0);
            p1 = __builtin_amdgcn_mfma_f32_32x32x16_bf16(b1, qr[4 + d0], p1, 0, 0, 0); }
    }
}
template <bool WIN> __device__ __forceinline__ void partialSM(f32x16& p0, f32x16& p1, float& m_reg, float& alpha, int drel, float slope2, int hi) {
    if constexpr (WIN) {
#pragma unroll
        for (int r = 0; r < 16; ++r) { const int d0_ = drel + crow(r, hi), d1_ = d0_ + 32; const float a0 = fabsf((float)d0_), a1 = fabsf((float)d1_);
            p0[r] = (a0 <= 128.f) ? p0[r] - slope2 * a0 : -1e30f; p1[r] = (a1 <= 128.f) ? p1[r] - slope2 * a1 : -1e30f; }
    }
    float pmax = p0[0];
#pragma unroll
    for (int r = 1; r < 16; ++r) pmax = fmaxf(pmax, p0[r]);
#pragma unroll
    for (int r = 0; r < 16; ++r) pmax = fmaxf(pmax, p1[r]);
    { auto rr = __builtin_amdgcn_permlane32_swap(__float_as_uint(pmax), __float_as_uint(pmax), false, false); pmax = fmaxf(__uint_as_float(rr[0]), __uint_as_float(rr[1])); }
    float mn;
    if (__builtin_expect(__all(pmax - m_reg <= THR2), 1)) { mn = m_reg; alpha = 1.f; }
    else { mn = fmaxf(m_reg, pmax); alpha = __builtin_amdgcn_exp2f(m_reg - mn); m_reg = mn; }
#pragma unroll
    for (int r = 0; r < 16; ++r) { p0[r] = p0[r] - mn; p1[r] = p1[r] - mn; }
#pragma unroll
    for (int r = 0; r < 16; ++r) p0[r] = __builtin_amdgcn_exp2f(p0[r]);
}
__device__ __forceinline__ void finishSM(f32x16& p0, f32x16& p1, float alpha, float& l_reg, bf16x8& pa0, bf16x8& pa1, bf16x8& pa2, bf16x8& pa3) {
#pragma unroll
    for (int r = 0; r < 16; ++r) p1[r] = __builtin_amdgcn_exp2f(p1[r]);
    float ps = 0;
#pragma unroll
    for (int r = 0; r < 16; ++r) ps += p0[r];
#pragma unroll
    for (int r = 0; r < 16; ++r) ps += p1[r];
    { auto rr = __builtin_amdgcn_permlane32_swap(__float_as_uint(ps), __float_as_uint(ps), false, false); ps = __uint_as_float(rr[0]) + __uint_as_float(rr[1]); }
    l_reg = l_reg * alpha + ps;
#define PK4(P, BASE, OUT) do { unsigned a0 = cvt_pk_bf16(P[BASE + 0], P[BASE + 1]), a1 = cvt_pk_bf16(P[BASE + 2], P[BASE + 3]);   \
    unsigned b0 = cvt_pk_bf16(P[BASE + 4], P[BASE + 5]), b1 = cvt_pk_bf16(P[BASE + 6], P[BASE + 7]);                              \
    auto r0 = __builtin_amdgcn_permlane32_swap(a0, b0, false, false); auto r1 = __builtin_amdgcn_permlane32_swap(a1, b1, false, false); \
    u32x4 w = {r0[0], r1[0], r0[1], r1[1]}; OUT = *reinterpret_cast<bf16x8*>(&w); } while (0)
    PK4(p0, 0, pa0); PK4(p0, 8, pa1); PK4(p1, 0, pa2); PK4(p1, 8, pa3);
#undef PK4
}

template <int DQK, bool WIN>
__device__ __forceinline__ void attn_unit(const bf16_t* __restrict__ Qb, int ldq, const bf16_t* __restrict__ Kn, int ldk, const bf16_t* __restrict__ Kr,
                                          const bf16_t* __restrict__ Vh, int ldv, const bf16_t* __restrict__ Zb, int ldz, bf16_t* __restrict__ Ob, int ldo,
                                          int t0, int NT, int qpos0, float slope2, float sink2, char* lds) {
    constexpr int ND0 = DQK / 16;
    const int tid = threadIdx.x, wid = __builtin_amdgcn_readfirstlane(tid >> 6), lane = tid & 63, r32 = lane & 31, hi = lane >> 5;
    char* V_lds = lds + OFF_V; char* Kn_lds = lds + OFF_KN; char* Kr_lds = lds + OFF_KR;
    float* ws = (float*)(lds + OFF_WS) + wid * 64; float* li_l = ws; float* al_l = ws + 32;
    float m_reg = WIN ? sink2 : -1e30f, l_reg = WIN ? 1.f : 0.f; f32x16 o[2] = {}; bf16x8 qr[ND0];
    const bf16_t* Qw = Qb + (size_t)(wid * QBLK + r32) * ldq + hi * 8;
#pragma unroll
    for (int d0 = 0; d0 < ND0; ++d0) qr[d0] = *reinterpret_cast<const bf16x8*>(Qw + d0 * 16);
    const int sr = tid >> 3, sc = (tid & 7) * 8;
    const int vst = v_st(sr, sc), knst = sr * 128 + (((tid & 7) ^ ((sr >> 1) & 7)) << 4);
    const int rr_ = (tid >> 2) & 63, rc_ = tid & 3, krst = rr_ * 64 + ((rc_ ^ ((rr_ >> 2) & 3)) << 4);
    const bool do_kr = (DQK == 96) && (wid < 4);
    const int vb0 = (int)(uintptr_t)V_lds + v_rd_base(lane);
    const int qposl = qpos0 + wid * QBLK + r32;
    struct { bf16x8 vs, ks, rs; } st_[2];
    const bf16_t* Vp = Vh + (size_t)t0 * KVBLK * ldv + (size_t)sr * ldv + sc;
    const bf16_t* Kp = Kn + (size_t)t0 * KVBLK * ldk + (size_t)sr * ldk + sc;
    const bf16_t* Rp = Kr + (size_t)t0 * KVBLK * 32 + (size_t)rr_ * 32 + rc_ * 8;
#define SLOAD(i, t) do { st_[i].vs = *reinterpret_cast<const bf16x8*>(Vp + (size_t)(t) * KVBLK * ldv); st_[i].ks = *reinterpret_cast<const bf16x8*>(Kp + (size_t)(t) * KVBLK * ldk); \
        if (do_kr) st_[i].rs = *reinterpret_cast<const bf16x8*>(Rp + (size_t)(t) * KVBLK * 32); } while (0)
#define SWRITE(b, i) do { *(bf16x8*)(V_lds + (b) * SHM_V + vst) = st_[i].vs; *(bf16x8*)(Kn_lds + (b) * SHM_KN + knst) = st_[i].ks; \
        if (do_kr) *(bf16x8*)(Kr_lds + (b) * SHM_KR + krst) = st_[i].rs; } while (0)
#define SWAIT() do { if (do_kr) asm volatile("s_waitcnt vmcnt(3)" ::: "memory"); else asm volatile("s_waitcnt vmcnt(2)" ::: "memory"); } while (0)
#define RESC(a) do { if (__any((a) < 1.f)) { if (hi == 0) al_l[r32] = (a); asm volatile("s_waitcnt lgkmcnt(0)" ::: "memory"); \
        _Pragma("unroll") for (int d = 0; d < 2; ++d) _Pragma("unroll") for (int r = 0; r < 16; ++r) o[d][r] *= al_l[crow(r, hi)]; } } while (0)
#define DREL(t) ((t0 + (t)) * KVBLK - qposl)
    f32x16 pA0, pA1, pB0, pB1; float alA, alB; bf16x8 pa0, pa1, pa2, pa3;
    SLOAD(0, 0); asm volatile("s_waitcnt vmcnt(0)" ::: "memory"); SWRITE(0, 0); __syncthreads();
    qkt<DQK>(pA0, pA1, Kn_lds, Kr_lds, qr, r32, hi); partialSM<WIN>(pA0, pA1, m_reg, alA, DREL(0), slope2, hi);
    SLOAD(1, 1); if (2 < NT) SLOAD(0, 2);
    SWAIT(); SWRITE(1, 1); __syncthreads();
    for (int j = 1; j + 1 < NT; j += 2) {
        SBAR(); qkt<DQK>(pB0, pB1, Kn_lds + SHM_KN, Kr_lds + SHM_KR, qr, r32, hi);
        finishSM(pA0, pA1, alA, l_reg, pa0, pa1, pa2, pa3); SBAR();
        SLOAD(1, j + 2); SBAR();
        pv_d0(o, vb0, pa0, pa1, pa2, pa3); partialSM<WIN>(pB0, pB1, m_reg, alB, DREL(j), slope2, hi);
        __syncthreads(); SWAIT(); SWRITE(0, 0);
        RESC(alB); __syncthreads();
        SBAR(); qkt<DQK>(pA0, pA1, Kn_lds, Kr_lds, qr, r32, hi);
        finishSM(pB0, pB1, alB, l_reg, pa0, pa1, pa2, pa3); SBAR();
        if (j + 3 < NT) SLOAD(0, j + 3); SBAR();
        pv_d0(o, vb0 + SHM_V, pa0, pa1, pa2, pa3); partialSM<WIN>(pA0, pA1, m_reg, alA, DREL(j + 1), slope2, hi);
        __syncthreads(); SWAIT(); SWRITE(1, 1);
        RESC(alA); __syncthreads();
    }
    SBAR(); qkt<DQK>(pB0, pB1, Kn_lds + SHM_KN, Kr_lds + SHM_KR, qr, r32, hi);
    finishSM(pA0, pA1, alA, l_reg, pa0, pa1, pa2, pa3); SBAR();
    pv_d0(o, vb0, pa0, pa1, pa2, pa3); partialSM<WIN>(pB0, pB1, m_reg, alB, DREL(NT - 1), slope2, hi);
    __syncthreads(); RESC(alB);
    finishSM(pB0, pB1, alB, l_reg, pa0, pa1, pa2, pa3); SBAR();
    pv_d0(o, vb0 + SHM_V, pa0, pa1, pa2, pa3);
    if (hi == 0) li_l[r32] = l_reg; asm volatile("s_waitcnt lgkmcnt(0)" ::: "memory");
#pragma unroll
    for (int r = 0; r < 16; ++r) { const int orow = wid * QBLK + crow(r, hi); const float rl = __builtin_amdgcn_rcpf(li_l[crow(r, hi)]);
#pragma unroll
        for (int d0 = 0; d0 < 2; ++d0) { const float z = __uint_as_float((unsigned)Zb[(size_t)orow * ldz + d0 * 32 + r32] << 16);
            const unsigned w = cvt_pk_bf16(o[d0][r] * rl * z, 0.f); Ob[(size_t)orow * ldo + d0 * 32 + r32] = (bf16_t)(w & 0xffffu); } }
    __syncthreads();
#undef SLOAD
#undef SWRITE
#undef SWAIT
#undef RESC
#undef DREL
}
#undef SBAR
}

constexpr int NWAVES = 8;
constexpr int LDS_BYTES = 147456;
static_assert(pg8::STAGE_BYTES <= 131072 && att::LDS_BYTES <= 131072, "LDS map");

struct Params { const float* in[17]; float* out; unsigned char* ws; int ph_lo, ph_hi; };

__device__ const double ROPE_INV[16] = {1.0, 0.5623413251903491, 0.31622776601683794, 0.1778279410038923, 0.1, 0.05623413251903491, 0.03162277660168379, 0.01778279410038923,
                                        0.01, 0.005623413251903491, 0.0031622776601683794, 0.0017782794100389228, 0.001, 0.0005623413251903491, 0.00031622776601683794, 0.00017782794100389227};

__device__ __forceinline__ unsigned f2bf(float f) { unsigned u = __builtin_bit_cast(unsigned, f); return (u + 0x7fffu + ((u >> 16) & 1u)) >> 16; }
__device__ __forceinline__ unsigned pk2(float lo, float hi) { return f2bf(lo) | (f2bf(hi) << 16); }

__device__ __forceinline__ int wsrc_col(int kind, int n, float& cs) {
    cs = 1.f;
    if (kind == 0) {
        if (n < 1280) { if (n < 512) cs = QA_SCALE; return n; }
        if (n < 1792) return n - 1280 + 1952;
        if (n < 2432) return n - 1792 + 1280;
        if (n < 2464) { const int j = n - 2432; return 1920 + (j >> 1) + 16 * (j & 1); }
        if (n < 2560) return -1;
        return n - 2560 + 2464;
    } else if (kind == 1) {
        cs = QB_SCALE; const int h = n / 96, d = n % 96;
        if (d < 64) return h * 96 + d;
        const int j = d - 64; return h * 96 + 64 + (j >> 1) + 16 * (j & 1);
    } else if (kind == 2) {
        if (n < 512) return (n >> 6) * 128 + (n & 63);
        const int q = n - 512; return (q >> 6) * 128 + 64 + (q & 63);
    }
    return n;
}
__device__ __forceinline__ void transpose_item(const float* W, int K, int Nsrc, int Ndst, int kind, const float* kgain, bf16_t* WT, LAS float* scr, int item, int lane) {
    const int nblk = Ndst / 32, kb = item / nblk, nb = item % nblk, k0 = 64 * kb, n0 = 32 * nb;
    float cs; const int src = wsrc_col(kind, n0 + (lane & 31), cs);
#pragma unroll 8
    for (int i = 0; i < 32; ++i) { const int kk = 2 * i + (lane >> 5); float v = 0.f;
        if (src >= 0) { v = W[(size_t)(k0 + kk) * Nsrc + src] * cs; if (kgain) v *= kgain[k0 + kk]; }
        scr[kk * 33 + (lane & 31)] = v; }
    asm volatile("s_waitcnt lgkmcnt(0)" ::: "memory");
    const int c = lane & 7;
#pragma unroll
    for (int j = 0; j < 4; ++j) { const int n = (lane >> 3) + 8 * j; const LAS float* s = scr + (8 * c) * 33 + n;
        u32x4 o; o.x = pk2(s[0 * 33], s[1 * 33]); o.y = pk2(s[2 * 33], s[3 * 33]); o.z = pk2(s[4 * 33], s[5 * 33]); o.w = pk2(s[6 * 33], s[7 * 33]);
        *(u32x4*)(WT + (size_t)(n0 + n) * K + k0 + 8 * c) = o; }
    asm volatile("s_waitcnt lgkmcnt(0)" ::: "memory");
}

__global__ void __launch_bounds__(NWAVES * 64, 2) mk_fwd(Params p) {
    extern __shared__ __attribute__((aligned(16))) unsigned char lds[];
    cg::grid_group grid = cg::this_grid();
    const int tid = threadIdx.x, lane = tid & 63, wave = __builtin_amdgcn_readfirstlane(tid >> 6);
    const int G = gridDim.x, bx = blockIdx.x;
    const int vcu = (G % 8 == 0) ? (bx % 8) * (G / 8) + bx / 8 : bx;
    const int gw = vcu * NWAVES + wave, NGW = G * NWAVES;
    unsigned char* ws = p.ws;
    const float *x_p = p.in[0], *x_s = p.in[1], *c_p = p.in[2], *c_s = p.in[3], *w_ada = p.in[4], *b_ada = p.in[5], *g_norm = p.in[6], *w_in = p.in[7], *g_q = p.in[8], *w_uq = p.in[9],
                *g_kv = p.in[10], *w_ukv = p.in[11], *sink = p.in[12], *w_oa = p.in[13], *w_ob = p.in[14], *w_out = p.in[15], *g_final = p.in[16];
    float* mod = (float*)(ws + WS_MOD); f32x2* rope = (f32x2*)(ws + WS_ROPE);
    bf16_t *Win_t = (bf16_t*)(ws + WS_WIN), *Wuq_t = (bf16_t*)(ws + WS_WUQ), *Wukv_t = (bf16_t*)(ws + WS_WUKV), *Woa_t = (bf16_t*)(ws + WS_WOA), *Wob_t = (bf16_t*)(ws + WS_WOB), *Wout_t = (bf16_t*)(ws + WS_WOUT);
    float *RSQ = (float*)(ws + WS_RSQ), *RSKV = (float*)(ws + WS_RSKV);
    bf16_t *HB = (bf16_t*)(ws + WS_R1), *YA = (bf16_t*)(ws + WS_R1), *YB = (bf16_t*)(ws + WS_R1 + 48 * MiB);
    bf16_t *PA = (bf16_t*)(ws + WS_R2), *QB = (bf16_t*)(ws + WS_R2);
    bf16_t *PZ = (bf16_t*)(ws + WS_R3), *TM = (bf16_t*)(ws + WS_R3);
    bf16_t *PC = (bf16_t*)(ws + WS_R4), *KN = (bf16_t*)(ws + WS_KN), *VB = (bf16_t*)(ws + WS_VB), *KR = (bf16_t*)(ws + WS_KR);
    bf16_t* PG = (bf16_t*)p.out;
    const int lo = p.ph_lo, hi = p.ph_hi;
#ifndef PH_MASK
#define PH_MASK 0x3ff
#endif
#define IN(k) (((PH_MASK >> (k)) & 1) && lo <= (k) && (k) < hi)
#define SEAM(k) do { if (IN(k) && IN((k) + 1)) grid.sync(); } while (0)

    if (IN(0)) {
        LAS float* scr = (LAS float*)((LAS unsigned char*)lds + wave * 16384);
        constexpr int I_IN = (DM / 64) * (N_IN / 32), I_UQ = (384 / 64) * (768 / 32), I_UKV = (256 / 64) * (1024 / 32), I_OA = (512 / 64) * (1024 / 32), I_OUT = (1024 / 64) * (1024 / 32);
        constexpr int NITEMS = I_IN + I_UQ + I_UKV + 2 * I_OA + I_OUT;
        for (int it = gw; it < NITEMS; it += NGW) {
            int r = it;
            if (r < I_IN) { transpose_item(w_in, DM, D_IN, N_IN, 0, nullptr, Win_t, scr, r, lane); continue; } r -= I_IN;
            if (r < I_UQ) { transpose_item(w_uq, 384, 768, 768, 1, g_q, Wuq_t, scr, r, lane); continue; } r -= I_UQ;
            if (r < I_UKV) { transpose_item(w_ukv, 256, 1024, 1024, 2, g_kv, Wukv_t, scr, r, lane); continue; } r -= I_UKV;
            if (r < I_OA) { transpose_item(w_oa, 512, 1024, 1024, 3, nullptr, Woa_t, scr, r, lane); continue; } r -= I_OA;
            if (r < I_OA) { transpose_item(w_ob, 512, 1024, 1024, 3, nullptr, Wob_t, scr, r, lane); continue; } r -= I_OA;
            transpose_item(w_out, 1024, 1024, 1024, 3, nullptr, Wout_t, scr, r, lane);
        }
        for (int it = gw; it < 16 * 48; it += NGW) { const int ks = it / 48, cgp = it % 48, col = cgp * 64 + lane; float a[NBATCH];
#pragma unroll
            for (int b = 0; b < NBATCH; ++b) a[b] = 0.f;
            for (int k = ks * 64; k < ks * 64 + 64; ++k) { const float w = w_ada[(size_t)k * 3 * DM + col];
#pragma unroll
                for (int b = 0; b < NBATCH; ++b) { const float c = (b < NB_P) ? c_p[b * DM + k] : c_s[(b - NB_P) * DM + k]; a[b] += c * sigmoidf_fast(c) * w; } }
#pragma unroll
            for (int b = 0; b < NBATCH; ++b) atomicAdd(mod + b * 3 * DM + col, a[b]);
        }
        for (int e = gw * 64 + lane; e < S_S * 16; e += NGW * 64) { const int pos = e >> 4, i = e & 15;
            const double ang = (double)pos * ROPE_INV[i]; const double n = rint(ang * 0.6366197723675814);
            const double r = (ang - n * 1.5707963267948966) - n * 6.123233995736766e-17; const double r2 = r * r;
            const double sn = r * (1.0 + r2 * (-1.0 / 6 + r2 * (1.0 / 120 + r2 * (-1.0 / 5040 + r2 * (1.0 / 362880 + r2 * (-1.0 / 39916800 + r2 * (1.0 / 6227020800.0)))))));
            const double cn = 1.0 + r2 * (-0.5 + r2 * (1.0 / 24 + r2 * (-1.0 / 720 + r2 * (1.0 / 40320 + r2 * (-1.0 / 3628800 + r2 * (1.0 / 479001600.0))))));
            const int q = (int)((long long)n & 3); double cs_, sn_;
            if (q == 0) { cs_ = cn; sn_ = sn; } else if (q == 1) { cs_ = -sn; sn_ = cn; } else if (q == 2) { cs_ = -cn; sn_ = -sn; } else { cs_ = sn; sn_ = -cn; }
            rope[e] = (f32x2){(float)cs_, (float)sn_}; }
    }
    SEAM(0);
    if (IN(1)) {
        constexpr int RPW = 24;
        for (int base = gw * RPW; base < M; base += NGW * RPW) {
            int cb = -1; f32x4 ga[4], sh[4];
            for (int row = base; row < base + RPW && row < M; ++row) {
                const int b = batch_of_row(row);
                if (b != cb) { cb = b;
#pragma unroll
                    for (int j = 0; j < 4; ++j) { const int c = 4 * lane + 256 * j;
                        const f32x4 sc = *(const f32x4*)(mod + b * 3 * DM + DM + c) + *(const f32x4*)(b_ada + DM + c);
                        sh[j] = *(const f32x4*)(mod + b * 3 * DM + c) + *(const f32x4*)(b_ada + c);
                        ga[j] = *(const f32x4*)(g_norm + c) * (sc + 1.0f); } }
                const float* xr = row < M_P ? x_p + (size_t)row * DM : x_s + (size_t)(row - M_P) * DM;
                f32x4 v[4]; float s = 0.f;
#pragma unroll
                for (int j = 0; j < 4; ++j) { v[j] = *(const f32x4*)(xr + 4 * lane + 256 * j); s += (v[j].x * v[j].x + v[j].y * v[j].y) + (v[j].z * v[j].z + v[j].w * v[j].w); }
                const float rstd = 1.0f / sqrtf(wave_sum(s) * (1.f / DM) + EPS);
#pragma unroll
                for (int j = 0; j < 4; ++j) { const f32x4 h = v[j] * rstd * ga[j] + sh[j]; u32x2 w; w.x = cvt_pk_bf16(h.x, h.y); w.y = cvt_pk_bf16(h.z, h.w);
                    *(u32x2*)(HB + (size_t)row * DM + 4 * lane + 256 * j) = w; }
            }
        }
    }
    SEAM(1);
    if (IN(2)) {
        pg8::Gemm g{HB, Win_t, M, N_IN, DM, DM}; pg8::StaticOrder S; S.init(M, N_IN, G, bx);
        pg8::EpiProj E{PA, PZ, PC, PG};
        pg8::gemm_phase<pg8::EpiProj, 1024, 1024>((LAS unsigned char*)lds, g, S, E);
    }
    SEAM(2);
    if (IN(3)) {
        for (int row = gw; row < M; row += NGW) {
            const bf16_t* pr = PC + (size_t)row * 768;
            const u32x4 a = *(const u32x4*)(pr + lane * 8); u32x4 b = (u32x4){0u, 0u, 0u, 0u};
            if (lane < 20) b = *(const u32x4*)(pr + 512 + lane * 8);
            float sa = 0.f, sb = 0.f;
#pragma unroll
            for (int e = 0; e < 4; ++e) { const float l0 = bf_lo(a[e]), h0 = bf_hi(a[e]); sa += l0 * l0 + h0 * h0; }
            if (lane < 16) {
#pragma unroll
                for (int e = 0; e < 4; ++e) { const float l0 = bf_lo(b[e]), h0 = bf_hi(b[e]); sb += l0 * l0 + h0 * h0; } }
            float sq = (lane < 48) ? sa : 0.f, skv = (lane < 48) ? 0.f : sa; skv += sb;
            sq = wave_sum(sq); skv = wave_sum(skv);
            if (lane == 0) { RSQ[row] = 1.0f / sqrtf(sq * (1.f / 384.f) + EPS); RSKV[row] = 1.0f / sqrtf(skv * (1.f / 256.f) + EPS); }
            if (lane >= 16 && lane < 20) { const int i0 = (lane - 16) * 4; const f32x4* tp = (const f32x4*)(rope + (size_t)pos_of_row(row) * 16 + i0); const f32x4 c0 = tp[0], c1 = tp[1];
                const float x0 = bf_lo(b.x), y0 = bf_hi(b.x), x1 = bf_lo(b.y), y1 = bf_hi(b.y), x2 = bf_lo(b.z), y2 = bf_hi(b.z), x3 = bf_lo(b.w), y3 = bf_hi(b.w);
                u32x4 w; w.x = cvt_pk_bf16(x0 * c0[0] - y0 * c0[1], x0 * c0[1] + y0 * c0[0]); w.y = cvt_pk_bf16(x1 * c0[2] - y1 * c0[3], x1 * c0[3] + y1 * c0[2]);
                w.z = cvt_pk_bf16(x2 * c1[0] - y2 * c1[1], x2 * c1[1] + y2 * c1[0]); w.w = cvt_pk_bf16(x3 * c1[2] - y3 * c1[3], x3 * c1[3] + y3 * c1[2]);
                *(u32x4*)(KR + (size_t)row * 32 + (lane - 16) * 8) = w; }
        }
        for (int U = vcu; U < (M / 256) * 8; U += G) { const int rb = U >> 3, h = U & 7, kvh = h >> 2; const int row0 = rb * 256;
            const int S = row0 < M_P ? S_P : S_S; const int qpos0 = pos_of_row(row0); const int seq0 = row0 - qpos0;
            const int ks = qpos0 - 128 < 0 ? 0 : qpos0 - 128, ke = qpos0 + 384 > S ? S : qpos0 + 384;
            const float slope2 = exp2f(-(float)(h + 1)) * LOG2E, sink2 = sink[h] * LOG2E;
            att::attn_unit<64, true>(PA + (size_t)row0 * 768 + h * 64, 768, PA + (size_t)seq0 * 768 + 512 + kvh * 64, 768, nullptr, PA + (size_t)seq0 * 768 + 640 + kvh * 64, 768,
                                     PZ + (size_t)row0 * 1024 + h * 64, 1024, YA + (size_t)row0 * 512 + h * 64, 512, ks / 64, (ke - ks) / 64, qpos0, slope2, sink2, (char*)lds);
        }
    }
    SEAM(3);
    if (IN(4)) {
#ifndef NO_Q
        { pg8::Gemm g{PC, Wuq_t, M, 768, 384, 768}; pg8::StaticOrder S; S.init(M, 768, G, bx); pg8::EpiQ E{QB, RSQ, rope};
          pg8::gemm_phase<pg8::EpiQ, 384, 768>((LAS unsigned char*)lds, g, S, E); }
#endif
#ifndef NO_KV
        { pg8::Gemm g{PC + 384, Wukv_t, M, 1024, 256, 768}; pg8::StaticOrder S; S.init(M, 1024, G, bx); pg8::EpiKV E{KN, VB, RSKV};
          pg8::gemm_phase<pg8::EpiKV, 256, 768>((LAS unsigned char*)lds, g, S, E); }
#endif
    }
    SEAM(4);
    if (IN(5)) {
        for (int U = vcu; U < 1536; U += G) {
            int row0, seq0, S, h;
            if (U < 1024) { const int i = U >> 8, v = U & 255, xcd = v >> 5, c = v & 31; const int bh = 2 * xcd + (i >> 1), qb = (i & 1) * 32 + c; const int b = bh >> 3; h = bh & 7;
                S = S_S; seq0 = M_P + b * S_S; row0 = seq0 + qb * 256; }
            else { const int U2 = U - 1024; const int j = U2 >> 8, v = U2 & 255, xcd = v >> 5, c = v & 31; const int bh = 4 * xcd + 2 * j + (c >> 4), qb = c & 15; const int b = bh >> 3; h = bh & 7;
                S = S_P; seq0 = b * S_P; row0 = seq0 + qb * 256; }
            att::attn_unit<96, false>(QB + (size_t)row0 * 768 + h * 96, 768, KN + (size_t)seq0 * 512 + h * 64, 512, KR + (size_t)seq0 * 32, VB + (size_t)seq0 * 512 + h * 64, 512,
                                      PZ + (size_t)row0 * 1024 + 512 + h * 64, 1024, YB + (size_t)row0 * 512 + h * 64, 512, 0, S / 64, 0, 0.f, 0.f, (char*)lds);
        }
    }
    SEAM(5);
    if (IN(6)) { pg8::Gemm g{YA, Woa_t, M, 1024, 512, 512}; pg8::StaticOrder S; S.init(M, 1024, G, bx); pg8::EpiGate<true> E{TM, PG, 0};
        pg8::gemm_phase<pg8::EpiGate<true>, 512, 512>((LAS unsigned char*)lds, g, S, E); }
    SEAM(6);
    if (IN(7)) { pg8::Gemm g{YB, Wob_t, M, 1024, 512, 512}; pg8::StaticOrder S; S.init(M, 1024, G, bx); pg8::EpiGate<false> E{TM, PG, 1024};
        pg8::gemm_phase<pg8::EpiGate<false>, 512, 512>((LAS unsigned char*)lds, g, S, E); }
    SEAM(7);
    if (IN(8)) { pg8::Gemm g{TM, Wout_t, M, 1024, 1024, 1024}; pg8::StaticOrder S; S.init(M, 1024, G, bx); pg8::EpiOut E{x_p, x_s, p.out, mod, b_ada};
        pg8::gemm_phase<pg8::EpiOut, 1024, 1024>((LAS unsigned char*)lds, g, S, E); }
    SEAM(8);
    if (IN(9)) {
        f32x4 gf[4];
#pragma unroll
        for (int j = 0; j < 4; ++j) gf[j] = *(const f32x4*)(g_final + 4 * lane + 256 * j);
        for (int row = gw; row < M; row += NGW) { float* orow = p.out + (size_t)row * DM; f32x4 v[4]; float s = 0.f;
#pragma unroll
            for (int j = 0; j < 4; ++j) { v[j] = *(const f32x4*)(orow + 4 * lane + 256 * j); s += (v[j].x * v[j].x + v[j].y * v[j].y) + (v[j].z * v[j].z + v[j].w * v[j].w); }
            const float rstd = 1.0f / sqrtf(wave_sum(s) * (1.f / DM) + EPS);
#pragma unroll
            for (int j = 0; j < 4; ++j) *(f32x4*)(orow + 4 * lane + 256 * j) = v[j] * rstd * gf[j];
        }
    }
#undef IN
#undef SEAM
}

extern "C" void kernel_launch(void* const* d_in, const int* in_sizes, int n_in, void* d_out, int out_size, void* d_ws, size_t ws_size, hipStream_t stream) {
    static int grid = 0;
    if (grid == 0) {
        if (n_in != 17 || out_size != M * DM || ws_size < WS_END) { fprintf(stderr, "kernel_launch: unexpected shapes: n_in %d out %d ws %zu (need %zu)\n", n_in, out_size, ws_size, (size_t)WS_END); grid = -1; return; }
        int dev = 0, cus = 0, per_cu = 0;
        hipGetDevice(&dev); hipDeviceGetAttribute(&cus, hipDeviceAttributeMultiprocessorCount, dev);
        if (hipFuncSetAttribute((const void*)mk_fwd, hipFuncAttributeMaxDynamicSharedMemorySize, LDS_BYTES) != hipSuccess) { fprintf(stderr, "kernel_launch: hipFuncSetAttribute failed\n"); grid = -1; return; }
        if (hipOccupancyMaxActiveBlocksPerMultiprocessor(&per_cu, (const void*)mk_fwd, NWAVES * 64, LDS_BYTES) != hipSuccess || per_cu < 1) { fprintf(stderr, "kernel_launch: occupancy query says %d\n", per_cu); per_cu = 1; }
        (void)hipGetLastError();
        grid = cus;
    }
    if (grid < 0) return;
    hipMemsetAsync((char*)d_ws + WS_MOD, 0, MOD_BYTES, stream);
    Params p{};
    for (int i = 0; i < 17; ++i) p.in[i] = (const float*)d_in[i];
    p.out = (float*)d_out; p.ws = (unsigned char*)d_ws;
#if MK_N_LAUNCHES == 1
    p.ph_lo = 0; p.ph_hi = 10;
    void* args[] = {&p};
    hipError_t e = hipLaunchCooperativeKernel((const void*)mk_fwd, dim3(grid), dim3(NWAVES * 64), args, LDS_BYTES, stream);
    if (e != hipSuccess) fprintf(stderr, "cooperative launch failed: %s (grid %d)\n", hipGetErrorString(e), grid);
#else
    for (int ph = 0; ph < 10; ++ph) { p.ph_lo = ph; p.ph_hi = ph + 1; hipLaunchKernelGGL(mk_fwd, dim3(grid), dim3(NWAVES * 64), LDS_BYTES, stream, p); }
#endif
}
```

```cpp
#include <hip/hip_runtime.h>
#include <hip/hip_cooperative_groups.h>
#include <cstdio>
#include <cstdint>
namespace cg = cooperative_groups;

#ifndef MK_N_LAUNCHES
#define MK_N_LAUNCHES 1
#endif

constexpr int DM = 1024;
constexpr int NB_P = 4, S_P = 4096, NB_S = 2, S_S = 16384;
constexpr int M_P = NB_P * S_P, M_S = NB_S * S_S, M = M_P + M_S;
constexpr int D_IN = 4512, N_IN = 4608;
constexpr int NBATCH = NB_P + NB_S;
constexpr float EPS = 1e-6f;
constexpr float LOG2E = 1.4426950408889634f;
constexpr float QA_SCALE = 0.125f * LOG2E;
constexpr float QB_SCALE = 0.10206207261596575f * LOG2E;

constexpr size_t MiB = 1u << 20;
constexpr size_t WS_MOD = 0;
constexpr size_t MOD_BYTES = (size_t)NBATCH * 3 * DM * 4;
constexpr size_t WS_KMAX = WS_MOD + MOD_BYTES;
constexpr size_t ZERO_BYTES = MOD_BYTES + 256;
constexpr size_t WS_ROPE = 128 * 1024;
constexpr size_t WS_WIN = WS_ROPE + 2 * MiB;
constexpr size_t WS_WUQ = WS_WIN + (size_t)N_IN * DM * 2;
constexpr size_t WS_WUKV = WS_WUQ + (size_t)768 * 384 * 2;
constexpr size_t WS_WOA = WS_WUKV + (size_t)1024 * 256 * 2;
constexpr size_t WS_WOB = WS_WOA + (size_t)1024 * 512 * 2;
constexpr size_t WS_WOUT = WS_WOB + (size_t)1024 * 512 * 2;
constexpr size_t WS_RSQ = WS_WOUT + (size_t)1024 * 1024 * 2;
constexpr size_t WS_RSKV = WS_RSQ + (size_t)M * 4;
static_assert(WS_RSKV + (size_t)M * 4 <= 20 * MiB, "small region");
constexpr size_t WS_R1 = 20 * MiB;
constexpr size_t WS_R2 = WS_R1 + 96 * MiB;
constexpr size_t WS_R3 = WS_R2 + 72 * MiB;
constexpr size_t WS_R4 = WS_R3 + 96 * MiB;
constexpr size_t WS_KN = WS_R4 + 72 * MiB;
constexpr size_t WS_VB = WS_KN + 48 * MiB;
constexpr size_t WS_KR = WS_VB + 48 * MiB;
constexpr size_t WS_END = WS_KR + 3 * MiB;

typedef unsigned short bf16_t;
typedef short bf16x8 __attribute__((ext_vector_type(8)));
typedef short s16x4 __attribute__((ext_vector_type(4)));
typedef float f32x4 __attribute__((ext_vector_type(4)));
typedef float f32x2 __attribute__((ext_vector_type(2)));
typedef float f32x16 __attribute__((ext_vector_type(16)));
typedef unsigned u32x4 __attribute__((ext_vector_type(4)));
typedef unsigned u32x2 __attribute__((ext_vector_type(2)));
#define LAS __attribute__((address_space(3)))

__device__ __forceinline__ unsigned cvt_pk_bf16(float lo, float hi) { unsigned r; asm volatile("v_cvt_pk_bf16_f32 %0, %1, %2" : "=v"(r) : "v"(lo), "v"(hi)); return r; }
__device__ __forceinline__ float bf_lo(unsigned w) { return __uint_as_float(w << 16); }
__device__ __forceinline__ float bf_hi(unsigned w) { return __uint_as_float(w & 0xffff0000u); }
__device__ __forceinline__ float sigmoidf_fast(float v) { return __builtin_amdgcn_rcpf(1.0f + __builtin_amdgcn_exp2f(-v * LOG2E)); }
__device__ __forceinline__ float wave_sum(float v) {
#pragma unroll
    for (int o = 1; o < 64; o <<= 1) v += __shfl_xor(v, o);
    return v;
}
__device__ __forceinline__ int batch_of_row(int row) { return row < M_P ? (row >> 12) : NB_P + ((row - M_P) >> 14); }
__device__ __forceinline__ int pos_of_row(int row) { return row < M_P ? (row & (S_P - 1)) : ((row - M_P) & (S_S - 1)); }

namespace pg8 {
constexpr int BM = 256, BK = 64, HALF = 128, HTB = HALF * BK * 2, STAGE_BYTES = 8 * HTB, NXCD = 8, WGM = 8;
__host__ __device__ __forceinline__ int lds_byte(int r, int c) { const int st = (r >> 4) * 2 + (c >> 5), rr = r & 15, cc = c & 31, ob = rr * 64 + cc * 2; return st * 1024 + (ob ^ (((ob >> 9) & 1) << 5)); }
__host__ __device__ __forceinline__ void stage_rc(int b, int& R, int& C) { const int st = b / 1024, sb = b % 1024, swz = sb ^ (((sb >> 9) & 1) << 5); R = (st >> 1) * 16 + swz / 64; C = (st & 1) * 32 + (swz % 64) / 2; }
__host__ __device__ __forceinline__ int perm32(int rho) { const int n = rho >> 4, i = rho & 15; return 8 * (i >> 2) + 4 * n + (i & 3); }

struct Unit { int pm, pn; };
struct Gemm { const bf16_t* A; const bf16_t* Bt; int M, N, K, lda; };

struct StaticOrder {
    int nM, nN, nwg, G, c;
    __device__ void init(int M_, int N_, int G_, int c_) { nM = M_ / BM; nN = N_ / BM; nwg = nM * nN; G = G_; c = c_; }
    __device__ bool next(int i, Unit& u) const {
        const long L = (long)i * G + c; if (L >= nwg) return false;
        int wgid = (int)L; { const int q = nwg / NXCD, r = nwg % NXCD, xcd = wgid % NXCD, off = wgid / NXCD; wgid = (xcd < r ? xcd * (q + 1) : r * (q + 1) + (xcd - r) * q) + off; }
        const int nig = WGM * nN, gid = wgid / nig, fm = gid * WGM, gsz = (nM - fm) < WGM ? (nM - fm) : WGM;
        u.pm = fm + ((wgid % nig) % gsz); u.pn = (wgid % nig) / gsz; return true;
    }
};

template <class Epi, int K, int LDA, bool ALIGN_EPI = true>
__device__ __forceinline__ void gemm_phase(LAS unsigned char* lds, const Gemm g, const StaticOrder& S, const Epi& E) {
    int tid = threadIdx.x; asm volatile("" : "+v"(tid));
    const int wid = __builtin_amdgcn_readfirstlane(tid >> 6), lane = tid & 63, wr = wid >> 2, wc = wid & 3, fr = lane & 15, fq = lane >> 4;
    constexpr int nt = K / BK, lda = LDA;
    unsigned voffA[2], voffB[2];
#pragma unroll
    for (int i = 0; i < 2; ++i) { int R, C; stage_rc(tid * 16 + i * 8192, R, C); const int Rb = (R & ~31) + perm32(R & 31);
        voffA[i] = (unsigned)(R * lda + C) * 2u; voffB[i] = (unsigned)(Rb * K + C) * 2u; }
    const size_t kstep = (size_t)(BK * 2);
    const size_t hstepA = (size_t)HALF * lda * 2, tstepA = 2 * hstepA;
    const size_t hstepB = (size_t)HALF * K * 2, tstepB = 2 * hstepB;
    const unsigned ldsw = (unsigned)wid * 1024u;
    const int aoff = lds_byte(wr * 64 + fr, fq * 8), boff = lds_byte(wc * 32 + fr, fq * 8);
#define PG8_SA(b, h) (((b) * 2 + (h)) * HTB)
#define PG8_SB(b, h) ((4 + (b) * 2 + (h)) * HTB)
#define PG8_STAGE(bufoff, gbase, voff) do { _Pragma("unroll") for (int _i = 0; _i < 2; ++_i) \
        __builtin_amdgcn_global_load_lds((const unsigned*)((const char*)(gbase) + (voff)[_i]), (LAS unsigned*)(lds + (bufoff) + ldsw + _i * 8192), 16, 0, 0); } while (0)
#define PG8_LDA(dst, b, h) do { _Pragma("unroll") for (int m = 0; m < 4; ++m) _Pragma("unroll") for (int k = 0; k < 2; ++k) dst[m][k] = *(const LAS bf16x8*)(lds + PG8_SA(b, h) + aoff + m * 2048 + k * 1024); } while (0)
#define PG8_LDB(dst, b, h) do { _Pragma("unroll") for (int n = 0; n < 2; ++n) _Pragma("unroll") for (int k = 0; k < 2; ++k) dst[n][k] = *(const LAS bf16x8*)(lds + PG8_SB(b, h) + boff + n * 2048 + k * 1024); } while (0)
#define PG8_MMA(ai, bj, At, Bt) do { __builtin_amdgcn_s_setprio(1); _Pragma("unroll") for (int m = 0; m < 4; ++m) _Pragma("unroll") for (int n = 0; n < 2; ++n) _Pragma("unroll") for (int k = 0; k < 2; ++k) \
        acc[ai][bj][m][n] = __builtin_amdgcn_mfma_f32_16x16x32_bf16(Bt[n][k], At[m][k], acc[ai][bj][m][n], 0, 0, 0); __builtin_amdgcn_s_setprio(0); } while (0)
#define PG8_WAIT_V(n) asm volatile("s_waitcnt vmcnt(" #n ")" ::: "memory")
#define PG8_WAIT_L(n) asm volatile("s_waitcnt lgkmcnt(" #n ")" ::: "memory")
#define PG8_BAR __builtin_amdgcn_s_barrier()
#define PG8_SCHED __builtin_amdgcn_sched_barrier(0)
    Unit cur, nxt; int ui = 0;
    if (!S.next(0, cur)) return;
    f32x4 acc[2][2][4][2];
#pragma unroll
    for (int a = 0; a < 2; ++a)
#pragma unroll
        for (int b = 0; b < 2; ++b)
#pragma unroll
            for (int m = 0; m < 4; ++m)
#pragma unroll
                for (int n = 0; n < 2; ++n) acc[a][b][m][n] = (f32x4){0.f, 0.f, 0.f, 0.f};
    bf16x8 At[4][2], B0[2][2], B1[2][2];
    const char* cA = (const char*)g.A + (size_t)cur.pm * tstepA; const char* cB = (const char*)g.Bt + (size_t)cur.pn * tstepB;
    PG8_STAGE(PG8_SB(0, 0), cB, voffB); PG8_STAGE(PG8_SB(0, 1), cB + hstepB, voffB); PG8_STAGE(PG8_SA(0, 0), cA, voffA); PG8_STAGE(PG8_SA(0, 1), cA + hstepA, voffA);
    if (wr == 1) PG8_BAR;
    PG8_WAIT_V(2); PG8_BAR;
    PG8_STAGE(PG8_SB(1, 0), cB + kstep, voffB); PG8_STAGE(PG8_SA(1, 0), cA + kstep, voffA); PG8_STAGE(PG8_SB(1, 1), cB + hstepB + kstep, voffB);
    PG8_WAIT_V(6); PG8_BAR;
    for (;;) {
        const bool has_next = S.next(ui + 1, nxt);
        const char* nA = has_next ? (const char*)g.A + (size_t)nxt.pm * tstepA : cA; const char* nB = has_next ? (const char*)g.Bt + (size_t)nxt.pn * tstepB : cB;
#pragma unroll 1
        for (int t = 0; t < nt; t += 2) {
            const bool last = (t == nt - 2);
            const char* a1 = cA + (size_t)(t + 1) * kstep;
            const char* a2 = last ? nA : cA + (size_t)(t + 2) * kstep; const char* b2 = last ? nB : cB + (size_t)(t + 2) * kstep;
            const char* a3 = a2 + kstep; const char* b3 = b2 + kstep;
            PG8_LDB(B0, 0, 0); PG8_LDB(B1, 0, 1); PG8_SCHED; PG8_LDA(At, 0, 0); PG8_STAGE(PG8_SA(1, 1), a1 + hstepA, voffA);
            PG8_WAIT_V(8); PG8_WAIT_L(0); PG8_BAR; PG8_MMA(0, 0, At, B0); PG8_MMA(0, 1, At, B1); PG8_BAR; PG8_SCHED;
            PG8_LDA(At, 0, 1); PG8_STAGE(PG8_SB(0, 0), b2, voffB); PG8_STAGE(PG8_SB(0, 1), b2 + hstepB, voffB); PG8_STAGE(PG8_SA(0, 0), a2, voffA);
            PG8_WAIT_V(8); PG8_WAIT_L(0); PG8_BAR; PG8_MMA(1, 0, At, B0); PG8_MMA(1, 1, At, B1); PG8_BAR; PG8_SCHED;
            PG8_LDB(B0, 1, 0); PG8_LDB(B1, 1, 1); PG8_SCHED; PG8_LDA(At, 1, 0); PG8_STAGE(PG8_SA(0, 1), a2 + hstepA, voffA);
            PG8_WAIT_V(8); PG8_WAIT_L(0); PG8_BAR; PG8_MMA(0, 0, At, B0); PG8_MMA(0, 1, At, B1); PG8_BAR; PG8_SCHED;
            PG8_LDA(At, 1, 1); PG8_STAGE(PG8_SB(1, 0), b3, voffB); PG8_STAGE(PG8_SB(1, 1), b3 + hstepB, voffB); PG8_STAGE(PG8_SA(1, 0), a3, voffA);
            PG8_WAIT_V(8); PG8_WAIT_L(0); PG8_BAR; PG8_MMA(1, 0, At, B0); PG8_MMA(1, 1, At, B1); PG8_BAR; PG8_SCHED;
        }
        if constexpr (ALIGN_EPI) { if (wr == 0) PG8_BAR; }
        E(acc, cur, wr, wc, fr, fq);
        if (!has_next) break;
#pragma unroll
        for (int a = 0; a < 2; ++a)
#pragma unroll
            for (int b = 0; b < 2; ++b)
#pragma unroll
                for (int m = 0; m < 4; ++m)
#pragma unroll
                    for (int n = 0; n < 2; ++n) acc[a][b][m][n] = (f32x4){0.f, 0.f, 0.f, 0.f};
        cur = nxt; cA = nA; cB = nB; ++ui;
        if constexpr (ALIGN_EPI) { if (wr == 1) PG8_BAR; }
    }
    PG8_WAIT_V(0);
    if constexpr (!ALIGN_EPI) { if (wr == 0) PG8_BAR; }
    PG8_BAR;
#undef PG8_SA
#undef PG8_SB
#undef PG8_STAGE
#undef PG8_LDA
#undef PG8_LDB
#undef PG8_MMA
#undef PG8_WAIT_V
#undef PG8_WAIT_L
#undef PG8_BAR
#undef PG8_SCHED
}

typedef const f32x4 (&AccRef)[2][2][4][2];
__device__ __forceinline__ u32x4 pack8(f32x4 v0, f32x4 v1) { u32x4 w; w.x = cvt_pk_bf16(v0[0], v0[1]); w.y = cvt_pk_bf16(v0[2], v0[3]); w.z = cvt_pk_bf16(v1[0], v1[1]); w.w = cvt_pk_bf16(v1[2], v1[3]); return w; }

struct EpiProj {
    bf16_t *PA, *PZ, *PC, *PG;
    __device__ __forceinline__ void operator()(AccRef acc, const Unit& u, int wr, int wc, int fr, int fq) const {
        bf16_t* base; int ldc, colt, act;
        if (u.pn < 3) { base = PA; ldc = 768; colt = u.pn * 256; act = 0; }
        else if (u.pn < 7) { base = PZ; ldc = 1024; colt = (u.pn - 3) * 256; act = 1; }
        else if (u.pn < 10) { base = PC; ldc = 768; colt = (u.pn - 7) * 256; act = 0; }
        else { base = PG; ldc = 2048; colt = (u.pn - 10) * 256; act = 2; }
        const int row0 = u.pm * BM + wr * 64 + fr, col0 = colt + wc * 32 + 8 * fq;
#pragma unroll
        for (int ai = 0; ai < 2; ++ai)
#pragma unroll
            for (int m = 0; m < 4; ++m) { bf16_t* rowp = base + (size_t)(row0 + ai * HALF + m * 16) * ldc + col0;
#pragma unroll
                for (int bj = 0; bj < 2; ++bj) { f32x4 v0 = acc[ai][bj][m][0], v1 = acc[ai][bj][m][1];
                    if (act != 0) {
#pragma unroll
                        for (int e = 0; e < 4; ++e) { const float s0 = sigmoidf_fast(v0[e]), s1 = sigmoidf_fast(v1[e]); v0[e] = (act == 1) ? v0[e] * s0 : s0; v1[e] = (act == 1) ? v1[e] * s1 : s1; }
                    }
                    *(u32x4*)(rowp + bj * HALF) = pack8(v0, v1); } }
    }
};
struct EpiQ {
    bf16_t* QB; const float* rs; const f32x2* rope;
    __device__ __forceinline__ void operator()(AccRef acc, const Unit& u, int wr, int wc, int fr, int fq) const {
        const int row0 = u.pm * BM + wr * 64 + fr; const int colb = u.pn * BM + wc * 32 + 8 * fq;
        const int dp0 = colb % 96, dp1 = (colb + HALF) % 96;
#pragma unroll
        for (int ai = 0; ai < 2; ++ai)
#pragma unroll
            for (int m = 0; m < 4; ++m) { const int row = row0 + ai * HALF + m * 16; const float r = rs[row]; const f32x2* tr = rope + (size_t)pos_of_row(row) * 16;
#pragma unroll
                for (int bj = 0; bj < 2; ++bj) { const int dp = bj ? dp1 : dp0;
                    f32x4 v0 = acc[ai][bj][m][0] * r, v1 = acc[ai][bj][m][1] * r;
                    if (dp >= 64) { const f32x4* tp = (const f32x4*)(tr + ((dp - 64) >> 1)); const f32x4 c0 = tp[0], c1 = tp[1];
                        f32x4 w0, w1;
                        w0[0] = v0[0] * c0[0] - v0[1] * c0[1]; w0[1] = v0[0] * c0[1] + v0[1] * c0[0];
                        w0[2] = v0[2] * c0[2] - v0[3] * c0[3]; w0[3] = v0[2] * c0[3] + v0[3] * c0[2];
                        w1[0] = v1[0] * c1[0] - v1[1] * c1[1]; w1[1] = v1[0] * c1[1] + v1[1] * c1[0];
                        w1[2] = v1[2] * c1[2] - v1[3] * c1[3]; w1[3] = v1[2] * c1[3] + v1[3] * c1[2];
                        v0 = w0; v1 = w1; }
                    *(u32x4*)(QB + (size_t)row * 768 + colb + bj * HALF) = pack8(v0, v1); }
                asm volatile("" ::: "memory"); }
    }
};
struct EpiKV {
    bf16_t *KN, *VB; const float* rs;
    __device__ __forceinline__ void operator()(AccRef acc, const Unit& u, int wr, int wc, int fr, int fq) const {
        bf16_t* base = (u.pn < 2) ? KN : VB; const int colt = (u.pn & 1) * 256;
        const int row0 = u.pm * BM + wr * 64 + fr, col0 = colt + wc * 32 + 8 * fq;
#pragma unroll
        for (int ai = 0; ai < 2; ++ai)
#pragma unroll
            for (int m = 0; m < 4; ++m) { const int row = row0 + ai * HALF + m * 16; const float r = rs[row]; bf16_t* rowp = base + (size_t)row * 512 + col0;
#pragma unroll
                for (int bj = 0; bj < 2; ++bj) *(u32x4*)(rowp + bj * HALF) = pack8(acc[ai][bj][m][0] * r, acc[ai][bj][m][1] * r); }
    }
};
template <bool FIRST> struct EpiGate {
    bf16_t* T; const bf16_t* PG; int goff;
    __device__ __forceinline__ void operator()(AccRef acc, const Unit& u, int wr, int wc, int fr, int fq) const {
        const int row0 = u.pm * BM + wr * 64 + fr, col0 = u.pn * BM + wc * 32 + 8 * fq;
#pragma unroll
        for (int ai = 0; ai < 2; ++ai)
#pragma unroll
            for (int m = 0; m < 4; ++m) { const int row = row0 + ai * HALF + m * 16;
#pragma unroll
                for (int bj = 0; bj < 2; ++bj) { const int col = col0 + bj * HALF;
                    const u32x4 gw = *(const u32x4*)(PG + (size_t)row * 2048 + goff + col);
                    f32x4 v0 = acc[ai][bj][m][0], v1 = acc[ai][bj][m][1];
                    v0[0] *= bf_lo(gw.x); v0[1] *= bf_hi(gw.x); v0[2] *= bf_lo(gw.y); v0[3] *= bf_hi(gw.y);
                    v1[0] *= bf_lo(gw.z); v1[1] *= bf_hi(gw.z); v1[2] *= bf_lo(gw.w); v1[3] *= bf_hi(gw.w);
                    bf16_t* tp = T + (size_t)row * 1024 + col;
                    if (!FIRST) { const u32x4 tw = *(const u32x4*)tp;
                        v0[0] += bf_lo(tw.x); v0[1] += bf_hi(tw.x); v0[2] += bf_lo(tw.y); v0[3] += bf_hi(tw.y);
                        v1[0] += bf_lo(tw.z); v1[1] += bf_hi(tw.z); v1[2] += bf_lo(tw.w); v1[3] += bf_hi(tw.w); }
                    *(u32x4*)tp = pack8(v0, v1); } }
    }
};
struct EpiOut {
    const float *xp, *xs; float* out; const float* mod; const float* b_ada;
    __device__ __forceinline__ void operator()(AccRef acc, const Unit& u, int wr, int wc, int fr, int fq) const {
        const int rowt = u.pm * BM; const int b = batch_of_row(rowt);
        const float* xbase = rowt < M_P ? xp + (size_t)rowt * DM : xs + (size_t)(rowt - M_P) * DM;
        float* obase = out + (size_t)rowt * DM;
        const int col0 = u.pn * BM + wc * 32 + 8 * fq;
        f32x4 g[2][2];
#pragma unroll
        for (int bj = 0; bj < 2; ++bj)
#pragma unroll
            for (int n = 0; n < 2; ++n) g[bj][n] = *(const f32x4*)(mod + (size_t)b * 3 * DM + 2 * DM + col0 + bj * HALF + 4 * n) + *(const f32x4*)(b_ada + 2 * DM + col0 + bj * HALF + 4 * n);
#pragma unroll
        for (int ai = 0; ai < 2; ++ai)
#pragma unroll
            for (int m = 0; m < 4; ++m) { const size_t off = (size_t)(wr * 64 + fr + ai * HALF + m * 16) * DM + col0;
#pragma unroll
                for (int bj = 0; bj < 2; ++bj)
#pragma unroll
                    for (int n = 0; n < 2; ++n) { const f32x4 xv = *(const f32x4*)(xbase + off + bj * HALF + 4 * n);
                        *(f32x4*)(obase + off + bj * HALF + 4 * n) = xv + g[bj][n] * acc[ai][bj][m][n]; } }
    }
};
}

namespace att {
constexpr int NW = 8, QBLK = 32, KVBLK = 64;
constexpr int SHM_V = 8192, SHM_KN = 8192, SHM_KR = 4096;
constexpr int OFF_V = 0, OFF_KN = 2 * SHM_V, OFF_KR = OFF_KN + 2 * SHM_KN, OFF_WS = OFF_KR + 2 * SHM_KR, LDS_BYTES = OFF_WS + NW * 64 * 4;
constexpr float THR2 = 8.0f;
#define SBAR() __builtin_amdgcn_sched_barrier(0)
__device__ __forceinline__ int crow(int r, int hi) { return (r & 3) + 8 * (r >> 2) + 4 * hi; }
__device__ __forceinline__ int v_st(int k, int c) { const int kk = (k & ~0xC) | ((k & 4) << 1) | ((k & 8) >> 1); return ((kk >> 3) * 2 + (c >> 5)) * 512 + ((kk & 7) * 32 + (c & 31)) * 2; }
__device__ __forceinline__ int v_rd_base(int lane) { return ((lane & 3) << 3) | (((lane >> 2) & 3) << 6) | (((lane >> 4) & 1) << 5) | (((lane >> 5) & 1) << 8); }
constexpr int v_rd_off(int d0, int ks, int half) { return d0 * 512 + ks * 2048 + half * 1024; }
template <int OFF> __device__ __forceinline__ s16x4 tr_read(int vb) { s16x4 r; asm volatile("ds_read_b64_tr_b16 %0, %1 offset:%2" : "=&v"(r) : "v"(vb), "i"(OFF) : "memory"); return r; }
template <int D0> __device__ __forceinline__ void pv_one(f32x16& od, int vb, bf16x8 pa0, bf16x8 pa1, bf16x8 pa2, bf16x8 pa3) {
    const s16x4 l0 = tr_read<v_rd_off(D0, 0, 0)>(vb), h0 = tr_read<v_rd_off(D0, 0, 1)>(vb), l1 = tr_read<v_rd_off(D0, 1, 0)>(vb), h1 = tr_read<v_rd_off(D0, 1, 1)>(vb);
    const s16x4 l2 = tr_read<v_rd_off(D0, 2, 0)>(vb), h2 = tr_read<v_rd_off(D0, 2, 1)>(vb), l3 = tr_read<v_rd_off(D0, 3, 0)>(vb), h3 = tr_read<v_rd_off(D0, 3, 1)>(vb);
    asm volatile("s_waitcnt lgkmcnt(0)" ::: "memory"); SBAR();
#define PK(L, H) (bf16x8){L[0], L[1], L[2], L[3], H[0], H[1], H[2], H[3]}
    od = __builtin_amdgcn_mfma_f32_32x32x16_bf16(pa0, PK(l0, h0), od, 0, 0, 0);
    od = __builtin_amdgcn_mfma_f32_32x32x16_bf16(pa1, PK(l1, h1), od, 0, 0, 0);
    od = __builtin_amdgcn_mfma_f32_32x32x16_bf16(pa2, PK(l2, h2), od, 0, 0, 0);
    od = __builtin_amdgcn_mfma_f32_32x32x16_bf16(pa3, PK(l3, h3), od, 0, 0, 0);
#undef PK
}
__device__ __forceinline__ void pv_d0(f32x16* o, int vb, bf16x8 pa0, bf16x8 pa1, bf16x8 pa2, bf16x8 pa3) { pv_one<0>(o[0], vb, pa0, pa1, pa2, pa3); pv_one<1>(o[1], vb, pa0, pa1, pa2, pa3); }

template <int DQK> __device__ __forceinline__ void qkt(f32x16& p0, f32x16& p1, const char* Kn_s, const char* Kr_s, const bf16x8* qr, int r32, int hi) {
    p0 = f32x16{}; p1 = f32x16{};
    const int keyn = (r32 >> 1) & 7, keyr = (r32 >> 2) & 3;
#pragma unroll
    for (int d0 = 0; d0 < 4; ++d0) { const int off = r32 * 128 + (((2 * d0 + hi) ^ keyn) << 4);
        const bf16x8 b0 = *reinterpret_cast<const bf16x8*>(Kn_s + off), b1 = *reinterpret_cast<const bf16x8*>(Kn_s + off + 32 * 128);
        p0 = __builtin_amdgcn_mfma_f32_32x32x16_bf16(b0, qr[d0], p0, 0, 0, 0);
        p1 = __builtin_amdgcn_mfma_f32_32x32x16_bf16(b1, qr[d0], p1, 0, 0, 0); }
    if constexpr (DQK == 96) {
#pragma unroll
        for (int d0 = 0; d0 < 2; ++d0) { const int off = r32 * 64 + (((2 * d0 + hi) ^ keyr) << 4);
            const bf16x8 b0 = *reinterpret_cast<const bf16x8*>(Kr_s + off), b1 = *reinterpret_cast<const bf16x8*>(Kr_s + off + 32 * 64);
            p0 = __builtin_amdgcn_mfma_f32_32x32x16_bf16(b0, qr[4 + d0], p0, 0, 0, 0);
            p1 = __builtin_amdgcn_mfma_f32_32x32x16_bf16(b1, qr[4 + d0], p1, 0, 0, 0); }
    }
}
template <bool WIN> __device__ __forceinline__ void partialSM(f32x16& p0, f32x16& p1, float& m_reg, float& alpha, int drel, float slope2, int hi) {
    if constexpr (WIN) {
#pragma unroll
        for (int r = 0; r < 16; ++r) { const int d0_ = drel + crow(r, hi), d1_ = d0_ + 32; const float a0 = fabsf((float)d0_), a1 = fabsf((float)d1_);
            p0[r] = (a0 <= 128.f) ? p0[r] - slope2 * a0 : -1e30f; p1[r] = (a1 <= 128.f) ? p1[r] - slope2 * a1 : -1e30f; }
    }
    float pmax = p0[0];
#pragma unroll
    for (int r = 1; r < 16; ++r) pmax = fmaxf(pmax, p0[r]);
#pragma unroll
    for (int r = 0; r < 16; ++r) pmax = fmaxf(pmax, p1[r]);
    { auto rr = __builtin_amdgcn_permlane32_swap(__float_as_uint(pmax), __float_as_uint(pmax), false, false); pmax = fmaxf(__uint_as_float(rr[0]), __uint_as_float(rr[1])); }
    float mn;
    if (__builtin_expect(__all(pmax - m_reg <= THR2), 1)) { mn = m_reg; alpha = 1.f; }
    else { mn = fmaxf(m_reg, pmax); alpha = __builtin_amdgcn_exp2f(m_reg - mn); m_reg = mn; }
#pragma unroll
    for (int r = 0; r < 16; ++r) { p0[r] = p0[r] - mn; p1[r] = p1[r] - mn; }
#pragma unroll
    for (int r = 0; r < 16; ++r) p0[r] = __builtin_amdgcn_exp2f(p0[r]);
}
__device__ __forceinline__ void finishSM(f32x16& p0, f32x16& p1, float alpha, float& l_reg, bf16x8& pa0, bf16x8& pa1, bf16x8& pa2, bf16x8& pa3) {
#pragma unroll
    for (int r = 0; r < 16; ++r) p1[r] = __builtin_amdgcn_exp2f(p1[r]);
    float ps = 0;
#pragma unroll
    for (int r = 0; r < 16; ++r) ps += p0[r];
#pragma unroll
    for (int r = 0; r < 16; ++r) ps += p1[r];
    { auto rr = __builtin_amdgcn_permlane32_swap(__float_as_uint(ps), __float_as_uint(ps), false, false); ps = __uint_as_float(rr[0]) + __uint_as_float(rr[1]); }
    l_reg = l_reg * alpha + ps;
#define PK4(P, BASE, OUT) do { unsigned a0 = cvt_pk_bf16(P[BASE + 0], P[BASE + 1]), a1 = cvt_pk_bf16(P[BASE + 2], P[BASE + 3]);   \
    unsigned b0 = cvt_pk_bf16(P[BASE + 4], P[BASE + 5]), b1 = cvt_pk_bf16(P[BASE + 6], P[BASE + 7]);                              \
    auto r0 = __builtin_amdgcn_permlane32_swap(a0, b0, false, false); auto r1 = __builtin_amdgcn_permlane32_swap(a1, b1, false, false); \
    u32x4 w = {r0[0], r1[0], r0[1], r1[1]}; OUT = *reinterpret_cast<bf16x8*>(&w); } while (0)
    PK4(p0, 0, pa0); PK4(p0, 8, pa1); PK4(p1, 0, pa2); PK4(p1, 8, pa3);
#undef PK4
}

template <int DQK, bool WIN>
__device__ __forceinline__ void attn_unit(const bf16_t* __restrict__ Qb, int ldq, const bf16_t* __restrict__ Kn, int ldk, const bf16_t* __restrict__ Kr,
                                          const bf16_t* __restrict__ Vh, int ldv, const bf16_t* __restrict__ Zb, int ldz, bf16_t* __restrict__ Ob, int ldo,
                                          int t0, int NT, int qpos0, float slope2, float sink2, char* lds) {
    constexpr int ND0 = DQK / 16;
    int tid = threadIdx.x; asm volatile("" : "+v"(tid));
    const int wid = __builtin_amdgcn_readfirstlane(tid >> 6), lane = tid & 63, r32 = lane & 31, hi = lane >> 5;
    char* V_lds = lds + OFF_V; char* Kn_lds = lds + OFF_KN; char* Kr_lds = lds + OFF_KR;
    float* ws = (float*)(lds + OFF_WS) + wid * 64; float* li_l = ws; float* al_l = ws + 32;
    float m_reg = WIN ? sink2 : -1e30f, l_reg = WIN ? 1.f : 0.f; f32x16 o[2] = {}; bf16x8 qr[ND0];
    const bf16_t* Qw = Qb + (size_t)(wid * QBLK + r32) * ldq + hi * 8;
#pragma unroll
    for (int d0 = 0; d0 < ND0; ++d0) qr[d0] = *reinterpret_cast<const bf16x8*>(Qw + d0 * 16);
    const int sr = tid >> 3, sc = (tid & 7) * 8;
    const int vst = v_st(sr, sc), knst = sr * 128 + (((tid & 7) ^ ((sr >> 1) & 7)) << 4);
    const int rr_ = (tid >> 2) & 63, rc_ = tid & 3, krst = rr_ * 64 + ((rc_ ^ ((rr_ >> 2) & 3)) << 4);
    const bool do_kr = (DQK == 96) && (wid < 4);
    const int vb0 = (int)(uintptr_t)V_lds + v_rd_base(lane);
    const int qposl = qpos0 + wid * QBLK + r32;
    struct { bf16x8 vs, ks, rs; } st_[2];
    const bf16_t* Vp = Vh + (size_t)t0 * KVBLK * ldv + (size_t)sr * ldv + sc;
    const bf16_t* Kp = Kn + (size_t)t0 * KVBLK * ldk + (size_t)sr * ldk + sc;
    const bf16_t* Rp = Kr + (size_t)t0 * KVBLK * 32 + (size_t)rr_ * 32 + rc_ * 8;
#define SLOAD(i, t) do { st_[i].vs = *reinterpret_cast<const bf16x8*>(Vp + (size_t)(t) * KVBLK * ldv); st_[i].ks = *reinterpret_cast<const bf16x8*>(Kp + (size_t)(t) * KVBLK * ldk); \
        if (do_kr) st_[i].rs = *reinterpret_cast<const bf16x8*>(Rp + (size_t)(t) * KVBLK * 32); } while (0)
#define SWRITE(b, i) do { *(bf16x8*)(V_lds + (b) * SHM_V + vst) = st_[i].vs; *(bf16x8*)(Kn_lds + (b) * SHM_KN + knst) = st_[i].ks; \
        if (do_kr) *(bf16x8*)(Kr_lds + (b) * SHM_KR + krst) = st_[i].rs; } while (0)
#define SWAIT() do { if (do_kr) asm volatile("s_waitcnt vmcnt(3)" ::: "memory"); else asm volatile("s_waitcnt vmcnt(2)" ::: "memory"); } while (0)
#define RESC(a) do { if (__any((a) < 1.f)) { if (hi == 0) al_l[r32] = (a); asm volatile("s_waitcnt lgkmcnt(0)" ::: "memory"); \
        _Pragma("unroll") for (int d = 0; d < 2; ++d) _Pragma("unroll") for (int r = 0; r < 16; ++r) o[d][r] *= al_l[crow(r, hi)]; } } while (0)
#define DREL(t) ((t0 + (t)) * KVBLK - qposl)
    f32x16 pA0, pA1, pB0, pB1; float alA, alB; bf16x8 pa0, pa1, pa2, pa3;
    SLOAD(0, 0); asm volatile("s_waitcnt vmcnt(0)" ::: "memory"); SWRITE(0, 0); __syncthreads();
    qkt<DQK>(pA0, pA1, Kn_lds, Kr_lds, qr, r32, hi); partialSM<WIN>(pA0, pA1, m_reg, alA, DREL(0), slope2, hi);
    SLOAD(1, 1); if (2 < NT) SLOAD(0, 2);
    SWAIT(); SWRITE(1, 1); __syncthreads();
    for (int j = 1; j + 1 < NT; j += 2) {
        SBAR(); qkt<DQK>(pB0, pB1, Kn_lds + SHM_KN, Kr_lds + SHM_KR, qr, r32, hi);
        finishSM(pA0, pA1, alA, l_reg, pa0, pa1, pa2, pa3); SBAR();
        SLOAD(1, j + 2); SBAR();
        pv_d0(o, vb0, pa0, pa1, pa2, pa3); partialSM<WIN>(pB0, pB1, m_reg, alB, DREL(j), slope2, hi);
        __syncthreads(); SWAIT(); SWRITE(0, 0);
        RESC(alB); __syncthreads();
        SBAR(); qkt<DQK>(pA0, pA1, Kn_lds, Kr_lds, qr, r32, hi);
        finishSM(pB0, pB1, alB, l_reg, pa0, pa1, pa2, pa3); SBAR();
        if (j + 3 < NT) SLOAD(0, j + 3); SBAR();
        pv_d0(o, vb0 + SHM_V, pa0, pa1, pa2, pa3); partialSM<WIN>(pA0, pA1, m_reg, alA, DREL(j + 1), slope2, hi);
        __syncthreads(); SWAIT(); SWRITE(1, 1);
        RESC(alA); __syncthreads();
    }
    SBAR(); qkt<DQK>(pB0, pB1, Kn_lds + SHM_KN, Kr_lds + SHM_KR, qr, r32, hi);
    finishSM(pA0, pA1, alA, l_reg, pa0, pa1, pa2, pa3); SBAR();
    pv_d0(o, vb0, pa0, pa1, pa2, pa3); partialSM<WIN>(pB0, pB1, m_reg, alB, DREL(NT - 1), slope2, hi);
    __syncthreads(); RESC(alB);
    finishSM(pB0, pB1, alB, l_reg, pa0, pa1, pa2, pa3); SBAR();
    pv_d0(o, vb0 + SHM_V, pa0, pa1, pa2, pa3);
    if (hi == 0) li_l[r32] = l_reg; asm volatile("s_waitcnt lgkmcnt(0)" ::: "memory");
#pragma unroll
    for (int r = 0; r < 16; ++r) { const int orow = wid * QBLK + crow(r, hi); const float rl = __builtin_amdgcn_rcpf(li_l[crow(r, hi)]);
#pragma unroll
        for (int d0 = 0; d0 < 2; ++d0) { const float z = __uint_as_float((unsigned)Zb[(size_t)orow * ldz + d0 * 32 + r32] << 16);
            const unsigned w = cvt_pk_bf16(o[d0][r] * rl * z, 0.f); Ob[(size_t)orow * ldo + d0 * 32 + r32] = (bf16_t)(w & 0xffffu); } }
    __syncthreads();
#undef SLOAD
#undef SWRITE
#undef SWAIT
#undef RESC
#undef DREL
}
#undef SBAR
}

namespace mla {
constexpr int NW = 8, KSLOT = 12288, VSLOT = 8192, NKS = 4, NVS = 3;
constexpr int LDS_K = 0, LDS_V = NKS * KSLOT, LDS_WS = LDS_V + NVS * VSLOT, LDS_OST = LDS_WS + NW * 256, LDS_BYTES = LDS_OST + NW * 4096;
#define SBAR() __builtin_amdgcn_sched_barrier(0)
#define PIN(x) asm volatile("" : "+v"(x))
#define MFMA(a, b, c) __builtin_amdgcn_mfma_f32_32x32x16_bf16(a, b, c, 0, 0, 0)
#define WAIT_BAR(N) asm volatile("s_waitcnt vmcnt(" #N ") lgkmcnt(0)\n\ts_barrier" ::: "memory")
__device__ __forceinline__ int crow(int r, int hi) { return (r & 3) + 8 * (r >> 2) + 4 * hi; }
__device__ __forceinline__ unsigned cvtpk(float lo, float hi) { unsigned r; asm("v_cvt_pk_bf16_f32 %0, %1, %2" : "=v"(r) : "v"(lo), "v"(hi)); return r; }
__device__ __forceinline__ void glds16(const void* g, unsigned lds_base) {
    unsigned sv; asm volatile("s_mov_b32 %0, m0\n\ts_mov_b32 m0, %2\n\ts_nop 0\n\tglobal_load_lds_dwordx4 %1, off\n\ts_mov_b32 m0, %0" : "=&s"(sv) : "v"(g), "s"(lds_base) : "memory"); }
typedef __attribute__((address_space(3))) const char* lds_cptr;
typedef short v4i16_t __attribute__((ext_vector_type(4)));
__device__ __forceinline__ bf16x8 kld(lds_cptr p) { return *(const __attribute__((address_space(3))) bf16x8*)p; }
__device__ __forceinline__ s16x4 vtr(lds_cptr p) { return __builtin_bit_cast(s16x4, __builtin_amdgcn_ds_read_tr16_b64_v4i16((__attribute__((address_space(3))) v4i16_t*)p)); }

__device__ __forceinline__ void mla_unit(const bf16_t* __restrict__ Qu, const bf16_t* __restrict__ Knh, const bf16_t* __restrict__ Krs, const bf16_t* __restrict__ Vhh,
                                         const bf16_t* __restrict__ Zu, bf16_t* __restrict__ Ou, int NT, float kmax, char* lds) {
    int tid = threadIdx.x; asm volatile("" : "+v"(tid));
    const int lane = tid & 63, r32 = lane & 31, hi = lane >> 5; const int wid = __builtin_amdgcn_readfirstlane(tid >> 6); const bool wlow = wid < 4;
    const unsigned lds0 = (unsigned)(uintptr_t)lds; float* wsf = (float*)(lds + LDS_WS) + wid * 64;
    const bf16_t* ksrc = Knh + (size_t)lane * 512 + wid * 8;
    const bf16_t* rsrc = Krs + (size_t)lane * 32 + (wid & 3) * 8;
    const bf16_t* vsrc = Vhh + (size_t)(16 * (wid & 3) + (lane >> 2)) * 512 + (wid >> 2) * 32 + (lane & 3) * 8;
    const unsigned kdst = lds0 + LDS_K + wid * 1024, rdst = lds0 + LDS_K + (8 + (wid & 3)) * 1024, vdst = lds0 + LDS_V + wid * 1024;
#define DMA_K(t, slot) do { glds16(ksrc + (size_t)(t) * 64 * 512, (unsigned)__builtin_amdgcn_readfirstlane(kdst + (slot))); \
        if (wlow) glds16(rsrc + (size_t)(t) * 64 * 32, (unsigned)__builtin_amdgcn_readfirstlane(rdst + (slot))); } while (0)
#define DMA_V(t, slot) glds16(vsrc + (size_t)(t) * 64 * 512, (unsigned)__builtin_amdgcn_readfirstlane(vdst + (slot)))
#define WAITB(NHI, NLO) do { if (wlow) { WAIT_BAR(NLO); } else { WAIT_BAR(NHI); } } while (0)
    const lds_cptr vp0 = (lds_cptr)lds + LDS_V + ((lane >> 4) & 1) * 32 + (lane & 3) * 8 + (4 * hi + ((lane & 15) >> 2)) * 64;
    const lds_cptr kp0 = (lds_cptr)lds + LDS_K + hi * 1024 + r32 * 16;
    DMA_K(0, 0); DMA_V(0, 0); DMA_K(1, KSLOT);
    bf16x8 qr[6];
    const bf16_t* Qw = Qu + (size_t)(wid * 32 + r32) * 768 + hi * 8;
#pragma unroll
    for (int d0 = 0; d0 < 6; ++d0) qr[d0] = *reinterpret_cast<const bf16x8*>(Qw + d0 * 16);
    DMA_K(2, 2 * KSLOT);
    float qs = 0.f;
#pragma unroll
    for (int d0 = 0; d0 < 6; ++d0)
#pragma unroll
        for (int e = 0; e < 8; ++e) { const float v = __uint_as_float((unsigned)(unsigned short)qr[d0][e] << 16); qs += v * v; }
    { auto rr = __builtin_amdgcn_permlane32_swap(__float_as_uint(qs), __float_as_uint(qs), false, false); qs = __uint_as_float(rr[0]) + __uint_as_float(rr[1]); }
    const float mrow = sqrtf(qs) * kmax * 1.001f + 1e-3f;
    f32x16 negm;
#pragma unroll
    for (int r = 0; r < 16; ++r) negm[r] = -mrow;
    PIN(negm);
    float l_reg = 0.f; f32x16 o[2]; o[0] = f32x16{}; o[1] = f32x16{};
    f32x16 pA0, pA1, pB0, pB1; bf16x8 kf[12]; s16x4 vlo[8], vhi[8]; u32x4 pw0, pw1, pw2, pw3;
    int vs_prev = 0, vs_cur = 0, vs_next = VSLOT;
#define ROT() do { vs_prev = vs_cur; vs_cur = vs_next; vs_next = (vs_next == 2 * VSLOT) ? 0 : vs_next + VSLOT; } while (0)
#define KS(t) (((t) & 3) * KSLOT)
#define EX(v) __builtin_amdgcn_exp2f(v)
    WAITB(3, 5);
#pragma unroll
    for (int i = 0; i < 12; ++i) kf[i] = kld(kp0 + (i >> 1) * 2048 + (i & 1) * 512);
    pA0 = MFMA(kf[0], qr[0], negm); pA1 = MFMA(kf[1], qr[0], negm);
#pragma unroll
    for (int d0 = 1; d0 < 6; ++d0) { pA0 = MFMA(kf[2 * d0], qr[d0], pA0); pA1 = MFMA(kf[2 * d0 + 1], qr[d0], pA1); }
#pragma unroll
    for (int r = 0; r < 16; ++r) { pA0[r] = EX(pA0[r]); pA1[r] = EX(pA1[r]); }
    WAIT_BAR(0);
    DMA_K(3, 3 * KSLOT); DMA_V(1, VSLOT); ROT();
    kf[0] = kld(kp0 + KS(1)); kf[1] = kld(kp0 + KS(1) + 512);
#define PKW(P, i) cvtpk(P[i], P[i + 1])
#define PAF(k) __builtin_bit_cast(bf16x8, pw##k)
#define VFR(i) (bf16x8){vlo[i][0], vlo[i][1], vlo[i][2], vlo[i][3], vhi[i][0], vhi[i][1], vhi[i][2], vhi[i][3]}
#define VRD(i) do { vlo[i] = vtr(vp_ + (((i) >> 2) * 4096 + ((i) & 3) * 1024)); vhi[i] = vtr(vp_ + (((i) >> 2) * 4096 + ((i) & 3) * 1024 + 512)); } while (0)
#define KRD(i) do { kf[i] = kld(kp_ + ((i) >> 1) * 2048 + ((i) & 1) * 512); } while (0)
#define GAPA3(MF, a0, a1, a2, W0, PW) do { MF; sacc += a0; sacc += a1; sacc += a2; W0; PIN(PW); PIN(sacc); SBAR(); } while (0)
#define GAPA2(MF, a0, a1, W0, W1, PW) do { MF; sacc += a0; sacc += a1; W0; W1; PIN(PW); PIN(sacc); SBAR(); } while (0)
#define GAPB(MF, X, i) do { MF; X[i] = EX(X[i]); X[i + 1] = EX(X[i + 1]); X[i + 2] = EX(X[i + 2]); X[i + 3] = EX(X[i + 3]); PIN(X); SBAR(); } while (0)
#define STEP(C0, C1, P0, P1, t, GK, GV, GL) do { SBAR(); \
    const lds_cptr kp_ = kp0 + KS(t); const lds_cptr vp_ = vp0 + vs_prev; float sacc = P0[0] + P0[1]; \
    KRD(2);  SBAR(); GAPA3(C0 = MFMA(kf[0],  qr[0], negm), P0[2],  P0[3],  P0[4],  pw0[0] = PKW(P0, 0),  pw0); \
    KRD(3);  SBAR(); GAPA3(C1 = MFMA(kf[1],  qr[0], negm), P0[5],  P0[6],  P0[7],  pw0[1] = PKW(P0, 2),  pw0); \
    KRD(4);  SBAR(); GAPA3(C0 = MFMA(kf[2],  qr[1], C0),   P0[8],  P0[9],  P0[10], pw0[2] = PKW(P0, 4),  pw0); \
    KRD(5);  SBAR(); GAPA3(C1 = MFMA(kf[3],  qr[1], C1),   P0[11], P0[12], P0[13], pw0[3] = PKW(P0, 6),  pw0); \
    KRD(6);  SBAR(); GAPA3(C0 = MFMA(kf[4],  qr[2], C0),   P0[14], P0[15], P1[0],  pw1[0] = PKW(P0, 8),  pw1); \
    KRD(7);  SBAR(); GAPA3(C1 = MFMA(kf[5],  qr[2], C1),   P1[1],  P1[2],  P1[3],  pw1[1] = PKW(P0, 10), pw1); \
    KRD(8);  SBAR(); GAPA3(C0 = MFMA(kf[6],  qr[3], C0),   P1[4],  P1[5],  P1[6],  pw1[2] = PKW(P0, 12), pw1); \
    KRD(9);  SBAR(); GAPA3(C1 = MFMA(kf[7],  qr[3], C1),   P1[7],  P1[8],  P1[9],  pw1[3] = PKW(P0, 14), pw1); \
    KRD(10); SBAR(); GAPA2(C0 = MFMA(kf[8],  qr[4], C0),   P1[10], P1[11], pw2[0] = PKW(P1, 0),  pw2[1] = PKW(P1, 2),  pw2); \
    KRD(11); SBAR(); GAPA2(C1 = MFMA(kf[9],  qr[4], C1),   P1[12], P1[13], pw2[2] = PKW(P1, 4),  pw2[3] = PKW(P1, 6),  pw2); \
    VRD(0);  SBAR(); GAPA2(C0 = MFMA(kf[10], qr[5], C0),   P1[14], P1[15], pw3[0] = PKW(P1, 8),  pw3[1] = PKW(P1, 10), pw3); \
    VRD(4);  SBAR(); GAPA2(C1 = MFMA(kf[11], qr[5], C1),   0.f,    0.f,    pw3[2] = PKW(P1, 12), pw3[3] = PKW(P1, 14), pw3); \
    l_reg += sacc; \
    if (GK) DMA_K((t) + 3, KS((t) + 3)); if (GV) DMA_V((t) + 1, vs_next); \
    SBAR(); \
    VRD(1); SBAR(); GAPB(o[0] = MFMA(PAF(0), VFR(0), o[0]), C0, 0); \
    VRD(5); SBAR(); GAPB(o[1] = MFMA(PAF(0), VFR(4), o[1]), C0, 4); \
    VRD(2); SBAR(); GAPB(o[0] = MFMA(PAF(1), VFR(1), o[0]), C0, 8); \
    VRD(6); SBAR(); GAPB(o[1] = MFMA(PAF(1), VFR(5), o[1]), C0, 12); \
    VRD(3); SBAR(); GAPB(o[0] = MFMA(PAF(2), VFR(2), o[0]), C1, 0); \
    VRD(7); SBAR(); GAPB(o[1] = MFMA(PAF(2), VFR(6), o[1]), C1, 4); \
    if (GL) { kf[0] = kld(kp0 + KS((t) + 1)); kf[1] = kld(kp0 + KS((t) + 1) + 512); } SBAR(); \
                    GAPB(o[0] = MFMA(PAF(3), VFR(3), o[0]), C1, 8); \
                    GAPB(o[1] = MFMA(PAF(3), VFR(7), o[1]), C1, 12); \
    } while (0)
    int t = 1;
    for (; t + 4 < NT; t += 2) {
        STEP(pB0, pB1, pA0, pA1, t, true, true, true);     WAITB(2, 3); ROT();
        STEP(pA0, pA1, pB0, pB1, t + 1, true, true, true); WAITB(2, 3); ROT();
    }
    STEP(pB0, pB1, pA0, pA1, t, false, true, true);      WAIT_BAR(1); ROT();
    STEP(pA0, pA1, pB0, pB1, t + 1, false, true, true);  WAIT_BAR(0); ROT();
    STEP(pB0, pB1, pA0, pA1, t + 2, false, false, false);
    { float sacc = pB0[0] + pB0[1];
#pragma unroll
      for (int r = 2; r < 16; ++r) sacc += pB0[r];
#pragma unroll
      for (int r = 0; r < 16; ++r) sacc += pB1[r];
      l_reg += sacc;
      pw0 = (u32x4){PKW(pB0, 0), PKW(pB0, 2), PKW(pB0, 4), PKW(pB0, 6)}; pw1 = (u32x4){PKW(pB0, 8), PKW(pB0, 10), PKW(pB0, 12), PKW(pB0, 14)};
      pw2 = (u32x4){PKW(pB1, 0), PKW(pB1, 2), PKW(pB1, 4), PKW(pB1, 6)}; pw3 = (u32x4){PKW(pB1, 8), PKW(pB1, 10), PKW(pB1, 12), PKW(pB1, 14)};
      const lds_cptr vp_ = vp0 + vs_cur; VRD(0); VRD(4); VRD(1); VRD(5); VRD(2); VRD(6); VRD(3); VRD(7);
      o[0] = MFMA(PAF(0), VFR(0), o[0]); o[1] = MFMA(PAF(0), VFR(4), o[1]); o[0] = MFMA(PAF(1), VFR(1), o[0]); o[1] = MFMA(PAF(1), VFR(5), o[1]);
      o[0] = MFMA(PAF(2), VFR(2), o[0]); o[1] = MFMA(PAF(2), VFR(6), o[1]); o[0] = MFMA(PAF(3), VFR(3), o[0]); o[1] = MFMA(PAF(3), VFR(7), o[1]); }
    { auto rr = __builtin_amdgcn_permlane32_swap(__float_as_uint(l_reg), __float_as_uint(l_reg), false, false); l_reg = __uint_as_float(rr[0]) + __uint_as_float(rr[1]); }
    if (hi == 0) wsf[32 + r32] = l_reg; asm volatile("s_waitcnt lgkmcnt(0)" ::: "memory");
    bf16_t* stg = (bf16_t*)(lds + LDS_OST) + wid * 2048;
    const bf16_t* Zw = Zu + (size_t)(wid * 32) * 1024; bf16_t* Ow = Ou + (size_t)(wid * 32) * 512;
#pragma unroll
    for (int r = 0; r < 16; ++r) { const int orow = crow(r, hi); const float rl = __builtin_amdgcn_rcpf(wsf[32 + orow]);
#pragma unroll
        for (int d0 = 0; d0 < 2; ++d0) { const float z = __uint_as_float((unsigned)Zw[(size_t)orow * 1024 + d0 * 32 + r32] << 16);
            stg[orow * 64 + d0 * 32 + r32] = (bf16_t)(cvtpk(o[d0][r] * rl * z, 0.f) & 0xffffu); } }
    asm volatile("s_waitcnt lgkmcnt(0)" ::: "memory");
#pragma unroll
    for (int i = 0; i < 4; ++i) { const int row = i * 8 + (lane >> 3), ch = lane & 7; *(u32x4*)(Ow + (size_t)row * 512 + ch * 8) = *(const u32x4*)(stg + row * 64 + ch * 8); }
    asm volatile("s_waitcnt lgkmcnt(0)\n\ts_barrier" ::: "memory");
#undef DMA_K
#undef DMA_V
#undef WAITB
#undef ROT
#undef KS
#undef EX
#undef PKW
#undef PAF
#undef VFR
#undef VRD
#undef KRD
#undef GAPA3
#undef GAPA2
#undef GAPB
#undef STEP
}
#undef SBAR
#undef PIN
#undef MFMA
#undef WAIT_BAR
}

constexpr int NWAVES = 8;
constexpr int LDS_BYTES = 147456;
static_assert(pg8::STAGE_BYTES <= 131072 && att::LDS_BYTES <= 131072 && mla::LDS_BYTES <= 131072, "LDS map");

struct Params { const float* in[17]; float* out; unsigned char* ws; int ph_lo, ph_hi; };

__device__ const double ROPE_INV[16] = {1.0, 0.5623413251903491, 0.31622776601683794, 0.1778279410038923, 0.1, 0.05623413251903491, 0.03162277660168379, 0.01778279410038923,
                                        0.01, 0.005623413251903491, 0.0031622776601683794, 0.0017782794100389228, 0.001, 0.0005623413251903491, 0.00031622776601683794, 0.00017782794100389227};

__device__ __forceinline__ unsigned f2bf(float f) { unsigned u = __builtin_bit_cast(unsigned, f); return (u + 0x7fffu + ((u >> 16) & 1u)) >> 16; }
__device__ __forceinline__ unsigned pk2(float lo, float hi) { return f2bf(lo) | (f2bf(hi) << 16); }

__device__ __forceinline__ int wsrc_col(int kind, int n, float& cs) {
    cs = 1.f;
    if (kind == 0) {
        if (n < 1280) { if (n < 512) cs = QA_SCALE; return n; }
        if (n < 1792) return n - 1280 + 1952;
        if (n < 2432) return n - 1792 + 1280;
        if (n < 2464) { const int j = n - 2432; return 1920 + (j >> 1) + 16 * (j & 1); }
        if (n < 2560) return -1;
        return n - 2560 + 2464;
    } else if (kind == 1) {
        cs = QB_SCALE; const int h = n / 96, d = n % 96;
        if (d < 64) return h * 96 + d;
        const int j = d - 64; return h * 96 + 64 + (j >> 1) + 16 * (j & 1);
    } else if (kind == 2) {
        if (n < 512) return (n >> 6) * 128 + (n & 63);
        const int q = n - 512; return (q >> 6) * 128 + 64 + (q & 63);
    }
    return n;
}
__device__ __forceinline__ void transpose_item(const float* W, int K, int Nsrc, int Ndst, int kind, const float* kgain, bf16_t* WT, LAS float* scr, int item, int lane) {
    const int nblk = Ndst / 32, kb = item / nblk, nb = item % nblk, k0 = 64 * kb, n0 = 32 * nb;
    float cs; const int src = wsrc_col(kind, n0 + (lane & 31), cs);
#pragma unroll 8
    for (int i = 0; i < 32; ++i) { const int kk = 2 * i + (lane >> 5); float v = 0.f;
        if (src >= 0) { v = W[(size_t)(k0 + kk) * Nsrc + src] * cs; if (kgain) v *= kgain[k0 + kk]; }
        scr[kk * 33 + (lane & 31)] = v; }
    asm volatile("s_waitcnt lgkmcnt(0)" ::: "memory");
    const int c = lane & 7;
#pragma unroll
    for (int j = 0; j < 4; ++j) { const int n = (lane >> 3) + 8 * j; const LAS float* s = scr + (8 * c) * 33 + n;
        u32x4 o; o.x = pk2(s[0 * 33], s[1 * 33]); o.y = pk2(s[2 * 33], s[3 * 33]); o.z = pk2(s[4 * 33], s[5 * 33]); o.w = pk2(s[6 * 33], s[7 * 33]);
        *(u32x4*)(WT + (size_t)(n0 + n) * K + k0 + 8 * c) = o; }
    asm volatile("s_waitcnt lgkmcnt(0)" ::: "memory");
}

__global__ void __launch_bounds__(NWAVES * 64, 2) mk_fwd(Params p) {
    extern __shared__ __attribute__((aligned(16))) unsigned char lds[];
    cg::grid_group grid = cg::this_grid();
    const int G = gridDim.x, bx = blockIdx.x;
    const int vcu = (G % 8 == 0) ? (bx % 8) * (G / 8) + bx / 8 : bx;
    const int NGW = G * NWAVES;
    typedef const __attribute__((address_space(4))) Params* KP;
    const KP PP = (KP)__builtin_amdgcn_kernarg_segment_ptr();
#define PHASE_PTRS() KP q_ = PP; asm volatile("" : "+s"(q_)); unsigned char* ws = q_->ws; (void)ws; \
    const float *x_p = q_->in[0], *x_s = q_->in[1], *c_p = q_->in[2], *c_s = q_->in[3], *w_ada = q_->in[4], *b_ada = q_->in[5], *g_norm = q_->in[6], *w_in = q_->in[7], *g_q = q_->in[8], *w_uq = q_->in[9], \
                *g_kv = q_->in[10], *w_ukv = q_->in[11], *sink = q_->in[12], *w_oa = q_->in[13], *w_ob = q_->in[14], *w_out = q_->in[15], *g_final = q_->in[16]; float* outp = q_->out; \
    (void)x_p; (void)x_s; (void)c_p; (void)c_s; (void)w_ada; (void)b_ada; (void)g_norm; (void)w_in; (void)g_q; (void)w_uq; (void)g_kv; (void)w_ukv; (void)sink; (void)w_oa; (void)w_ob; (void)w_out; (void)g_final; (void)outp; \
    int tid = threadIdx.x; asm volatile("" : "+v"(tid)); const int lane = tid & 63, wave = __builtin_amdgcn_readfirstlane(tid >> 6), gw = vcu * NWAVES + wave; (void)lane; (void)wave; (void)gw; \
    float* mod = (float*)(ws + WS_MOD); f32x2* rope = (f32x2*)(ws + WS_ROPE); (void)mod; (void)rope; \
    bf16_t *Win_t = (bf16_t*)(ws + WS_WIN), *Wuq_t = (bf16_t*)(ws + WS_WUQ), *Wukv_t = (bf16_t*)(ws + WS_WUKV), *Woa_t = (bf16_t*)(ws + WS_WOA), *Wob_t = (bf16_t*)(ws + WS_WOB), *Wout_t = (bf16_t*)(ws + WS_WOUT); \
    (void)Win_t; (void)Wuq_t; (void)Wukv_t; (void)Woa_t; (void)Wob_t; (void)Wout_t; \
    float *RSQ = (float*)(ws + WS_RSQ), *RSKV = (float*)(ws + WS_RSKV); (void)RSQ; (void)RSKV; \
    bf16_t *HB = (bf16_t*)(ws + WS_R1), *YA = (bf16_t*)(ws + WS_R1), *YB = (bf16_t*)(ws + WS_R1 + 48 * MiB); (void)HB; (void)YA; (void)YB; \
    bf16_t *PA = (bf16_t*)(ws + WS_R2), *QB = (bf16_t*)(ws + WS_R2); (void)PA; (void)QB; \
    bf16_t *PZ = (bf16_t*)(ws + WS_R3), *TM = (bf16_t*)(ws + WS_R3); (void)PZ; (void)TM; \
    bf16_t *PC = (bf16_t*)(ws + WS_R4), *KN = (bf16_t*)(ws + WS_KN), *VB = (bf16_t*)(ws + WS_VB), *KR = (bf16_t*)(ws + WS_KR); (void)PC; (void)KN; (void)VB; (void)KR; \
    bf16_t* PG = (bf16_t*)outp; (void)PG;
    const int lo = p.ph_lo, hi = p.ph_hi;
#ifndef PH_MASK
#define PH_MASK 0x3ff
#endif
#define IN(k) (((PH_MASK >> (k)) & 1) && lo <= (k) && (k) < hi)
#define SEAM(k) do { if (IN(k) && IN((k) + 1)) grid.sync(); } while (0)
#ifndef REP_MASK
#define REP_MASK 0x002
#endif
#define REPS(k) (1 + ((REP_MASK >> (k)) & 1))
#define REPSYNC() do { if (rep_) grid.sync(); } while (0)

    if (IN(0)) { PHASE_PTRS();
        LAS float* scr = (LAS float*)((LAS unsigned char*)lds + wave * 16384);
        constexpr int I_IN = (DM / 64) * (N_IN / 32), I_UQ = (384 / 64) * (768 / 32), I_UKV = (256 / 64) * (1024 / 32), I_OA = (512 / 64) * (1024 / 32), I_OUT = (1024 / 64) * (1024 / 32);
        constexpr int NITEMS = I_IN + I_UQ + I_UKV + 2 * I_OA + I_OUT;
        for (int it = gw; it < NITEMS; it += NGW) {
            int r = it;
            if (r < I_IN) { transpose_item(w_in, DM, D_IN, N_IN, 0, nullptr, Win_t, scr, r, lane); continue; } r -= I_IN;
            if (r < I_UQ) { transpose_item(w_uq, 384, 768, 768, 1, g_q, Wuq_t, scr, r, lane); continue; } r -= I_UQ;
            if (r < I_UKV) { transpose_item(w_ukv, 256, 1024, 1024, 2, g_kv, Wukv_t, scr, r, lane); continue; } r -= I_UKV;
            if (r < I_OA) { transpose_item(w_oa, 512, 1024, 1024, 3, nullptr, Woa_t, scr, r, lane); continue; } r -= I_OA;
            if (r < I_OA) { transpose_item(w_ob, 512, 1024, 1024, 3, nullptr, Wob_t, scr, r, lane); continue; } r -= I_OA;
            transpose_item(w_out, 1024, 1024, 1024, 3, nullptr, Wout_t, scr, r, lane);
        }
        for (int it = gw; it < 16 * 48; it += NGW) { const int ks = it / 48, cgp = it % 48, col = cgp * 64 + lane; float a[NBATCH];
#pragma unroll
            for (int b = 0; b < NBATCH; ++b) a[b] = 0.f;
            for (int k = ks * 64; k < ks * 64 + 64; ++k) { const float w = w_ada[(size_t)k * 3 * DM + col];
#pragma unroll
                for (int b = 0; b < NBATCH; ++b) { const float c = (b < NB_P) ? c_p[b * DM + k] : c_s[(b - NB_P) * DM + k]; a[b] += c * sigmoidf_fast(c) * w; } }
#pragma unroll
            for (int b = 0; b < NBATCH; ++b) atomicAdd(mod + b * 3 * DM + col, a[b]);
        }
        for (int e = gw * 64 + lane; e < S_S * 16; e += NGW * 64) { const int pos = e >> 4, i = e & 15;
            const double ang = (double)pos * ROPE_INV[i]; const double n = rint(ang * 0.6366197723675814);
            const double r = (ang - n * 1.5707963267948966) - n * 6.123233995736766e-17; const double r2 = r * r;
            const double sn = r * (1.0 + r2 * (-1.0 / 6 + r2 * (1.0 / 120 + r2 * (-1.0 / 5040 + r2 * (1.0 / 362880 + r2 * (-1.0 / 39916800 + r2 * (1.0 / 6227020800.0)))))));
            const double cn = 1.0 + r2 * (-0.5 + r2 * (1.0 / 24 + r2 * (-1.0 / 720 + r2 * (1.0 / 40320 + r2 * (-1.0 / 3628800 + r2 * (1.0 / 479001600.0))))));
            const int q = (int)((long long)n & 3); double cs_, sn_;
            if (q == 0) { cs_ = cn; sn_ = sn; } else if (q == 1) { cs_ = -sn; sn_ = cn; } else if (q == 2) { cs_ = -cn; sn_ = -sn; } else { cs_ = sn; sn_ = -cn; }
            rope[e] = (f32x2){(float)cs_, (float)sn_}; }
    }
    SEAM(0);
    for (int rep_ = 0; rep_ < REPS(1); ++rep_) { REPSYNC();
    if (IN(1)) { PHASE_PTRS();
        constexpr int RPW = 24;
        for (int base = gw * RPW; base < M; base += NGW * RPW) {
            int cb = -1; f32x4 ga[4], sh[4];
            for (int row = base; row < base + RPW && row < M; ++row) {
                const int b = batch_of_row(row);
                if (b != cb) { cb = b;
#pragma unroll
                    for (int j = 0; j < 4; ++j) { const int c = 4 * lane + 256 * j;
                        const f32x4 sc = *(const f32x4*)(mod + b * 3 * DM + DM + c) + *(const f32x4*)(b_ada + DM + c);
                        sh[j] = *(const f32x4*)(mod + b * 3 * DM + c) + *(const f32x4*)(b_ada + c);
                        ga[j] = *(const f32x4*)(g_norm + c) * (sc + 1.0f); } }
                const float* xr = row < M_P ? x_p + (size_t)row * DM : x_s + (size_t)(row - M_P) * DM;
                f32x4 v[4]; float s = 0.f;
#pragma unroll
                for (int j = 0; j < 4; ++j) { v[j] = *(const f32x4*)(xr + 4 * lane + 256 * j); s += (v[j].x * v[j].x + v[j].y * v[j].y) + (v[j].z * v[j].z + v[j].w * v[j].w); }
                const float rstd = 1.0f / sqrtf(wave_sum(s) * (1.f / DM) + EPS);
#pragma unroll
                for (int j = 0; j < 4; ++j) { const f32x4 h = v[j] * rstd * ga[j] + sh[j]; u32x2 w; w.x = cvt_pk_bf16(h.x, h.y); w.y = cvt_pk_bf16(h.z, h.w);
                    *(u32x2*)(HB + (size_t)row * DM + 4 * lane + 256 * j) = w; }
            }
        }
    }
    }
    SEAM(1);
    for (int rep_ = 0; rep_ < REPS(2); ++rep_) { REPSYNC();
    if (IN(2)) { PHASE_PTRS();
        pg8::Gemm g{HB, Win_t, M, N_IN, DM, DM}; pg8::StaticOrder S; S.init(M, N_IN, G, bx);
        pg8::EpiProj E{PA, PZ, PC, PG};
        pg8::gemm_phase<pg8::EpiProj, 1024, 1024>((LAS unsigned char*)lds, g, S, E);
    }
    }
    SEAM(2);
    for (int rep_ = 0; rep_ < REPS(3); ++rep_) { REPSYNC();
    if (IN(3)) { PHASE_PTRS();
        for (int row = gw; row < M; row += NGW) {
            const bf16_t* pr = PC + (size_t)row * 768;
            const u32x4 a = *(const u32x4*)(pr + lane * 8); u32x4 b = (u32x4){0u, 0u, 0u, 0u};
            if (lane < 20) b = *(const u32x4*)(pr + 512 + lane * 8);
            float sa = 0.f, sb = 0.f;
#pragma unroll
            for (int e = 0; e < 4; ++e) { const float l0 = bf_lo(a[e]), h0 = bf_hi(a[e]); sa += l0 * l0 + h0 * h0; }
            if (lane < 16) {
#pragma unroll
                for (int e = 0; e < 4; ++e) { const float l0 = bf_lo(b[e]), h0 = bf_hi(b[e]); sb += l0 * l0 + h0 * h0; } }
            float sq = (lane < 48) ? sa : 0.f, skv = (lane < 48) ? 0.f : sa; skv += sb;
            sq = wave_sum(sq); skv = wave_sum(skv);
            if (lane == 0) { RSQ[row] = 1.0f / sqrtf(sq * (1.f / 384.f) + EPS); RSKV[row] = 1.0f / sqrtf(skv * (1.f / 256.f) + EPS); }
            if (lane >= 16 && lane < 20) { const int i0 = (lane - 16) * 4; const f32x4* tp = (const f32x4*)(rope + (size_t)pos_of_row(row) * 16 + i0); const f32x4 c0 = tp[0], c1 = tp[1];
                const float x0 = bf_lo(b.x), y0 = bf_hi(b.x), x1 = bf_lo(b.y), y1 = bf_hi(b.y), x2 = bf_lo(b.z), y2 = bf_hi(b.z), x3 = bf_lo(b.w), y3 = bf_hi(b.w);
                u32x4 w; w.x = cvt_pk_bf16(x0 * c0[0] - y0 * c0[1], x0 * c0[1] + y0 * c0[0]); w.y = cvt_pk_bf16(x1 * c0[2] - y1 * c0[3], x1 * c0[3] + y1 * c0[2]);
                w.z = cvt_pk_bf16(x2 * c1[0] - y2 * c1[1], x2 * c1[1] + y2 * c1[0]); w.w = cvt_pk_bf16(x3 * c1[2] - y3 * c1[3], x3 * c1[3] + y3 * c1[2]);
                *(u32x4*)(KR + (size_t)row * 32 + (lane - 16) * 8) = w; }
        }
        for (int U = vcu; U < (M / 256) * 8; U += G) { const int rb = U >> 3, h = U & 7, kvh = h >> 2; const int row0 = rb * 256;
            const int S = row0 < M_P ? S_P : S_S; const int qpos0 = pos_of_row(row0); const int seq0 = row0 - qpos0;
            const int ks = qpos0 - 128 < 0 ? 0 : qpos0 - 128, ke = qpos0 + 384 > S ? S : qpos0 + 384;
            const float slope2 = exp2f(-(float)(h + 1)) * LOG2E, sink2 = sink[h] * LOG2E;
            att::attn_unit<64, true>(PA + (size_t)row0 * 768 + h * 64, 768, PA + (size_t)seq0 * 768 + 512 + kvh * 64, 768, nullptr, PA + (size_t)seq0 * 768 + 640 + kvh * 64, 768,
                                     PZ + (size_t)row0 * 1024 + h * 64, 1024, YA + (size_t)row0 * 512 + h * 64, 512, ks / 64, (ke - ks) / 64, qpos0, slope2, sink2, (char*)lds);
        }
    }
    }
    SEAM(3);
    for (int rep_ = 0; rep_ < REPS(4); ++rep_) { REPSYNC();
    if (IN(4)) { PHASE_PTRS();
#ifndef NO_Q
        { pg8::Gemm g{PC, Wuq_t, M, 768, 384, 768}; pg8::StaticOrder S; S.init(M, 768, G, bx); pg8::EpiQ E{QB, RSQ, rope};
          pg8::gemm_phase<pg8::EpiQ, 384, 768>((LAS unsigned char*)lds, g, S, E); }
#endif
#ifndef NO_KV
        { pg8::Gemm g{PC + 384, Wukv_t, M, 1024, 256, 768}; pg8::StaticOrder S; S.init(M, 1024, G, bx); pg8::EpiKV E{KN, VB, RSKV};
          pg8::gemm_phase<pg8::EpiKV, 256, 768>((LAS unsigned char*)lds, g, S, E); }
#endif
    }
    }
    SEAM(4);
    for (int rep_ = 0; rep_ < REPS(5); ++rep_) { REPSYNC();
    if (IN(5)) { PHASE_PTRS();
        { unsigned* KMAX = (unsigned*)(ws + WS_KMAX); constexpr int RPW = 24;
          for (int base = gw * RPW; base < M; base += NGW * RPW) { int cb = -1; float mx = 0.f;
            for (int row = base; row < base + RPW && row < M; ++row) { const int b = batch_of_row(row);
                if (b != cb) { if (cb >= 0 && (lane & 7) == 0) atomicMax(KMAX + cb * 8 + (lane >> 3), __float_as_uint(mx)); cb = b; mx = 0.f; }
                const u32x4 a = *(const u32x4*)(KN + (size_t)row * 512 + lane * 8); const u32x4 r4 = *(const u32x4*)(KR + (size_t)row * 32 + (lane & 3) * 8);
                float sn = 0.f, sr = 0.f;
#pragma unroll
                for (int e = 0; e < 4; ++e) { const float l0 = bf_lo(a[e]), h0 = bf_hi(a[e]), l1 = bf_lo(r4[e]), h1 = bf_hi(r4[e]); sn += l0 * l0 + h0 * h0; sr += l1 * l1 + h1 * h1; }
                sn += __shfl_xor(sn, 1); sn += __shfl_xor(sn, 2); sn += __shfl_xor(sn, 4); sr += __shfl_xor(sr, 1); sr += __shfl_xor(sr, 2);
                mx = fmaxf(mx, sn + sr); }
            if (cb >= 0 && (lane & 7) == 0) atomicMax(KMAX + cb * 8 + (lane >> 3), __float_as_uint(mx)); }
        }
        grid.sync();
        for (int U = vcu; U < 1536; U += G) {
            int row0, seq0, S, h, b;
            if (U < 1024) { const int i = U >> 8, v = U & 255, xcd = v >> 5, c = v & 31; const int bh = 2 * xcd + (i >> 1), qb = (i & 1) * 32 + c; b = bh >> 3; h = bh & 7;
                S = S_S; seq0 = M_P + b * S_S; row0 = seq0 + qb * 256; b += NB_P; }
            else { const int U2 = U - 1024; const int j = U2 >> 8, v = U2 & 255, xcd = v >> 5, c = v & 31; const int bh = 4 * xcd + 2 * j + (c >> 4), qb = c & 15; b = bh >> 3; h = bh & 7;
                S = S_P; seq0 = b * S_P; row0 = seq0 + qb * 256; }
            const float kmax = sqrtf(__uint_as_float(__hip_atomic_load((unsigned*)(ws + WS_KMAX) + b * 8 + h, __ATOMIC_RELAXED, __HIP_MEMORY_SCOPE_AGENT)));
            mla::mla_unit(QB + (size_t)row0 * 768 + h * 96, KN + (size_t)seq0 * 512 + h * 64, KR + (size_t)seq0 * 32, VB + (size_t)seq0 * 512 + h * 64,
                          PZ + (size_t)row0 * 1024 + 512 + h * 64, YB + (size_t)row0 * 512 + h * 64, S / 64, kmax, (char*)lds);
        }
    }
    }
    SEAM(5);
    for (int rep_ = 0; rep_ < REPS(6); ++rep_) { REPSYNC();
    if (IN(6)) { PHASE_PTRS(); pg8::Gemm g{YA, Woa_t, M, 1024, 512, 512}; pg8::StaticOrder S; S.init(M, 1024, G, bx); pg8::EpiGate<true> E{TM, PG, 0};
        pg8::gemm_phase<pg8::EpiGate<true>, 512, 512>((LAS unsigned char*)lds, g, S, E); }
    SEAM(6);
    if (IN(7)) { PHASE_PTRS(); pg8::Gemm g{YB, Wob_t, M, 1024, 512, 512}; pg8::StaticOrder S; S.init(M, 1024, G, bx); pg8::EpiGate<false> E{TM, PG, 1024};
        pg8::gemm_phase<pg8::EpiGate<false>, 512, 512>((LAS unsigned char*)lds, g, S, E); }
    SEAM(7);
    }
    for (int rep_ = 0; rep_ < REPS(8); ++rep_) { REPSYNC();
    if (IN(8)) { PHASE_PTRS(); pg8::Gemm g{TM, Wout_t, M, 1024, 1024, 1024}; pg8::StaticOrder S; S.init(M, 1024, G, bx); pg8::EpiOut E{x_p, x_s, outp, mod, b_ada};
        pg8::gemm_phase<pg8::EpiOut, 1024, 1024>((LAS unsigned char*)lds, g, S, E); }
    SEAM(8);
    if (IN(9)) { PHASE_PTRS();
        f32x4 gf[4];
#pragma unroll
        for (int j = 0; j < 4; ++j) gf[j] = *(const f32x4*)(g_final + 4 * lane + 256 * j);
        for (int row = gw; row < M; row += NGW) { float* orow = outp + (size_t)row * DM; f32x4 v[4]; float s = 0.f;
#pragma unroll
            for (int j = 0; j < 4; ++j) { v[j] = *(const f32x4*)(orow + 4 * lane + 256 * j); s += (v[j].x * v[j].x + v[j].y * v[j].y) + (v[j].z * v[j].z + v[j].w * v[j].w); }
            const float rstd = 1.0f / sqrtf(wave_sum(s) * (1.f / DM) + EPS);
#pragma unroll
            for (int j = 0; j < 4; ++j) *(f32x4*)(orow + 4 * lane + 256 * j) = v[j] * rstd * gf[j];
        }
    }
    }
#undef IN
#undef SEAM
#undef PHASE_PTRS
}

extern "C" void kernel_launch(void* const* d_in, const int* in_sizes, int n_in, void* d_out, int out_size, void* d_ws, size_t ws_size, hipStream_t stream) {
    static int grid = 0;
    if (grid == 0) {
        if (n_in != 17 || out_size != M * DM || ws_size < WS_END) { fprintf(stderr, "kernel_launch: unexpected shapes: n_in %d out %d ws %zu (need %zu)\n", n_in, out_size, ws_size, (size_t)WS_END); grid = -1; return; }
        int dev = 0, cus = 0, per_cu = 0;
        hipGetDevice(&dev); hipDeviceGetAttribute(&cus, hipDeviceAttributeMultiprocessorCount, dev);
        if (hipFuncSetAttribute((const void*)mk_fwd, hipFuncAttributeMaxDynamicSharedMemorySize, LDS_BYTES) != hipSuccess) { fprintf(stderr, "kernel_launch: hipFuncSetAttribute failed\n"); grid = -1; return; }
        if (hipOccupancyMaxActiveBlocksPerMultiprocessor(&per_cu, (const void*)mk_fwd, NWAVES * 64, LDS_BYTES) != hipSuccess || per_cu < 1) { fprintf(stderr, "kernel_launch: occupancy query says %d\n", per_cu); per_cu = 1; }
        (void)hipGetLastError();
        grid = cus;
    }
    if (grid < 0) return;
    hipMemsetAsync((char*)d_ws + WS_MOD, 0, ZERO_BYTES, stream);
    Params p{};
    for (int i = 0; i < 17; ++i) p.in[i] = (const float*)d_in[i];
    p.out = (float*)d_out; p.ws = (unsigned char*)d_ws;
#if MK_N_LAUNCHES == 1
    p.ph_lo = 0; p.ph_hi = 10;
    void* args[] = {&p};
    hipError_t e = hipLaunchCooperativeKernel((const void*)mk_fwd, dim3(grid), dim3(NWAVES * 64), args, LDS_BYTES, stream);
    if (e != hipSuccess) fprintf(stderr, "cooperative launch failed: %s (grid %d)\n", hipGetErrorString(e), grid);
#else
    for (int ph = 0; ph < 10; ++ph) { p.ph_lo = ph; p.ph_hi = ph + 1; hipLaunchKernelGGL(mk_fwd, dim3(grid), dim3(NWAVES * 64), LDS_BYTES, stream, p); }
#endif
}
```

```cpp
#include <hip/hip_runtime.h>
#include <hip/hip_cooperative_groups.h>
#include <cstdio>
#include <cstdint>
namespace cg = cooperative_groups;

#ifndef MK_N_LAUNCHES
#define MK_N_LAUNCHES 1
#endif

constexpr int DM = 1024;
constexpr int NB_P = 4, S_P = 4096, NB_S = 2, S_S = 16384;
constexpr int M_P = NB_P * S_P, M_S = NB_S * S_S, M = M_P + M_S;
constexpr int D_IN = 4512, N_IN = 4608;
constexpr int NBATCH = NB_P + NB_S;
constexpr float EPS = 1e-6f;
constexpr float LOG2E = 1.4426950408889634f;
constexpr float QA_SCALE = 0.125f * LOG2E;
constexpr float QB_SCALE = 0.10206207261596575f * LOG2E;

constexpr size_t MiB = 1u << 20;
constexpr size_t WS_MOD = 0;
constexpr size_t MOD_BYTES = (size_t)NBATCH * 3 * DM * 4;
constexpr size_t WS_KMAX = WS_MOD + MOD_BYTES;
constexpr size_t ZERO_BYTES = MOD_BYTES + 256;
constexpr size_t WS_ROPE = 128 * 1024;
constexpr size_t WS_WIN = WS_ROPE + 2 * MiB;
constexpr size_t WS_WUQ = WS_WIN + (size_t)N_IN * DM * 2;
constexpr size_t WS_WUKV = WS_WUQ + (size_t)768 * 384 * 2;
constexpr size_t WS_WOA = WS_WUKV + (size_t)1024 * 256 * 2;
constexpr size_t WS_WOB = WS_WOA + (size_t)1024 * 512 * 2;
constexpr size_t WS_WOUT = WS_WOB + (size_t)1024 * 512 * 2;
constexpr size_t WS_RSQ = WS_WOUT + (size_t)1024 * 1024 * 2;
constexpr size_t WS_RSKV = WS_RSQ + (size_t)M * 4;
static_assert(WS_RSKV + (size_t)M * 4 <= 20 * MiB, "small region");
constexpr size_t WS_R1 = 20 * MiB;
constexpr size_t WS_R2 = WS_R1 + 96 * MiB;
constexpr size_t WS_R3 = WS_R2 + 72 * MiB;
constexpr size_t WS_R4 = WS_R3 + 96 * MiB;
constexpr size_t WS_KN = WS_R4 + 72 * MiB;
constexpr size_t WS_VB = WS_KN + 48 * MiB;
constexpr size_t WS_KR = WS_VB + 48 * MiB;
constexpr size_t WS_END = WS_KR + 3 * MiB;

typedef unsigned short bf16_t;
typedef short bf16x8 __attribute__((ext_vector_type(8)));
typedef short s16x4 __attribute__((ext_vector_type(4)));
typedef float f32x4 __attribute__((ext_vector_type(4)));
typedef float f32x2 __attribute__((ext_vector_type(2)));
typedef float f32x16 __attribute__((ext_vector_type(16)));
typedef unsigned u32x4 __attribute__((ext_vector_type(4)));
typedef unsigned u32x2 __attribute__((ext_vector_type(2)));
#define LAS __attribute__((address_space(3)))

__device__ __forceinline__ unsigned cvt_pk_bf16(float lo, float hi) { unsigned r; asm volatile("v_cvt_pk_bf16_f32 %0, %1, %2" : "=v"(r) : "v"(lo), "v"(hi)); return r; }
__device__ __forceinline__ float bf_lo(unsigned w) { return __uint_as_float(w << 16); }
__device__ __forceinline__ float bf_hi(unsigned w) { return __uint_as_float(w & 0xffff0000u); }
__device__ __forceinline__ float sigmoidf_fast(float v) { return __builtin_amdgcn_rcpf(1.0f + __builtin_amdgcn_exp2f(-v * LOG2E)); }
__device__ __forceinline__ float wave_sum(float v) {
#pragma unroll
    for (int o = 1; o < 64; o <<= 1) v += __shfl_xor(v, o);
    return v;
}
__device__ __forceinline__ int batch_of_row(int row) { return row < M_P ? (row >> 12) : NB_P + ((row - M_P) >> 14); }
__device__ __forceinline__ int pos_of_row(int row) { return row < M_P ? (row & (S_P - 1)) : ((row - M_P) & (S_S - 1)); }

namespace pg8 {
constexpr int BM = 256, BK = 64, HALF = 128, HTB = HALF * BK * 2, STAGE_BYTES = 8 * HTB, NXCD = 8, WGM = 8;
__host__ __device__ __forceinline__ int lds_byte(int r, int c) { const int st = (r >> 4) * 2 + (c >> 5), rr = r & 15, cc = c & 31, ob = rr * 64 + cc * 2; return st * 1024 + (ob ^ (((ob >> 9) & 1) << 5)); }
__host__ __device__ __forceinline__ void stage_rc(int b, int& R, int& C) { const int st = b / 1024, sb = b % 1024, swz = sb ^ (((sb >> 9) & 1) << 5); R = (st >> 1) * 16 + swz / 64; C = (st & 1) * 32 + (swz % 64) / 2; }
__host__ __device__ __forceinline__ int perm32(int rho) { const int n = rho >> 4, i = rho & 15; return 8 * (i >> 2) + 4 * n + (i & 3); }

struct Unit { int pm, pn; };
struct Gemm { const bf16_t* A; const bf16_t* Bt; int M, N, K, lda; };

struct StaticOrder {
    int nM, nN, nwg, G, c;
    __device__ void init(int M_, int N_, int G_, int c_) { nM = M_ / BM; nN = N_ / BM; nwg = nM * nN; G = G_; c = c_; }
    __device__ bool next(int i, Unit& u) const {
        const long L = (long)i * G + c; if (L >= nwg) return false;
        int wgid = (int)L; { const int q = nwg / NXCD, r = nwg % NXCD, xcd = wgid % NXCD, off = wgid / NXCD; wgid = (xcd < r ? xcd * (q + 1) : r * (q + 1) + (xcd - r) * q) + off; }
        const int nig = WGM * nN, gid = wgid / nig, fm = gid * WGM, gsz = (nM - fm) < WGM ? (nM - fm) : WGM;
        u.pm = fm + ((wgid % nig) % gsz); u.pn = (wgid % nig) / gsz; return true;
    }
};

template <class Epi, int K, int LDA, bool ALIGN_EPI = true>
__device__ __forceinline__ void gemm_phase(LAS unsigned char* lds, const Gemm g, const StaticOrder& S, const Epi& E) {
    int tid = threadIdx.x; asm volatile("" : "+v"(tid));
    const int wid = __builtin_amdgcn_readfirstlane(tid >> 6), lane = tid & 63, wr = wid >> 2, wc = wid & 3, fr = lane & 15, fq = lane >> 4;
    constexpr int nt = K / BK, lda = LDA;
    unsigned voffA[2], voffB[2];
#pragma unroll
    for (int i = 0; i < 2; ++i) { int R, C; stage_rc(tid * 16 + i * 8192, R, C); const int Rb = (R & ~31) + perm32(R & 31);
        voffA[i] = (unsigned)(R * lda + C) * 2u; voffB[i] = (unsigned)(Rb * K + C) * 2u; }
    const size_t kstep = (size_t)(BK * 2);
    const size_t hstepA = (size_t)HALF * lda * 2, tstepA = 2 * hstepA;
    const size_t hstepB = (size_t)HALF * K * 2, tstepB = 2 * hstepB;
    const unsigned ldsw = (unsigned)wid * 1024u;
    const int aoff = lds_byte(wr * 64 + fr, fq * 8), boff = lds_byte(wc * 32 + fr, fq * 8);
#define PG8_SA(b, h) (((b) * 2 + (h)) * HTB)
#define PG8_SB(b, h) ((4 + (b) * 2 + (h)) * HTB)
#define PG8_STAGE(bufoff, gbase, voff) do { _Pragma("unroll") for (int _i = 0; _i < 2; ++_i) \
        __builtin_amdgcn_global_load_lds((const unsigned*)((const char*)(gbase) + (voff)[_i]), (LAS unsigned*)(lds + (bufoff) + ldsw + _i * 8192), 16, 0, 0); } while (0)
#define PG8_LDA(dst, b, h) do { _Pragma("unroll") for (int m = 0; m < 4; ++m) _Pragma("unroll") for (int k = 0; k < 2; ++k) dst[m][k] = *(const LAS bf16x8*)(lds + PG8_SA(b, h) + aoff + m * 2048 + k * 1024); } while (0)
#define PG8_LDB(dst, b, h) do { _Pragma("unroll") for (int n = 0; n < 2; ++n) _Pragma("unroll") for (int k = 0; k < 2; ++k) dst[n][k] = *(const LAS bf16x8*)(lds + PG8_SB(b, h) + boff + n * 2048 + k * 1024); } while (0)
#define PG8_MMA(ai, bj, At, Bt) do { __builtin_amdgcn_s_setprio(1); _Pragma("unroll") for (int m = 0; m < 4; ++m) _Pragma("unroll") for (int n = 0; n < 2; ++n) _Pragma("unroll") for (int k = 0; k < 2; ++k) \
        acc[ai][bj][m][n] = __builtin_amdgcn_mfma_f32_16x16x32_bf16(Bt[n][k], At[m][k], acc[ai][bj][m][n], 0, 0, 0); __builtin_amdgcn_s_setprio(0); } while (0)
#define PG8_WAIT_V(n) asm volatile("s_waitcnt vmcnt(" #n ")" ::: "memory")
#define PG8_WAIT_L(n) asm volatile("s_waitcnt lgkmcnt(" #n ")" ::: "memory")
#define PG8_BAR __builtin_amdgcn_s_barrier()
#define PG8_SCHED __builtin_amdgcn_sched_barrier(0)
    Unit cur, nxt; int ui = 0;
    if (!S.next(0, cur)) return;
    f32x4 acc[2][2][4][2];
#pragma unroll
    for (int a = 0; a < 2; ++a)
#pragma unroll
        for (int b = 0; b < 2; ++b)
#pragma unroll
            for (int m = 0; m < 4; ++m)
#pragma unroll
                for (int n = 0; n < 2; ++n) acc[a][b][m][n] = (f32x4){0.f, 0.f, 0.f, 0.f};
    bf16x8 At[4][2], B0[2][2], B1[2][2];
    const char* cA = (const char*)g.A + (size_t)cur.pm * tstepA; const char* cB = (const char*)g.Bt + (size_t)cur.pn * tstepB;
    PG8_STAGE(PG8_SB(0, 0), cB, voffB); PG8_STAGE(PG8_SB(0, 1), cB + hstepB, voffB); PG8_STAGE(PG8_SA(0, 0), cA, voffA); PG8_STAGE(PG8_SA(0, 1), cA + hstepA, voffA);
    if (wr == 1) PG8_BAR;
    PG8_WAIT_V(2); PG8_BAR;
    PG8_STAGE(PG8_SB(1, 0), cB + kstep, voffB); PG8_STAGE(PG8_SA(1, 0), cA + kstep, voffA); PG8_STAGE(PG8_SB(1, 1), cB + hstepB + kstep, voffB);
    PG8_WAIT_V(6); PG8_BAR;
    for (;;) {
        const bool has_next = S.next(ui + 1, nxt);
        const char* nA = has_next ? (const char*)g.A + (size_t)nxt.pm * tstepA : cA; const char* nB = has_next ? (const char*)g.Bt + (size_t)nxt.pn * tstepB : cB;
#pragma unroll 1
        for (int t = 0; t < nt; t += 2) {
            const bool last = (t == nt - 2);
            const char* a1 = cA + (size_t)(t + 1) * kstep;
            const char* a2 = last ? nA : cA + (size_t)(t + 2) * kstep; const char* b2 = last ? nB : cB + (size_t)(t + 2) * kstep;
            const char* a3 = a2 + kstep; const char* b3 = b2 + kstep;
            PG8_LDB(B0, 0, 0); PG8_LDB(B1, 0, 1); PG8_SCHED; PG8_LDA(At, 0, 0); PG8_STAGE(PG8_SA(1, 1), a1 + hstepA, voffA);
            PG8_WAIT_V(8); PG8_WAIT_L(0); PG8_BAR; PG8_MMA(0, 0, At, B0); PG8_MMA(0, 1, At, B1); PG8_BAR; PG8_SCHED;
            PG8_LDA(At, 0, 1); PG8_STAGE(PG8_SB(0, 0), b2, voffB); PG8_STAGE(PG8_SB(0, 1), b2 + hstepB, voffB); PG8_STAGE(PG8_SA(0, 0), a2, voffA);
            PG8_WAIT_V(8); PG8_WAIT_L(0); PG8_BAR; PG8_MMA(1, 0, At, B0); PG8_MMA(1, 1, At, B1); PG8_BAR; PG8_SCHED;
            PG8_LDB(B0, 1, 0); PG8_LDB(B1, 1, 1); PG8_SCHED; PG8_LDA(At, 1, 0); PG8_STAGE(PG8_SA(0, 1), a2 + hstepA, voffA);
            PG8_WAIT_V(8); PG8_WAIT_L(0); PG8_BAR; PG8_MMA(0, 0, At, B0); PG8_MMA(0, 1, At, B1); PG8_BAR; PG8_SCHED;
            PG8_LDA(At, 1, 1); PG8_STAGE(PG8_SB(1, 0), b3, voffB); PG8_STAGE(PG8_SB(1, 1), b3 + hstepB, voffB); PG8_STAGE(PG8_SA(1, 0), a3, voffA);
            PG8_WAIT_V(8); PG8_WAIT_L(0); PG8_BAR; PG8_MMA(1, 0, At, B0); PG8_MMA(1, 1, At, B1); PG8_BAR; PG8_SCHED;
        }
        if constexpr (ALIGN_EPI) { if (wr == 0) PG8_BAR; }
        E(acc, cur, wr, wc, fr, fq);
        if (!has_next) break;
#pragma unroll
        for (int a = 0; a < 2; ++a)
#pragma unroll
            for (int b = 0; b < 2; ++b)
#pragma unroll
                for (int m = 0; m < 4; ++m)
#pragma unroll
                    for (int n = 0; n < 2; ++n) acc[a][b][m][n] = (f32x4){0.f, 0.f, 0.f, 0.f};
        cur = nxt; cA = nA; cB = nB; ++ui;
        if constexpr (ALIGN_EPI) { if (wr == 1) PG8_BAR; }
    }
    PG8_WAIT_V(0);
    if constexpr (!ALIGN_EPI) { if (wr == 0) PG8_BAR; }
    PG8_BAR;
#undef PG8_SA
#undef PG8_SB
#undef PG8_STAGE
#undef PG8_LDA
#undef PG8_LDB
#undef PG8_MMA
#undef PG8_WAIT_V
#undef PG8_WAIT_L
#undef PG8_BAR
#undef PG8_SCHED
}

typedef const f32x4 (&AccRef)[2][2][4][2];
__device__ __forceinline__ u32x4 pack8(f32x4 v0, f32x4 v1) { u32x4 w; w.x = cvt_pk_bf16(v0[0], v0[1]); w.y = cvt_pk_bf16(v0[2], v0[3]); w.z = cvt_pk_bf16(v1[0], v1[1]); w.w = cvt_pk_bf16(v1[2], v1[3]); return w; }

struct EpiProj {
    bf16_t *PA, *PZ, *PC, *PG;
    __device__ __forceinline__ void operator()(AccRef acc, const Unit& u, int wr, int wc, int fr, int fq) const {
        bf16_t* base; int ldc, colt, act;
        if (u.pn < 3) { base = PA; ldc = 768; colt = u.pn * 256; act = 0; }
        else if (u.pn < 7) { base = PZ; ldc = 1024; colt = (u.pn - 3) * 256; act = 1; }
        else if (u.pn < 10) { base = PC; ldc = 768; colt = (u.pn - 7) * 256; act = 0; }
        else { base = PG; ldc = 2048; colt = (u.pn - 10) * 256; act = 2; }
        const int row0 = u.pm * BM + wr * 64 + fr, col0 = colt + wc * 32 + 8 * fq;
#pragma unroll
        for (int ai = 0; ai < 2; ++ai)
#pragma unroll
            for (int m = 0; m < 4; ++m) { bf16_t* rowp = base + (size_t)(row0 + ai * HALF + m * 16) * ldc + col0;
#pragma unroll
                for (int bj = 0; bj < 2; ++bj) { f32x4 v0 = acc[ai][bj][m][0], v1 = acc[ai][bj][m][1];
                    if (act != 0) {
#pragma unroll
                        for (int e = 0; e < 4; ++e) { const float s0 = sigmoidf_fast(v0[e]), s1 = sigmoidf_fast(v1[e]); v0[e] = (act == 1) ? v0[e] * s0 : s0; v1[e] = (act == 1) ? v1[e] * s1 : s1; }
                    }
                    *(u32x4*)(rowp + bj * HALF) = pack8(v0, v1); } }
    }
};
struct EpiQ {
    bf16_t* QB; const float* rs; const f32x2* rope;
    __device__ __forceinline__ void operator()(AccRef acc, const Unit& u, int wr, int wc, int fr, int fq) const {
        const int row0 = u.pm * BM + wr * 64 + fr; const int colb = u.pn * BM + wc * 32 + 8 * fq;
        const int dp0 = colb % 96, dp1 = (colb + HALF) % 96;
#pragma unroll
        for (int ai = 0; ai < 2; ++ai)
#pragma unroll
            for (int m = 0; m < 4; ++m) { const int row = row0 + ai * HALF + m * 16; const float r = rs[row]; const f32x2* tr = rope + (size_t)pos_of_row(row) * 16;
#pragma unroll
                for (int bj = 0; bj < 2; ++bj) { const int dp = bj ? dp1 : dp0;
                    f32x4 v0 = acc[ai][bj][m][0] * r, v1 = acc[ai][bj][m][1] * r;
                    if (dp >= 64) { const f32x4* tp = (const f32x4*)(tr + ((dp - 64) >> 1)); const f32x4 c0 = tp[0], c1 = tp[1];
                        f32x4 w0, w1;
                        w0[0] = v0[0] * c0[0] - v0[1] * c0[1]; w0[1] = v0[0] * c0[1] + v0[1] * c0[0];
                        w0[2] = v0[2] * c0[2] - v0[3] * c0[3]; w0[3] = v0[2] * c0[3] + v0[3] * c0[2];
                        w1[0] = v1[0] * c1[0] - v1[1] * c1[1]; w1[1] = v1[0] * c1[1] + v1[1] * c1[0];
                        w1[2] = v1[2] * c1[2] - v1[3] * c1[3]; w1[3] = v1[2] * c1[3] + v1[3] * c1[2];
                        v0 = w0; v1 = w1; }
                    *(u32x4*)(QB + (size_t)row * 768 + colb + bj * HALF) = pack8(v0, v1); }
                asm volatile("" ::: "memory"); }
    }
};
struct EpiKV {
    bf16_t *KN, *VB; const float* rs;
    __device__ __forceinline__ void operator()(AccRef acc, const Unit& u, int wr, int wc, int fr, int fq) const {
        bf16_t* base = (u.pn < 2) ? KN : VB; const int colt = (u.pn & 1) * 256;
        const int row0 = u.pm * BM + wr * 64 + fr, col0 = colt + wc * 32 + 8 * fq;
#pragma unroll
        for (int ai = 0; ai < 2; ++ai)
#pragma unroll
            for (int m = 0; m < 4; ++m) { const int row = row0 + ai * HALF + m * 16; const float r = rs[row]; bf16_t* rowp = base + (size_t)row * 512 + col0;
#pragma unroll
                for (int bj = 0; bj < 2; ++bj) *(u32x4*)(rowp + bj * HALF) = pack8(acc[ai][bj][m][0] * r, acc[ai][bj][m][1] * r); }
    }
};
template <bool FIRST> struct EpiGate {
    bf16_t* T; const bf16_t* PG; int goff;
    __device__ __forceinline__ void operator()(AccRef acc, const Unit& u, int wr, int wc, int fr, int fq) const {
        const int row0 = u.pm * BM + wr * 64 + fr, col0 = u.pn * BM + wc * 32 + 8 * fq;
#pragma unroll
        for (int ai = 0; ai < 2; ++ai)
#pragma unroll
            for (int m = 0; m < 4; ++m) { const int row = row0 + ai * HALF + m * 16;
#pragma unroll
                for (int bj = 0; bj < 2; ++bj) { const int col = col0 + bj * HALF;
                    const u32x4 gw = *(const u32x4*)(PG + (size_t)row * 2048 + goff + col);
                    f32x4 v0 = acc[ai][bj][m][0], v1 = acc[ai][bj][m][1];
                    v0[0] *= bf_lo(gw.x); v0[1] *= bf_hi(gw.x); v0[2] *= bf_lo(gw.y); v0[3] *= bf_hi(gw.y);
                    v1[0] *= bf_lo(gw.z); v1[1] *= bf_hi(gw.z); v1[2] *= bf_lo(gw.w); v1[3] *= bf_hi(gw.w);
                    bf16_t* tp = T + (size_t)row * 1024 + col;
                    if (!FIRST) { const u32x4 tw = *(const u32x4*)tp;
                        v0[0] += bf_lo(tw.x); v0[1] += bf_hi(tw.x); v0[2] += bf_lo(tw.y); v0[3] += bf_hi(tw.y);
                        v1[0] += bf_lo(tw.z); v1[1] += bf_hi(tw.z); v1[2] += bf_lo(tw.w); v1[3] += bf_hi(tw.w); }
                    *(u32x4*)tp = pack8(v0, v1); } }
    }
};
struct EpiOut {
    const float *xp, *xs; float* out; const float* mod; const float* b_ada;
    __device__ __forceinline__ void operator()(AccRef acc, const Unit& u, int wr, int wc, int fr, int fq) const {
        const int rowt = u.pm * BM; const int b = batch_of_row(rowt);
        const float* xbase = rowt < M_P ? xp + (size_t)rowt * DM : xs + (size_t)(rowt - M_P) * DM;
        float* obase = out + (size_t)rowt * DM;
        const int col0 = u.pn * BM + wc * 32 + 8 * fq;
        f32x4 g[2][2];
#pragma unroll
        for (int bj = 0; bj < 2; ++bj)
#pragma unroll
            for (int n = 0; n < 2; ++n) g[bj][n] = *(const f32x4*)(mod + (size_t)b * 3 * DM + 2 * DM + col0 + bj * HALF + 4 * n) + *(const f32x4*)(b_ada + 2 * DM + col0 + bj * HALF + 4 * n);
#pragma unroll
        for (int ai = 0; ai < 2; ++ai)
#pragma unroll
            for (int m = 0; m < 4; ++m) { const size_t off = (size_t)(wr * 64 + fr + ai * HALF + m * 16) * DM + col0;
#pragma unroll
                for (int bj = 0; bj < 2; ++bj)
#pragma unroll
                    for (int n = 0; n < 2; ++n) { const f32x4 xv = *(const f32x4*)(xbase + off + bj * HALF + 4 * n);
                        *(f32x4*)(obase + off + bj * HALF + 4 * n) = xv + g[bj][n] * acc[ai][bj][m][n]; } }
    }
};
}

namespace att {
constexpr int NW = 8, QBLK = 32, KVBLK = 64;
constexpr int SHM_V = 8192, SHM_KN = 8192, SHM_KR = 4096;
constexpr int OFF_V = 0, OFF_KN = 2 * SHM_V, OFF_KR = OFF_KN + 2 * SHM_KN, OFF_WS = OFF_KR + 2 * SHM_KR, LDS_BYTES = OFF_WS + NW * 64 * 4;
constexpr float THR2 = 8.0f;
#define SBAR() __builtin_amdgcn_sched_barrier(0)
__device__ __forceinline__ int crow(int r, int hi) { return (r & 3) + 8 * (r >> 2) + 4 * hi; }
__device__ __forceinline__ int v_st(int k, int c) { const int kk = (k & ~0xC) | ((k & 4) << 1) | ((k & 8) >> 1); return ((kk >> 3) * 2 + (c >> 5)) * 512 + ((kk & 7) * 32 + (c & 31)) * 2; }
__device__ __forceinline__ int v_rd_base(int lane) { return ((lane & 3) << 3) | (((lane >> 2) & 3) << 6) | (((lane >> 4) & 1) << 5) | (((lane >> 5) & 1) << 8); }
constexpr int v_rd_off(int d0, int ks, int half) { return d0 * 512 + ks * 2048 + half * 1024; }
template <int OFF> __device__ __forceinline__ s16x4 tr_read(int vb) { s16x4 r; asm volatile("ds_read_b64_tr_b16 %0, %1 offset:%2" : "=&v"(r) : "v"(vb), "i"(OFF) : "memory"); return r; }
template <int D0> __device__ __forceinline__ void pv_one(f32x16& od, int vb, bf16x8 pa0, bf16x8 pa1, bf16x8 pa2, bf16x8 pa3) {
    const s16x4 l0 = tr_read<v_rd_off(D0, 0, 0)>(vb), h0 = tr_read<v_rd_off(D0, 0, 1)>(vb), l1 = tr_read<v_rd_off(D0, 1, 0)>(vb), h1 = tr_read<v_rd_off(D0, 1, 1)>(vb);
    const s16x4 l2 = tr_read<v_rd_off(D0, 2, 0)>(vb), h2 = tr_read<v_rd_off(D0, 2, 1)>(vb), l3 = tr_read<v_rd_off(D0, 3, 0)>(vb), h3 = tr_read<v_rd_off(D0, 3, 1)>(vb);
    asm volatile("s_waitcnt lgkmcnt(0)" ::: "memory"); SBAR();
#define PK(L, H) (bf16x8){L[0], L[1], L[2], L[3], H[0], H[1], H[2], H[3]}
    od = __builtin_amdgcn_mfma_f32_32x32x16_bf16(pa0, PK(l0, h0), od, 0, 0, 0);
    od = __builtin_amdgcn_mfma_f32_32x32x16_bf16(pa1, PK(l1, h1), od, 0, 0, 0);
    od = __builtin_amdgcn_mfma_f32_32x32x16_bf16(pa2, PK(l2, h2), od, 0, 0, 0);
    od = __builtin_amdgcn_mfma_f32_32x32x16_bf16(pa3, PK(l3, h3), od, 0, 0, 0);
#undef PK
}
__device__ __forceinline__ void pv_d0(f32x16* o, int vb, bf16x8 pa0, bf16x8 pa1, bf16x8 pa2, bf16x8 pa3) { pv_one<0>(o[0], vb, pa0, pa1, pa2, pa3); pv_one<1>(o[1], vb, pa0, pa1, pa2, pa3); }

template <int DQK> __device__ __forceinline__ void qkt(f32x16& p0, f32x16& p1, const char* Kn_s, const char* Kr_s, const bf16x8* qr, int r32, int hi) {
    p0 = f32x16{}; p1 = f32x16{};
    const int keyn = (r32 >> 1) & 7, keyr = (r32 >> 2) & 3;
#pragma unroll
    for (int d0 = 0; d0 < 4; ++d0) { const int off = r32 * 128 + (((2 * d0 + hi) ^ keyn) << 4);
        const bf16x8 b0 = *reinterpret_cast<const bf16x8*>(Kn_s + off), b1 = *reinterpret_cast<const bf16x8*>(Kn_s + off + 32 * 128);
        p0 = __builtin_amdgcn_mfma_f32_32x32x16_bf16(b0, qr[d0], p0, 0, 0, 0);
        p1 = __builtin_amdgcn_mfma_f32_32x32x16_bf16(b1, qr[d0], p1, 0, 0, 0); }
    if constexpr (DQK == 96) {
#pragma unroll
        for (int d0 = 0; d0 < 2; ++d0) { const int off = r32 * 64 + (((2 * d0 + hi) ^ keyr) << 4);
            const bf16x8 b0 = *reinterpret_cast<const bf16x8*>(Kr_s + off), b1 = *reinterpret_cast<const bf16x8*>(Kr_s + off + 32 * 64);
            p0 = __builtin_amdgcn_mfma_f32_32x32x16_bf16(b0, qr[4 + d0], p0, 0, 0, 0);
            p1 = __builtin_amdgcn_mfma_f32_32x32x16_bf16(b1, qr[4 + d0], p1, 0, 0, 0); }
    }
}
template <bool WIN> __device__ __forceinline__ void partialSM(f32x16& p0, f32x16& p1, float& m_reg, float& alpha, int drel, float slope2, int hi) {
    if constexpr (WIN) {
#pragma unroll
        for (int r = 0; r < 16; ++r) { const int d0_ = drel + crow(r, hi), d1_ = d0_ + 32; const float a0 = fabsf((float)d0_), a1 = fabsf((float)d1_);
            p0[r] = (a0 <= 128.f) ? p0[r] - slope2 * a0 : -1e30f; p1[r] = (a1 <= 128.f) ? p1[r] - slope2 * a1 : -1e30f; }
    }
    float pmax = p0[0];
#pragma unroll
    for (int r = 1; r < 16; ++r) pmax = fmaxf(pmax, p0[r]);
#pragma unroll
    for (int r = 0; r < 16; ++r) pmax = fmaxf(pmax, p1[r]);
    { auto rr = __builtin_amdgcn_permlane32_swap(__float_as_uint(pmax), __float_as_uint(pmax), false, false); pmax = fmaxf(__uint_as_float(rr[0]), __uint_as_float(rr[1])); }
    float mn;
    if (__builtin_expect(__all(pmax - m_reg <= THR2), 1)) { mn = m_reg; alpha = 1.f; }
    else { mn = fmaxf(m_reg, pmax); alpha = __builtin_amdgcn_exp2f(m_reg - mn); m_reg = mn; }
#pragma unroll
    for (int r = 0; r < 16; ++r) { p0[r] = p0[r] - mn; p1[r] = p1[r] - mn; }
#pragma unroll
    for (int r = 0; r < 16; ++r) p0[r] = __builtin_amdgcn_exp2f(p0[r]);
}
__device__ __forceinline__ void finishSM(f32x16& p0, f32x16& p1, float alpha, float& l_reg, bf16x8& pa0, bf16x8& pa1, bf16x8& pa2, bf16x8& pa3) {
#pragma unroll
    for (int r = 0; r < 16; ++r) p1[r] = __builtin_amdgcn_exp2f(p1[r]);
    float ps = 0;
#pragma unroll
    for (int r = 0; r < 16; ++r) ps += p0[r];
#pragma unroll
    for (int r = 0; r < 16; ++r) ps += p1[r];
    { auto rr = __builtin_amdgcn_permlane32_swap(__float_as_uint(ps), __float_as_uint(ps), false, false); ps = __uint_as_float(rr[0]) + __uint_as_float(rr[1]); }
    l_reg = l_reg * alpha + ps;
#define PK4(P, BASE, OUT) do { unsigned a0 = cvt_pk_bf16(P[BASE + 0], P[BASE + 1]), a1 = cvt_pk_bf16(P[BASE + 2], P[BASE + 3]);   \
    unsigned b0 = cvt_pk_bf16(P[BASE + 4], P[BASE + 5]), b1 = cvt_pk_bf16(P[BASE + 6], P[BASE + 7]);                              \
    auto r0 = __builtin_amdgcn_permlane32_swap(a0, b0, false, false); auto r1 = __builtin_amdgcn_permlane32_swap(a1, b1, false, false); \
    u32x4 w = {r0[0], r1[0], r0[1], r1[1]}; OUT = *reinterpret_cast<bf16x8*>(&w); } while (0)
    PK4(p0, 0, pa0); PK4(p0, 8, pa1); PK4(p1, 0, pa2); PK4(p1, 8, pa3);
#undef PK4
}

template <int DQK, bool WIN>
__device__ __forceinline__ void attn_unit(const bf16_t* __restrict__ Qb, int ldq, const bf16_t* __restrict__ Kn, int ldk, const bf16_t* __restrict__ Kr,
                                          const bf16_t* __restrict__ Vh, int ldv, const bf16_t* __restrict__ Zb, int ldz, bf16_t* __restrict__ Ob, int ldo,
                                          int t0, int NT, int qpos0, float slope2, float sink2, char* lds) {
    constexpr int ND0 = DQK / 16;
    int tid = threadIdx.x; asm volatile("" : "+v"(tid));
    const int wid = __builtin_amdgcn_readfirstlane(tid >> 6), lane = tid & 63, r32 = lane & 31, hi = lane >> 5;
    char* V_lds = lds + OFF_V; char* Kn_lds = lds + OFF_KN; char* Kr_lds = lds + OFF_KR;
    float* ws = (float*)(lds + OFF_WS) + wid * 64; float* li_l = ws; float* al_l = ws + 32;
    float m_reg = WIN ? sink2 : -1e30f, l_reg = WIN ? 1.f : 0.f; f32x16 o[2] = {}; bf16x8 qr[ND0];
    const bf16_t* Qw = Qb + (size_t)(wid * QBLK + r32) * ldq + hi * 8;
#pragma unroll
    for (int d0 = 0; d0 < ND0; ++d0) qr[d0] = *reinterpret_cast<const bf16x8*>(Qw + d0 * 16);
    const int sr = tid >> 3, sc = (tid & 7) * 8;
    const int vst = v_st(sr, sc), knst = sr * 128 + (((tid & 7) ^ ((sr >> 1) & 7)) << 4);
    const int rr_ = (tid >> 2) & 63, rc_ = tid & 3, krst = rr_ * 64 + ((rc_ ^ ((rr_ >> 2) & 3)) << 4);
    const bool do_kr = (DQK == 96) && (wid < 4);
    const int vb0 = (int)(uintptr_t)V_lds + v_rd_base(lane);
    const int qposl = qpos0 + wid * QBLK + r32;
    struct { bf16x8 vs, ks, rs; } st_[2];
    const bf16_t* Vp = Vh + (size_t)t0 * KVBLK * ldv + (size_t)sr * ldv + sc;
    const bf16_t* Kp = Kn + (size_t)t0 * KVBLK * ldk + (size_t)sr * ldk + sc;
    const bf16_t* Rp = Kr + (size_t)t0 * KVBLK * 32 + (size_t)rr_ * 32 + rc_ * 8;
#define SLOAD(i, t) do { st_[i].vs = *reinterpret_cast<const bf16x8*>(Vp + (size_t)(t) * KVBLK * ldv); st_[i].ks = *reinterpret_cast<const bf16x8*>(Kp + (size_t)(t) * KVBLK * ldk); \
        if (do_kr) st_[i].rs = *reinterpret_cast<const bf16x8*>(Rp + (size_t)(t) * KVBLK * 32); } while (0)
#define SWRITE(b, i) do { *(bf16x8*)(V_lds + (b) * SHM_V + vst) = st_[i].vs; *(bf16x8*)(Kn_lds + (b) * SHM_KN + knst) = st_[i].ks; \
        if (do_kr) *(bf16x8*)(Kr_lds + (b) * SHM_KR + krst) = st_[i].rs; } while (0)
#define SWAIT() do { if (do_kr) asm volatile("s_waitcnt vmcnt(3)" ::: "memory"); else asm volatile("s_waitcnt vmcnt(2)" ::: "memory"); } while (0)
#define RESC(a) do { if (__any((a) < 1.f)) { if (hi == 0) al_l[r32] = (a); asm volatile("s_waitcnt lgkmcnt(0)" ::: "memory"); \
        _Pragma("unroll") for (int d = 0; d < 2; ++d) _Pragma("unroll") for (int r = 0; r < 16; ++r) o[d][r] *= al_l[crow(r, hi)]; } } while (0)
#define DREL(t) ((t0 + (t)) * KVBLK - qposl)
    f32x16 pA0, pA1, pB0, pB1; float alA = 1.f, alB = 1.f; bf16x8 pa0, pa1, pa2, pa3;
    const int wq_lo = qpos0 + wid * QBLK - 128, wq_hi = qpos0 + wid * QBLK + QBLK - 1 + 128;
#define ACT(t) (!WIN || (((t0 + (t)) * KVBLK + KVBLK - 1 >= wq_lo) && ((t0 + (t)) * KVBLK <= wq_hi)))
    SLOAD(0, 0); asm volatile("s_waitcnt vmcnt(0)" ::: "memory"); SWRITE(0, 0); __syncthreads();
    if (ACT(0)) { qkt<DQK>(pA0, pA1, Kn_lds, Kr_lds, qr, r32, hi); partialSM<WIN>(pA0, pA1, m_reg, alA, DREL(0), slope2, hi); }
    SLOAD(1, 1); if (2 < NT) SLOAD(0, 2);
    SWAIT(); SWRITE(1, 1); __syncthreads();
    for (int j = 1; j + 1 < NT; j += 2) {
        const bool a0 = ACT(j - 1), a1 = ACT(j), a2 = ACT(j + 1);
        SBAR(); if (a1) qkt<DQK>(pB0, pB1, Kn_lds + SHM_KN, Kr_lds + SHM_KR, qr, r32, hi);
        if (a0) finishSM(pA0, pA1, alA, l_reg, pa0, pa1, pa2, pa3); SBAR();
        SLOAD(1, j + 2); SBAR();
        if (a0) pv_d0(o, vb0, pa0, pa1, pa2, pa3); alB = 1.f; if (a1) partialSM<WIN>(pB0, pB1, m_reg, alB, DREL(j), slope2, hi);
        __syncthreads(); SWAIT(); SWRITE(0, 0);
        RESC(alB); __syncthreads();
        SBAR(); if (a2) qkt<DQK>(pA0, pA1, Kn_lds, Kr_lds, qr, r32, hi);
        if (a1) finishSM(pB0, pB1, alB, l_reg, pa0, pa1, pa2, pa3); SBAR();
        if (j + 3 < NT) SLOAD(0, j + 3); SBAR();
        if (a1) pv_d0(o, vb0 + SHM_V, pa0, pa1, pa2, pa3); alA = 1.f; if (a2) partialSM<WIN>(pA0, pA1, m_reg, alA, DREL(j + 1), slope2, hi);
        __syncthreads(); SWAIT(); SWRITE(1, 1);
        RESC(alA); __syncthreads();
    }
    { const bool a0 = ACT(NT - 2), a1 = ACT(NT - 1);
    SBAR(); if (a1) qkt<DQK>(pB0, pB1, Kn_lds + SHM_KN, Kr_lds + SHM_KR, qr, r32, hi);
    if (a0) finishSM(pA0, pA1, alA, l_reg, pa0, pa1, pa2, pa3); SBAR();
    if (a0) pv_d0(o, vb0, pa0, pa1, pa2, pa3); alB = 1.f; if (a1) partialSM<WIN>(pB0, pB1, m_reg, alB, DREL(NT - 1), slope2, hi);
    __syncthreads(); RESC(alB);
    if (a1) { finishSM(pB0, pB1, alB, l_reg, pa0, pa1, pa2, pa3); SBAR();
    pv_d0(o, vb0 + SHM_V, pa0, pa1, pa2, pa3); } }
#undef ACT
    if (hi == 0) li_l[r32] = l_reg; asm volatile("s_waitcnt lgkmcnt(0)" ::: "memory");
#pragma unroll
    for (int r = 0; r < 16; ++r) { const int orow = wid * QBLK + crow(r, hi); const float rl = __builtin_amdgcn_rcpf(li_l[crow(r, hi)]);
#pragma unroll
        for (int d0 = 0; d0 < 2; ++d0) { const float z = __uint_as_float((unsigned)Zb[(size_t)orow * ldz + d0 * 32 + r32] << 16);
            const unsigned w = cvt_pk_bf16(o[d0][r] * rl * z, 0.f); Ob[(size_t)orow * ldo + d0 * 32 + r32] = (bf16_t)(w & 0xffffu); } }
    __syncthreads();
#undef SLOAD
#undef SWRITE
#undef SWAIT
#undef RESC
#undef DREL
}
#undef SBAR
}

namespace mla {
constexpr int NW = 8, KSLOT = 12288, VSLOT = 8192, NKS = 4, NVS = 3;
constexpr int LDS_K = 0, LDS_V = NKS * KSLOT, LDS_WS = LDS_V + NVS * VSLOT, LDS_OST = LDS_WS + NW * 256, LDS_BYTES = LDS_OST + NW * 4096;
#define SBAR() __builtin_amdgcn_sched_barrier(0)
#define PIN(x) asm volatile("" : "+v"(x))
#define MFMA(a, b, c) __builtin_amdgcn_mfma_f32_32x32x16_bf16(a, b, c, 0, 0, 0)
#define WAIT_BAR(N) asm volatile("s_waitcnt vmcnt(" #N ") lgkmcnt(0)\n\ts_barrier" ::: "memory")
__device__ __forceinline__ int crow(int r, int hi) { return (r & 3) + 8 * (r >> 2) + 4 * hi; }
__device__ __forceinline__ unsigned cvtpk(float lo, float hi) { unsigned r; asm("v_cvt_pk_bf16_f32 %0, %1, %2" : "=v"(r) : "v"(lo), "v"(hi)); return r; }
__device__ __forceinline__ void glds16(const void* g, unsigned lds_base) {
    unsigned sv; asm volatile("s_mov_b32 %0, m0\n\ts_mov_b32 m0, %2\n\ts_nop 0\n\tglobal_load_lds_dwordx4 %1, off\n\ts_mov_b32 m0, %0" : "=&s"(sv) : "v"(g), "s"(lds_base) : "memory"); }
typedef __attribute__((address_space(3))) const char* lds_cptr;
typedef short v4i16_t __attribute__((ext_vector_type(4)));
__device__ __forceinline__ bf16x8 kld(lds_cptr p) { return *(const __attribute__((address_space(3))) bf16x8*)p; }
__device__ __forceinline__ s16x4 vtr(lds_cptr p) { return __builtin_bit_cast(s16x4, __builtin_amdgcn_ds_read_tr16_b64_v4i16((__attribute__((address_space(3))) v4i16_t*)p)); }

__device__ __forceinline__ void mla_unit(const bf16_t* __restrict__ Qu, const bf16_t* __restrict__ Knh, const bf16_t* __restrict__ Krs, const bf16_t* __restrict__ Vhh,
                                         const bf16_t* __restrict__ Zu, bf16_t* __restrict__ Ou, int NT, float kmax, char* lds) {
    int tid = threadIdx.x; asm volatile("" : "+v"(tid));
    const int lane = tid & 63, r32 = lane & 31, hi = lane >> 5; const int wid = __builtin_amdgcn_readfirstlane(tid >> 6); const bool wlow = wid < 4;
    const unsigned lds0 = (unsigned)(uintptr_t)lds; float* wsf = (float*)(lds + LDS_WS) + wid * 64;
    const bf16_t* ksrc = Knh + (size_t)lane * 512 + wid * 8;
    const bf16_t* rsrc = Krs + (size_t)lane * 32 + (wid & 3) * 8;
    const bf16_t* vsrc = Vhh + (size_t)(16 * (wid & 3) + (lane >> 2)) * 512 + (wid >> 2) * 32 + (lane & 3) * 8;
    const unsigned kdst = lds0 + LDS_K + wid * 1024, rdst = lds0 + LDS_K + (8 + (wid & 3)) * 1024, vdst = lds0 + LDS_V + wid * 1024;
#define DMA_K(t, slot) do { glds16(ksrc + (size_t)(t) * 64 * 512, (unsigned)__builtin_amdgcn_readfirstlane(kdst + (slot))); \
        if (wlow) glds16(rsrc + (size_t)(t) * 64 * 32, (unsigned)__builtin_amdgcn_readfirstlane(rdst + (slot))); } while (0)
#define DMA_V(t, slot) glds16(vsrc + (size_t)(t) * 64 * 512, (unsigned)__builtin_amdgcn_readfirstlane(vdst + (slot)))
#define WAITB(NHI, NLO) do { if (wlow) { WAIT_BAR(NLO); } else { WAIT_BAR(NHI); } } while (0)
    const lds_cptr vp0 = (lds_cptr)lds + LDS_V + ((lane >> 4) & 1) * 32 + (lane & 3) * 8 + (4 * hi + ((lane & 15) >> 2)) * 64;
    const lds_cptr kp0 = (lds_cptr)lds + LDS_K + hi * 1024 + r32 * 16;
    DMA_K(0, 0); DMA_V(0, 0); DMA_K(1, KSLOT);
    bf16x8 qr[6];
    const bf16_t* Qw = Qu + (size_t)(wid * 32 + r32) * 768 + hi * 8;
#pragma unroll
    for (int d0 = 0; d0 < 6; ++d0) qr[d0] = *reinterpret_cast<const bf16x8*>(Qw + d0 * 16);
    DMA_K(2, 2 * KSLOT);
    float qs = 0.f;
#pragma unroll
    for (int d0 = 0; d0 < 6; ++d0)
#pragma unroll
        for (int e = 0; e < 8; ++e) { const float v = __uint_as_float((unsigned)(unsigned short)qr[d0][e] << 16); qs += v * v; }
    { auto rr = __builtin_amdgcn_permlane32_swap(__float_as_uint(qs), __float_as_uint(qs), false, false); qs = __uint_as_float(rr[0]) + __uint_as_float(rr[1]); }
    const float mrow = sqrtf(qs) * kmax * 1.001f + 1e-3f;
    f32x16 negm;
#pragma unroll
    for (int r = 0; r < 16; ++r) negm[r] = -mrow;
    PIN(negm);
    float l_reg = 0.f; f32x16 o[2]; o[0] = f32x16{}; o[1] = f32x16{};
    f32x16 pA0, pA1, pB0, pB1; bf16x8 kf[12]; s16x4 vlo[8], vhi[8]; u32x4 pw0, pw1, pw2, pw3;
    int vs_prev = 0, vs_cur = 0, vs_next = VSLOT;
#define ROT() do { vs_prev = vs_cur; vs_cur = vs_next; vs_next = (vs_next == 2 * VSLOT) ? 0 : vs_next + VSLOT; } while (0)
#define KS(t) (((t) & 3) * KSLOT)
#define EX(v) __builtin_amdgcn_exp2f(v)
    WAITB(3, 5);
#pragma unroll
    for (int i = 0; i < 12; ++i) kf[i] = kld(kp0 + (i >> 1) * 2048 + (i & 1) * 512);
    pA0 = MFMA(kf[0], qr[0], negm); pA1 = MFMA(kf[1], qr[0], negm);
#pragma unroll
    for (int d0 = 1; d0 < 6; ++d0) { pA0 = MFMA(kf[2 * d0], qr[d0], pA0); pA1 = MFMA(kf[2 * d0 + 1], qr[d0], pA1); }
#pragma unroll
    for (int r = 0; r < 16; ++r) { pA0[r] = EX(pA0[r]); pA1[r] = EX(pA1[r]); }
    WAIT_BAR(0);
    DMA_K(3, 3 * KSLOT); DMA_V(1, VSLOT); ROT();
    kf[0] = kld(kp0 + KS(1)); kf[1] = kld(kp0 + KS(1) + 512);
#define PKW(P, i) cvtpk(P[i], P[i + 1])
#define PAF(k) __builtin_bit_cast(bf16x8, pw##k)
#define VFR(i) (bf16x8){vlo[i][0], vlo[i][1], vlo[i][2], vlo[i][3], vhi[i][0], vhi[i][1], vhi[i][2], vhi[i][3]}
#define VRD(i) do { vlo[i] = vtr(vp_ + (((i) >> 2) * 4096 + ((i) & 3) * 1024)); vhi[i] = vtr(vp_ + (((i) >> 2) * 4096 + ((i) & 3) * 1024 + 512)); } while (0)
#define KRD(i) do { kf[i] = kld(kp_ + ((i) >> 1) * 2048 + ((i) & 1) * 512); } while (0)
#define GAPA3(MF, a0, a1, a2, W0, PW) do { MF; sacc += a0; sacc += a1; sacc += a2; W0; PIN(PW); PIN(sacc); SBAR(); } while (0)
#define GAPA2(MF, a0, a1, W0, W1, PW) do { MF; sacc += a0; sacc += a1; W0; W1; PIN(PW); PIN(sacc); SBAR(); } while (0)
#define GAPB(MF, X, i) do { MF; X[i] = EX(X[i]); X[i + 1] = EX(X[i + 1]); X[i + 2] = EX(X[i + 2]); X[i + 3] = EX(X[i + 3]); PIN(X); SBAR(); } while (0)
#define STEP(C0, C1, P0, P1, t, GK, GV, GL) do { SBAR(); \
    const lds_cptr kp_ = kp0 + KS(t); const lds_cptr vp_ = vp0 + vs_prev; float sacc = P0[0] + P0[1]; \
    KRD(2);  SBAR(); GAPA3(C0 = MFMA(kf[0],  qr[0], negm), P0[2],  P0[3],  P0[4],  pw0[0] = PKW(P0, 0),  pw0); \
    KRD(3);  SBAR(); GAPA3(C1 = MFMA(kf[1],  qr[0], negm), P0[5],  P0[6],  P0[7],  pw0[1] = PKW(P0, 2),  pw0); \
    KRD(4);  SBAR(); GAPA3(C0 = MFMA(kf[2],  qr[1], C0),   P0[8],  P0[9],  P0[10], pw0[2] = PKW(P0, 4),  pw0); \
    KRD(5);  SBAR(); GAPA3(C1 = MFMA(kf[3],  qr[1], C1),   P0[11], P0[12], P0[13], pw0[3] = PKW(P0, 6),  pw0); \
    KRD(6);  SBAR(); GAPA3(C0 = MFMA(kf[4],  qr[2], C0),   P0[14], P0[15], P1[0],  pw1[0] = PKW(P0, 8),  pw1); \
    KRD(7);  SBAR(); GAPA3(C1 = MFMA(kf[5],  qr[2], C1),   P1[1],  P1[2],  P1[3],  pw1[1] = PKW(P0, 10), pw1); \
    KRD(8);  SBAR(); GAPA3(C0 = MFMA(kf[6],  qr[3], C0),   P1[4],  P1[5],  P1[6],  pw1[2] = PKW(P0, 12), pw1); \
    KRD(9);  SBAR(); GAPA3(C1 = MFMA(kf[7],  qr[3], C1),   P1[7],  P1[8],  P1[9],  pw1[3] = PKW(P0, 14), pw1); \
    KRD(10); SBAR(); GAPA2(C0 = MFMA(kf[8],  qr[4], C0),   P1[10], P1[11], pw2[0] = PKW(P1, 0),  pw2[1] = PKW(P1, 2),  pw2); \
    KRD(11); SBAR(); GAPA2(C1 = MFMA(kf[9],  qr[4], C1),   P1[12], P1[13], pw2[2] = PKW(P1, 4),  pw2[3] = PKW(P1, 6),  pw2); \
    VRD(0);  SBAR(); GAPA2(C0 = MFMA(kf[10], qr[5], C0),   P1[14], P1[15], pw3[0] = PKW(P1, 8),  pw3[1] = PKW(P1, 10), pw3); \
    VRD(4);  SBAR(); GAPA2(C1 = MFMA(kf[11], qr[5], C1),   0.f,    0.f,    pw3[2] = PKW(P1, 12), pw3[3] = PKW(P1, 14), pw3); \
    l_reg += sacc; \
    if (GK) DMA_K((t) + 3, KS((t) + 3)); if (GV) DMA_V((t) + 1, vs_next); \
    SBAR(); \
    VRD(1); SBAR(); GAPB(o[0] = MFMA(PAF(0), VFR(0), o[0]), C0, 0); \
    VRD(5); SBAR(); GAPB(o[1] = MFMA(PAF(0), VFR(4), o[1]), C0, 4); \
    VRD(2); SBAR(); GAPB(o[0] = MFMA(PAF(1), VFR(1), o[0]), C0, 8); \
    VRD(6); SBAR(); GAPB(o[1] = MFMA(PAF(1), VFR(5), o[1]), C0, 12); \
    VRD(3); SBAR(); GAPB(o[0] = MFMA(PAF(2), VFR(2), o[0]), C1, 0); \
    VRD(7); SBAR(); GAPB(o[1] = MFMA(PAF(2), VFR(6), o[1]), C1, 4); \
    if (GL) { kf[0] = kld(kp0 + KS((t) + 1)); kf[1] = kld(kp0 + KS((t) + 1) + 512); } SBAR(); \
                    GAPB(o[0] = MFMA(PAF(3), VFR(3), o[0]), C1, 8); \
                    GAPB(o[1] = MFMA(PAF(3), VFR(7), o[1]), C1, 12); \
    } while (0)
    int t = 1;
    for (; t + 4 < NT; t += 2) {
        STEP(pB0, pB1, pA0, pA1, t, true, true, true);     WAITB(2, 3); ROT();
        STEP(pA0, pA1, pB0, pB1, t + 1, true, true, true); WAITB(2, 3); ROT();
    }
    STEP(pB0, pB1, pA0, pA1, t, false, true, true);      WAIT_BAR(1); ROT();
    STEP(pA0, pA1, pB0, pB1, t + 1, false, true, true);  WAIT_BAR(0); ROT();
    STEP(pB0, pB1, pA0, pA1, t + 2, false, false, false);
    { float sacc = pB0[0] + pB0[1];
#pragma unroll
      for (int r = 2; r < 16; ++r) sacc += pB0[r];
#pragma unroll
      for (int r = 0; r < 16; ++r) sacc += pB1[r];
      l_reg += sacc;
      pw0 = (u32x4){PKW(pB0, 0), PKW(pB0, 2), PKW(pB0, 4), PKW(pB0, 6)}; pw1 = (u32x4){PKW(pB0, 8), PKW(pB0, 10), PKW(pB0, 12), PKW(pB0, 14)};
      pw2 = (u32x4){PKW(pB1, 0), PKW(pB1, 2), PKW(pB1, 4), PKW(pB1, 6)}; pw3 = (u32x4){PKW(pB1, 8), PKW(pB1, 10), PKW(pB1, 12), PKW(pB1, 14)};
      const lds_cptr vp_ = vp0 + vs_cur; VRD(0); VRD(4); VRD(1); VRD(5); VRD(2); VRD(6); VRD(3); VRD(7);
      o[0] = MFMA(PAF(0), VFR(0), o[0]); o[1] = MFMA(PAF(0), VFR(4), o[1]); o[0] = MFMA(PAF(1), VFR(1), o[0]); o[1] = MFMA(PAF(1), VFR(5), o[1]);
      o[0] = MFMA(PAF(2), VFR(2), o[0]); o[1] = MFMA(PAF(2), VFR(6), o[1]); o[0] = MFMA(PAF(3), VFR(3), o[0]); o[1] = MFMA(PAF(3), VFR(7), o[1]); }
    { auto rr = __builtin_amdgcn_permlane32_swap(__float_as_uint(l_reg), __float_as_uint(l_reg), false, false); l_reg = __uint_as_float(rr[0]) + __uint_as_float(rr[1]); }
    if (hi == 0) wsf[32 + r32] = l_reg; asm volatile("s_waitcnt lgkmcnt(0)" ::: "memory");
    bf16_t* stg = (bf16_t*)(lds + LDS_OST) + wid * 2048;
    const bf16_t* Zw = Zu + (size_t)(wid * 32) * 1024; bf16_t* Ow = Ou + (size_t)(wid * 32) * 512;
#pragma unroll
    for (int r = 0; r < 16; ++r) { const int orow = crow(r, hi); const float rl = __builtin_amdgcn_rcpf(wsf[32 + orow]);
#pragma unroll
        for (int d0 = 0; d0 < 2; ++d0) { const float z = __uint_as_float((unsigned)Zw[(size_t)orow * 1024 + d0 * 32 + r32] << 16);
            stg[orow * 64 + d0 * 32 + r32] = (bf16_t)(cvtpk(o[d0][r] * rl * z, 0.f) & 0xffffu); } }
    asm volatile("s_waitcnt lgkmcnt(0)" ::: "memory");
#pragma unroll
    for (int i = 0; i < 4; ++i) { const int row = i * 8 + (lane >> 3), ch = lane & 7; *(u32x4*)(Ow + (size_t)row * 512 + ch * 8) = *(const u32x4*)(stg + row * 64 + ch * 8); }
    asm volatile("s_waitcnt lgkmcnt(0)\n\ts_barrier" ::: "memory");
#undef DMA_K
#undef DMA_V
#undef WAITB
#undef ROT
#undef KS
#undef EX
#undef PKW
#undef PAF
#undef VFR
#undef VRD
#undef KRD
#undef GAPA3
#undef GAPA2
#undef GAPB
#undef STEP
}
#undef SBAR
#undef PIN
#undef MFMA
#undef WAIT_BAR
}

constexpr int NWAVES = 8;
constexpr int LDS_BYTES = 147456;
static_assert(pg8::STAGE_BYTES <= 131072 && att::LDS_BYTES <= 131072 && mla::LDS_BYTES <= 131072, "LDS map");

struct Params { const float* in[17]; float* out; unsigned char* ws; int ph_lo, ph_hi; };

__device__ const double ROPE_INV[16] = {1.0, 0.5623413251903491, 0.31622776601683794, 0.1778279410038923, 0.1, 0.05623413251903491, 0.03162277660168379, 0.01778279410038923,
                                        0.01, 0.005623413251903491, 0.0031622776601683794, 0.0017782794100389228, 0.001, 0.0005623413251903491, 0.00031622776601683794, 0.00017782794100389227};

__device__ __forceinline__ unsigned f2bf(float f) { unsigned u = __builtin_bit_cast(unsigned, f); return (u + 0x7fffu + ((u >> 16) & 1u)) >> 16; }
__device__ __forceinline__ unsigned pk2(float lo, float hi) { return f2bf(lo) | (f2bf(hi) << 16); }

__device__ __forceinline__ int wsrc_col(int kind, int n, float& cs) {
    cs = 1.f;
    if (kind == 0) {
        if (n < 1280) { if (n < 512) cs = QA_SCALE; return n; }
        if (n < 1792) return n - 1280 + 1952;
        if (n < 2432) return n - 1792 + 1280;
        if (n < 2464) { const int j = n - 2432; return 1920 + (j >> 1) + 16 * (j & 1); }
        if (n < 2560) return -1;
        return n - 2560 + 2464;
    } else if (kind == 1) {
        cs = QB_SCALE; const int h = n / 96, d = n % 96;
        if (d < 64) return h * 96 + d;
        const int j = d - 64; return h * 96 + 64 + (j >> 1) + 16 * (j & 1);
    } else if (kind == 2) {
        if (n < 512) return (n >> 6) * 128 + (n & 63);
        const int q = n - 512; return (q >> 6) * 128 + 64 + (q & 63);
    }
    return n;
}
__device__ __forceinline__ void transpose_item(const float* W, int K, int Nsrc, int Ndst, int kind, const float* kgain, bf16_t* WT, LAS float* scr, int item, int lane) {
    const int nblk = Ndst / 32, kb = item / nblk, nb = item % nblk, k0 = 64 * kb, n0 = 32 * nb;
    float cs; const int src = wsrc_col(kind, n0 + (lane & 31), cs);
#pragma unroll 8
    for (int i = 0; i < 32; ++i) { const int kk = 2 * i + (lane >> 5); float v = 0.f;
        if (src >= 0) { v = W[(size_t)(k0 + kk) * Nsrc + src] * cs; if (kgain) v *= kgain[k0 + kk]; }
        scr[kk * 33 + (lane & 31)] = v; }
    asm volatile("s_waitcnt lgkmcnt(0)" ::: "memory");
    const int c = lane & 7;
#pragma unroll
    for (int j = 0; j < 4; ++j) { const int n = (lane >> 3) + 8 * j; const LAS float* s = scr + (8 * c) * 33 + n;
        u32x4 o; o.x = pk2(s[0 * 33], s[1 * 33]); o.y = pk2(s[2 * 33], s[3 * 33]); o.z = pk2(s[4 * 33], s[5 * 33]); o.w = pk2(s[6 * 33], s[7 * 33]);
        *(u32x4*)(WT + (size_t)(n0 + n) * K + k0 + 8 * c) = o; }
    asm volatile("s_waitcnt lgkmcnt(0)" ::: "memory");
}

__global__ void __launch_bounds__(NWAVES * 64, 2) mk_fwd(Params p) {
    extern __shared__ __attribute__((aligned(16))) unsigned char lds[];
    cg::grid_group grid = cg::this_grid();
    const int G = gridDim.x, bx = blockIdx.x;
    const int vcu = (G % 8 == 0) ? (bx % 8) * (G / 8) + bx / 8 : bx;
    const int NGW = G * NWAVES;
    typedef const __attribute__((address_space(4))) Params* KP;
    const KP PP = (KP)__builtin_amdgcn_kernarg_segment_ptr();
#define PHASE_PTRS() KP q_ = PP; asm volatile("" : "+s"(q_)); unsigned char* ws = q_->ws; (void)ws; \
    const float *x_p = q_->in[0], *x_s = q_->in[1], *c_p = q_->in[2], *c_s = q_->in[3], *w_ada = q_->in[4], *b_ada = q_->in[5], *g_norm = q_->in[6], *w_in = q_->in[7], *g_q = q_->in[8], *w_uq = q_->in[9], \
                *g_kv = q_->in[10], *w_ukv = q_->in[11], *sink = q_->in[12], *w_oa = q_->in[13], *w_ob = q_->in[14], *w_out = q_->in[15], *g_final = q_->in[16]; float* outp = q_->out; \
    (void)x_p; (void)x_s; (void)c_p; (void)c_s; (void)w_ada; (void)b_ada; (void)g_norm; (void)w_in; (void)g_q; (void)w_uq; (void)g_kv; (void)w_ukv; (void)sink; (void)w_oa; (void)w_ob; (void)w_out; (void)g_final; (void)outp; \
    int tid = threadIdx.x; asm volatile("" : "+v"(tid)); const int lane = tid & 63, wave = __builtin_amdgcn_readfirstlane(tid >> 6), gw = vcu * NWAVES + wave; (void)lane; (void)wave; (void)gw; \
    float* mod = (float*)(ws + WS_MOD); f32x2* rope = (f32x2*)(ws + WS_ROPE); (void)mod; (void)rope; \
    bf16_t *Win_t = (bf16_t*)(ws + WS_WIN), *Wuq_t = (bf16_t*)(ws + WS_WUQ), *Wukv_t = (bf16_t*)(ws + WS_WUKV), *Woa_t = (bf16_t*)(ws + WS_WOA), *Wob_t = (bf16_t*)(ws + WS_WOB), *Wout_t = (bf16_t*)(ws + WS_WOUT); \
    (void)Win_t; (void)Wuq_t; (void)Wukv_t; (void)Woa_t; (void)Wob_t; (void)Wout_t; \
    float *RSQ = (float*)(ws + WS_RSQ), *RSKV = (float*)(ws + WS_RSKV); (void)RSQ; (void)RSKV; \
    bf16_t *HB = (bf16_t*)(ws + WS_R1), *YA = (bf16_t*)(ws + WS_R1), *YB = (bf16_t*)(ws + WS_R1 + 48 * MiB); (void)HB; (void)YA; (void)YB; \
    bf16_t *PA = (bf16_t*)(ws + WS_R2), *QB = (bf16_t*)(ws + WS_R2); (void)PA; (void)QB; \
    bf16_t *PZ = (bf16_t*)(ws + WS_R3), *TM = (bf16_t*)(ws + WS_R3); (void)PZ; (void)TM; \
    bf16_t *PC = (bf16_t*)(ws + WS_R4), *KN = (bf16_t*)(ws + WS_KN), *VB = (bf16_t*)(ws + WS_VB), *KR = (bf16_t*)(ws + WS_KR); (void)PC; (void)KN; (void)VB; (void)KR; \
    bf16_t* PG = (bf16_t*)outp; (void)PG;
    const int lo = p.ph_lo, hi = p.ph_hi;
#ifndef PH_MASK
#define PH_MASK 0x3ff
#endif
#define IN(k) (((PH_MASK >> (k)) & 1) && lo <= (k) && (k) < hi)
#define SEAM(k) do { if (IN(k) && IN((k) + 1)) grid.sync(); } while (0)
#ifndef REP_MASK
#define REP_MASK 0
#endif
#define REPS(k) (1 + ((REP_MASK >> (k)) & 1))
#define REPSYNC() do { if (rep_) grid.sync(); } while (0)

    if (IN(0)) { PHASE_PTRS();
        LAS float* scr = (LAS float*)((LAS unsigned char*)lds + wave * 16384);
        constexpr int I_IN = (DM / 64) * (N_IN / 32), I_UQ = (384 / 64) * (768 / 32), I_UKV = (256 / 64) * (1024 / 32), I_OA = (512 / 64) * (1024 / 32), I_OUT = (1024 / 64) * (1024 / 32);
        constexpr int NITEMS = I_IN + I_UQ + I_UKV + 2 * I_OA + I_OUT;
        for (int it = gw; it < NITEMS; it += NGW) {
            int r = it;
            if (r < I_IN) { transpose_item(w_in, DM, D_IN, N_IN, 0, nullptr, Win_t, scr, r, lane); continue; } r -= I_IN;
            if (r < I_UQ) { transpose_item(w_uq, 384, 768, 768, 1, g_q, Wuq_t, scr, r, lane); continue; } r -= I_UQ;
            if (r < I_UKV) { transpose_item(w_ukv, 256, 1024, 1024, 2, g_kv, Wukv_t, scr, r, lane); continue; } r -= I_UKV;
            if (r < I_OA) { transpose_item(w_oa, 512, 1024, 1024, 3, nullptr, Woa_t, scr, r, lane); continue; } r -= I_OA;
            if (r < I_OA) { transpose_item(w_ob, 512, 1024, 1024, 3, nullptr, Wob_t, scr, r, lane); continue; } r -= I_OA;
            transpose_item(w_out, 1024, 1024, 1024, 3, nullptr, Wout_t, scr, r, lane);
        }
        for (int it = gw; it < 16 * 48; it += NGW) { const int ks = it / 48, cgp = it % 48, col = cgp * 64 + lane; float a[NBATCH];
#pragma unroll
            for (int b = 0; b < NBATCH; ++b) a[b] = 0.f;
            for (int k = ks * 64; k < ks * 64 + 64; ++k) { const float w = w_ada[(size_t)k * 3 * DM + col];
#pragma unroll
                for (int b = 0; b < NBATCH; ++b) { const float c = (b < NB_P) ? c_p[b * DM + k] : c_s[(b - NB_P) * DM + k]; a[b] += c * sigmoidf_fast(c) * w; } }
#pragma unroll
            for (int b = 0; b < NBATCH; ++b) atomicAdd(mod + b * 3 * DM + col, a[b]);
        }
        for (int e = gw * 64 + lane; e < S_S * 16; e += NGW * 64) { const int pos = e >> 4, i = e & 15;
            const double ang = (double)pos * ROPE_INV[i]; const double n = rint(ang * 0.6366197723675814);
            const double r = (ang - n * 1.5707963267948966) - n * 6.123233995736766e-17; const double r2 = r * r;
            const double sn = r * (1.0 + r2 * (-1.0 / 6 + r2 * (1.0 / 120 + r2 * (-1.0 / 5040 + r2 * (1.0 / 362880 + r2 * (-1.0 / 39916800 + r2 * (1.0 / 6227020800.0)))))));
            const double cn = 1.0 + r2 * (-0.5 + r2 * (1.0 / 24 + r2 * (-1.0 / 720 + r2 * (1.0 / 40320 + r2 * (-1.0 / 3628800 + r2 * (1.0 / 479001600.0))))));
            const int q = (int)((long long)n & 3); double cs_, sn_;
            if (q == 0) { cs_ = cn; sn_ = sn; } else if (q == 1) { cs_ = -sn; sn_ = cn; } else if (q == 2) { cs_ = -cn; sn_ = -sn; } else { cs_ = sn; sn_ = -cn; }
            rope[e] = (f32x2){(float)cs_, (float)sn_}; }
    }
    SEAM(0);
    for (int rep_ = 0; rep_ < REPS(1); ++rep_) { REPSYNC();
    if (IN(1)) { PHASE_PTRS();
        constexpr int RPW = 24;
        for (int base = gw * RPW; base < M; base += NGW * RPW) {
            int cb = -1; f32x4 ga[4], sh[4];
            for (int row = base; row < base + RPW && row < M; row += 2) {
                const int b = batch_of_row(row);
                if (b != cb) { cb = b;
#pragma unroll
                    for (int j = 0; j < 4; ++j) { const int c = 4 * lane + 256 * j;
                        const f32x4 sc = *(const f32x4*)(mod + b * 3 * DM + DM + c) + *(const f32x4*)(b_ada + DM + c);
                        sh[j] = *(const f32x4*)(mod + b * 3 * DM + c) + *(const f32x4*)(b_ada + c);
                        ga[j] = *(const f32x4*)(g_norm + c) * (sc + 1.0f); } }
                const float* xr = row < M_P ? x_p + (size_t)row * DM : x_s + (size_t)(row - M_P) * DM;
                f32x4 v[2][4]; float s0 = 0.f, s1 = 0.f;
#pragma unroll
                for (int j = 0; j < 4; ++j) { v[0][j] = *(const f32x4*)(xr + 4 * lane + 256 * j); v[1][j] = *(const f32x4*)(xr + DM + 4 * lane + 256 * j); }
#pragma unroll
                for (int j = 0; j < 4; ++j) { s0 += (v[0][j].x * v[0][j].x + v[0][j].y * v[0][j].y) + (v[0][j].z * v[0][j].z + v[0][j].w * v[0][j].w);
                                              s1 += (v[1][j].x * v[1][j].x + v[1][j].y * v[1][j].y) + (v[1][j].z * v[1][j].z + v[1][j].w * v[1][j].w); }
                const float r0 = 1.0f / sqrtf(wave_sum(s0) * (1.f / DM) + EPS), r1 = 1.0f / sqrtf(wave_sum(s1) * (1.f / DM) + EPS);
#pragma unroll
                for (int j = 0; j < 4; ++j) { const f32x4 h0 = v[0][j] * r0 * ga[j] + sh[j], h1 = v[1][j] * r1 * ga[j] + sh[j]; u32x2 w0, w1;
                    w0.x = cvt_pk_bf16(h0.x, h0.y); w0.y = cvt_pk_bf16(h0.z, h0.w); w1.x = cvt_pk_bf16(h1.x, h1.y); w1.y = cvt_pk_bf16(h1.z, h1.w);
                    *(u32x2*)(HB + (size_t)row * DM + 4 * lane + 256 * j) = w0; *(u32x2*)(HB + (size_t)(row + 1) * DM + 4 * lane + 256 * j) = w1; }
            }
        }
    }
    }
    SEAM(1);
    for (int rep_ = 0; rep_ < REPS(2); ++rep_) { REPSYNC();
    if (IN(2)) { PHASE_PTRS();
        pg8::Gemm g{HB, Win_t, M, N_IN, DM, DM}; pg8::StaticOrder S; S.init(M, N_IN, G, bx);
        pg8::EpiProj E{PA, PZ, PC, PG};
        pg8::gemm_phase<pg8::EpiProj, 1024, 1024>((LAS unsigned char*)lds, g, S, E);
    }
    }
    SEAM(2);
    for (int rep_ = 0; rep_ < REPS(3); ++rep_) { REPSYNC();
    if (IN(3)) { PHASE_PTRS();
        for (int row = gw; row < M; row += NGW) {
            const bf16_t* pr = PC + (size_t)row * 768;
            const u32x4 a = *(const u32x4*)(pr + lane * 8); u32x4 b = (u32x4){0u, 0u, 0u, 0u};
            if (lane < 20) b = *(const u32x4*)(pr + 512 + lane * 8);
            float sa = 0.f, sb = 0.f;
#pragma unroll
            for (int e = 0; e < 4; ++e) { const float l0 = bf_lo(a[e]), h0 = bf_hi(a[e]); sa += l0 * l0 + h0 * h0; }
            if (lane < 16) {
#pragma unroll
                for (int e = 0; e < 4; ++e) { const float l0 = bf_lo(b[e]), h0 = bf_hi(b[e]); sb += l0 * l0 + h0 * h0; } }
            float sq = (lane < 48) ? sa : 0.f, skv = (lane < 48) ? 0.f : sa; skv += sb;
            sq = wave_sum(sq); skv = wave_sum(skv);
            if (lane == 0) { RSQ[row] = 1.0f / sqrtf(sq * (1.f / 384.f) + EPS); RSKV[row] = 1.0f / sqrtf(skv * (1.f / 256.f) + EPS); }
            if (lane >= 16 && lane < 20) { const int i0 = (lane - 16) * 4; const f32x4* tp = (const f32x4*)(rope + (size_t)pos_of_row(row) * 16 + i0); const f32x4 c0 = tp[0], c1 = tp[1];
                const float x0 = bf_lo(b.x), y0 = bf_hi(b.x), x1 = bf_lo(b.y), y1 = bf_hi(b.y), x2 = bf_lo(b.z), y2 = bf_hi(b.z), x3 = bf_lo(b.w), y3 = bf_hi(b.w);
                u32x4 w; w.x = cvt_pk_bf16(x0 * c0[0] - y0 * c0[1], x0 * c0[1] + y0 * c0[0]); w.y = cvt_pk_bf16(x1 * c0[2] - y1 * c0[3], x1 * c0[3] + y1 * c0[2]);
                w.z = cvt_pk_bf16(x2 * c1[0] - y2 * c1[1], x2 * c1[1] + y2 * c1[0]); w.w = cvt_pk_bf16(x3 * c1[2] - y3 * c1[3], x3 * c1[3] + y3 * c1[2]);
                *(u32x4*)(KR + (size_t)row * 32 + (lane - 16) * 8) = w; }
        }
        for (int U = vcu; U < (M / 256) * 8; U += G) { const int rb = U >> 3, h = U & 7, kvh = h >> 2; const int row0 = rb * 256;
            const int S = row0 < M_P ? S_P : S_S; const int qpos0 = pos_of_row(row0); const int seq0 = row0 - qpos0;
            const int ks = qpos0 - 128 < 0 ? 0 : qpos0 - 128, ke = qpos0 + 384 > S ? S : qpos0 + 384;
            const float slope2 = exp2f(-(float)(h + 1)) * LOG2E, sink2 = sink[h] * LOG2E;
            att::attn_unit<64, true>(PA + (size_t)row0 * 768 + h * 64, 768, PA + (size_t)seq0 * 768 + 512 + kvh * 64, 768, nullptr, PA + (size_t)seq0 * 768 + 640 + kvh * 64, 768,
                                     PZ + (size_t)row0 * 1024 + h * 64, 1024, YA + (size_t)row0 * 512 + h * 64, 512, ks / 64, (ke - ks) / 64, qpos0, slope2, sink2, (char*)lds);
        }
    }
    }
    SEAM(3);
    for (int rep_ = 0; rep_ < REPS(4); ++rep_) { REPSYNC();
    if (IN(4)) { PHASE_PTRS();
#ifndef NO_Q
        { pg8::Gemm g{PC, Wuq_t, M, 768, 384, 768}; pg8::StaticOrder S; S.init(M, 768, G, bx); pg8::EpiQ E{QB, RSQ, rope};
          pg8::gemm_phase<pg8::EpiQ, 384, 768>((LAS unsigned char*)lds, g, S, E); }
#endif
#ifndef NO_KV
        { pg8::Gemm g{PC + 384, Wukv_t, M, 1024, 256, 768}; pg8::StaticOrder S; S.init(M, 1024, G, bx); pg8::EpiKV E{KN, VB, RSKV};
          pg8::gemm_phase<pg8::EpiKV, 256, 768>((LAS unsigned char*)lds, g, S, E); }
#endif
    }
    }
    SEAM(4);
    for (int rep_ = 0; rep_ < REPS(5); ++rep_) { REPSYNC();
    if (IN(5)) { PHASE_PTRS();
        { unsigned* KMAX = (unsigned*)(ws + WS_KMAX); constexpr int RPW = 24;
          for (int base = gw * RPW; base < M; base += NGW * RPW) { int cb = -1; float mx = 0.f;
            for (int row = base; row < base + RPW && row < M; ++row) { const int b = batch_of_row(row);
                if (b != cb) { if (cb >= 0 && (lane & 7) == 0) atomicMax(KMAX + cb * 8 + (lane >> 3), __float_as_uint(mx)); cb = b; mx = 0.f; }
                const u32x4 a = *(const u32x4*)(KN + (size_t)row * 512 + lane * 8); const u32x4 r4 = *(const u32x4*)(KR + (size_t)row * 32 + (lane & 3) * 8);
                float sn = 0.f, sr = 0.f;
#pragma unroll
                for (int e = 0; e < 4; ++e) { const float l0 = bf_lo(a[e]), h0 = bf_hi(a[e]), l1 = bf_lo(r4[e]), h1 = bf_hi(r4[e]); sn += l0 * l0 + h0 * h0; sr += l1 * l1 + h1 * h1; }
                sn += __shfl_xor(sn, 1); sn += __shfl_xor(sn, 2); sn += __shfl_xor(sn, 4); sr += __shfl_xor(sr, 1); sr += __shfl_xor(sr, 2);
                mx = fmaxf(mx, sn + sr); }
            if (cb >= 0 && (lane & 7) == 0) atomicMax(KMAX + cb * 8 + (lane >> 3), __float_as_uint(mx)); }
        }
        grid.sync();
        for (int U = vcu; U < 1536; U += G) {
            int row0, seq0, S, h, b;
            if (U < 1024) { const int i = U >> 8, v = U & 255, xcd = v >> 5, c = v & 31; const int bh = 2 * xcd + (i >> 1), qb = (i & 1) * 32 + c; b = bh >> 3; h = bh & 7;
                S = S_S; seq0 = M_P + b * S_S; row0 = seq0 + qb * 256; b += NB_P; }
            else { const int U2 = U - 1024; const int j = U2 >> 8, v = U2 & 255, xcd = v >> 5, c = v & 31; const int bh = 4 * xcd + 2 * j + (c >> 4), qb = c & 15; b = bh >> 3; h = bh & 7;
                S = S_P; seq0 = b * S_P; row0 = seq0 + qb * 256; }
            const float kmax = sqrtf(__uint_as_float(__hip_atomic_load((unsigned*)(ws + WS_KMAX) + b * 8 + h, __ATOMIC_RELAXED, __HIP_MEMORY_SCOPE_AGENT)));
            mla::mla_unit(QB + (size_t)row0 * 768 + h * 96, KN + (size_t)seq0 * 512 + h * 64, KR + (size_t)seq0 * 32, VB + (size_t)seq0 * 512 + h * 64,
                          PZ + (size_t)row0 * 1024 + 512 + h * 64, YB + (size_t)row0 * 512 + h * 64, S / 64, kmax, (char*)lds);
        }
    }
    }
    SEAM(5);
    for (int rep_ = 0; rep_ < REPS(6); ++rep_) { REPSYNC();
    if (IN(6)) { PHASE_PTRS(); pg8::Gemm g{YA, Woa_t, M, 1024, 512, 512}; pg8::StaticOrder S; S.init(M, 1024, G, bx); pg8::EpiGate<true> E{TM, PG, 0};
        pg8::gemm_phase<pg8::EpiGate<true>, 512, 512>((LAS unsigned char*)lds, g, S, E); }
    SEAM(6);
    if (IN(7)) { PHASE_PTRS(); pg8::Gemm g{YB, Wob_t, M, 1024, 512, 512}; pg8::StaticOrder S; S.init(M, 1024, G, bx); pg8::EpiGate<false> E{TM, PG, 1024};
        pg8::gemm_phase<pg8::EpiGate<false>, 512, 512>((LAS unsigned char*)lds, g, S, E); }
    SEAM(7);
    }
    for (int rep_ = 0; rep_ < REPS(8); ++rep_) { REPSYNC();
    if (IN(8)) { PHASE_PTRS(); pg8::Gemm g{TM, Wout_t, M, 1024, 1024, 1024}; pg8::StaticOrder S; S.init(M, 1024, G, bx); pg8::EpiOut E{x_p, x_s, outp, mod, b_ada};
        pg8::gemm_phase<pg8::EpiOut, 1024, 1024>((LAS unsigned char*)lds, g, S, E); }
    SEAM(8);
    if (IN(9)) { PHASE_PTRS();
        f32x4 gf[4];
#pragma unroll
        for (int j = 0; j < 4; ++j) gf[j] = *(const f32x4*)(g_final + 4 * lane + 256 * j);
        for (int row = 2 * gw; row < M; row += 2 * NGW) { float* orow = outp + (size_t)row * DM; f32x4 v[2][4]; float s0 = 0.f, s1 = 0.f;
#pragma unroll
            for (int j = 0; j < 4; ++j) { v[0][j] = *(const f32x4*)(orow + 4 * lane + 256 * j); v[1][j] = *(const f32x4*)(orow + DM + 4 * lane + 256 * j); }
#pragma unroll
            for (int j = 0; j < 4; ++j) { s0 += (v[0][j].x * v[0][j].x + v[0][j].y * v[0][j].y) + (v[0][j].z * v[0][j].z + v[0][j].w * v[0][j].w);
                                          s1 += (v[1][j].x * v[1][j].x + v[1][j].y * v[1][j].y) + (v[1][j].z * v[1][j].z + v[1][j].w * v[1][j].w); }
            const float r0 = 1.0f / sqrtf(wave_sum(s0) * (1.f / DM) + EPS), r1 = 1.0f / sqrtf(wave_sum(s1) * (1.f / DM) + EPS);
#pragma unroll
            for (int j = 0; j < 4; ++j) { *(f32x4*)(orow + 4 * lane + 256 * j) = v[0][j] * r0 * gf[j]; *(f32x4*)(orow + DM + 4 * lane + 256 * j) = v[1][j] * r1 * gf[j]; }
        }
    }
    }
#undef IN
#undef SEAM
#undef PHASE_PTRS
}

extern "C" void kernel_launch(void* const* d_in, const int* in_sizes, int n_in, void* d_out, int out_size, void* d_ws, size_t ws_size, hipStream_t stream) {
    static int grid = 0;
    if (grid == 0) {
        if (n_in != 17 || out_size != M * DM || ws_size < WS_END) { fprintf(stderr, "kernel_launch: unexpected shapes: n_in %d out %d ws %zu (need %zu)\n", n_in, out_size, ws_size, (size_t)WS_END); grid = -1; return; }
        int dev = 0, cus = 0, per_cu = 0;
        hipGetDevice(&dev); hipDeviceGetAttribute(&cus, hipDeviceAttributeMultiprocessorCount, dev);
        if (hipFuncSetAttribute((const void*)mk_fwd, hipFuncAttributeMaxDynamicSharedMemorySize, LDS_BYTES) != hipSuccess) { fprintf(stderr, "kernel_launch: hipFuncSetAttribute failed\n"); grid = -1; return; }
        if (hipOccupancyMaxActiveBlocksPerMultiprocessor(&per_cu, (const void*)mk_fwd, NWAVES * 64, LDS_BYTES) != hipSuccess || per_cu < 1) { fprintf(stderr, "kernel_launch: occupancy query says %d\n", per_cu); per_cu = 1; }
        (void)hipGetLastError();
        grid = cus;
    }
    if (grid < 0) return;
    hipMemsetAsync((char*)d_ws + WS_MOD, 0, ZERO_BYTES, stream);
    Params p{};
    for (int i = 0; i < 17; ++i) p.in[i] = (const float*)d_in[i];
    p.out = (float*)d_out; p.ws = (unsigned char*)d_ws;
#if MK_N_LAUNCHES == 1
    p.ph_lo = 0; p.ph_hi = 10;
    void* args[] = {&p};
    hipError_t e = hipLaunchCooperativeKernel((const void*)mk_fwd, dim3(grid), dim3(NWAVES * 64), args, LDS_BYTES, stream);
    if (e != hipSuccess) fprintf(stderr, "cooperative launch failed: %s (grid %d)\n", hipGetErrorString(e), grid);
#else
    for (int ph = 0; ph < 10; ++ph) { p.ph_lo = ph; p.ph_hi = ph + 1; hipLaunchKernelGGL(mk_fwd, dim3(grid), dim3(NWAVES * 64), LDS_BYTES, stream, p); }
#endif
}
```

```cpp
#include <hip/hip_runtime.h>
#include <hip/hip_cooperative_groups.h>
#include <cstdio>
#include <cstdint>
namespace cg = cooperative_groups;

#ifndef MK_N_LAUNCHES
#define MK_N_LAUNCHES 1
#endif

constexpr int DM = 1024;
constexpr int NB_P = 4, S_P = 4096, NB_S = 2, S_S = 16384;
constexpr int M_P = NB_P * S_P, M_S = NB_S * S_S, M = M_P + M_S;
constexpr int D_IN = 4512, N_IN = 4608;
constexpr int NBATCH = NB_P + NB_S;
constexpr float EPS = 1e-6f;
constexpr float LOG2E = 1.4426950408889634f;
constexpr float QA_SCALE = 0.125f * LOG2E;
constexpr float QB_SCALE = 0.10206207261596575f * LOG2E;

constexpr size_t MiB = 1u << 20;
constexpr size_t WS_MOD = 0;
constexpr size_t MOD_BYTES = (size_t)NBATCH * 3 * DM * 4;
constexpr size_t WS_KMAX = WS_MOD + MOD_BYTES;
constexpr size_t WS_BAR = 80 * 1024;
constexpr size_t ZERO_BYTES = 128 * 1024;
constexpr size_t WS_ROPE = 128 * 1024;
constexpr size_t WS_WIN = WS_ROPE + 2 * MiB;
constexpr size_t WS_WUQ = WS_WIN + (size_t)N_IN * DM * 2;
constexpr size_t WS_WUKV = WS_WUQ + (size_t)768 * 384 * 2;
constexpr size_t WS_WOA = WS_WUKV + (size_t)1024 * 256 * 2;
constexpr size_t WS_WOB = WS_WOA + (size_t)1024 * 512 * 2;
constexpr size_t WS_WOUT = WS_WOB + (size_t)1024 * 512 * 2;
constexpr size_t WS_RSQ = WS_WOUT + (size_t)1024 * 1024 * 2;
constexpr size_t WS_RSKV = WS_RSQ + (size_t)M * 4;
static_assert(WS_RSKV + (size_t)M * 4 <= 20 * MiB, "small region");
constexpr size_t WS_R1 = 20 * MiB;
constexpr size_t WS_R2 = WS_R1 + 96 * MiB;
constexpr size_t WS_R3 = WS_R2 + 72 * MiB;
constexpr size_t WS_R4 = WS_R3 + 96 * MiB;
constexpr size_t WS_KN = WS_R4 + 72 * MiB;
constexpr size_t WS_VB = WS_KN + 48 * MiB;
constexpr size_t WS_KR = WS_VB + 48 * MiB;
constexpr size_t WS_END = WS_KR + 3 * MiB;

typedef unsigned short bf16_t;
typedef short bf16x8 __attribute__((ext_vector_type(8)));
typedef short s16x4 __attribute__((ext_vector_type(4)));
typedef float f32x4 __attribute__((ext_vector_type(4)));
typedef float f32x2 __attribute__((ext_vector_type(2)));
typedef float f32x16 __attribute__((ext_vector_type(16)));
typedef unsigned u32x4 __attribute__((ext_vector_type(4)));
typedef unsigned u32x2 __attribute__((ext_vector_type(2)));
#define LAS __attribute__((address_space(3)))

__device__ __forceinline__ unsigned cvt_pk_bf16(float lo, float hi) { unsigned r; asm volatile("v_cvt_pk_bf16_f32 %0, %1, %2" : "=v"(r) : "v"(lo), "v"(hi)); return r; }
__device__ __forceinline__ float bf_lo(unsigned w) { return __uint_as_float(w << 16); }
__device__ __forceinline__ float bf_hi(unsigned w) { return __uint_as_float(w & 0xffff0000u); }
__device__ __forceinline__ float sigmoidf_fast(float v) { return __builtin_amdgcn_rcpf(1.0f + __builtin_amdgcn_exp2f(-v * LOG2E)); }
__device__ __forceinline__ float wave_sum(float v) {
#pragma unroll
    for (int o = 1; o < 64; o <<= 1) v += __shfl_xor(v, o);
    return v;
}
__device__ __forceinline__ int batch_of_row(int row) { return row < M_P ? (row >> 12) : NB_P + ((row - M_P) >> 14); }
__device__ __forceinline__ int pos_of_row(int row) { return row < M_P ? (row & (S_P - 1)) : ((row - M_P) & (S_S - 1)); }

namespace pg8 {
constexpr int BM = 256, BK = 64, HALF = 128, HTB = HALF * BK * 2, STAGE_BYTES = 8 * HTB, NXCD = 8, WGM = 8;
__host__ __device__ __forceinline__ int lds_byte(int r, int c) { const int st = (r >> 4) * 2 + (c >> 5), rr = r & 15, cc = c & 31, ob = rr * 64 + cc * 2; return st * 1024 + (ob ^ (((ob >> 9) & 1) << 5)); }
__host__ __device__ __forceinline__ void stage_rc(int b, int& R, int& C) { const int st = b / 1024, sb = b % 1024, swz = sb ^ (((sb >> 9) & 1) << 5); R = (st >> 1) * 16 + swz / 64; C = (st & 1) * 32 + (swz % 64) / 2; }
__host__ __device__ __forceinline__ int perm32(int rho) { const int n = rho >> 4, i = rho & 15; return 8 * (i >> 2) + 4 * n + (i & 3); }

struct Unit { int pm, pn; };
struct Gemm { const bf16_t* A; const bf16_t* Bt; int M, N, K, lda; };

struct StaticOrder {
    int nM, nN, nwg, G, c;
    __device__ void init(int M_, int N_, int G_, int c_) { nM = M_ / BM; nN = N_ / BM; nwg = nM * nN; G = G_; c = c_; }
    __device__ bool next(int i, Unit& u) const {
        const long L = (long)i * G + c; if (L >= nwg) return false;
        int wgid = (int)L; { const int q = nwg / NXCD, r = nwg % NXCD, xcd = wgid % NXCD, off = wgid / NXCD; wgid = (xcd < r ? xcd * (q + 1) : r * (q + 1) + (xcd - r) * q) + off; }
        const int nig = WGM * nN, gid = wgid / nig, fm = gid * WGM, gsz = (nM - fm) < WGM ? (nM - fm) : WGM;
        u.pm = fm + ((wgid % nig) % gsz); u.pn = (wgid % nig) / gsz; return true;
    }
};

template <class Epi, int K, int LDA, bool ALIGN_EPI = true>
__device__ __forceinline__ void gemm_phase(LAS unsigned char* lds, const Gemm g, const StaticOrder& S, const Epi& E) {
    int tid = threadIdx.x; asm volatile("" : "+v"(tid));
    const int wid = __builtin_amdgcn_readfirstlane(tid >> 6), lane = tid & 63, wr = wid >> 2, wc = wid & 3, fr = lane & 15, fq = lane >> 4;
    constexpr int nt = K / BK, lda = LDA;
    unsigned voffA[2], voffB[2];
#pragma unroll
    for (int i = 0; i < 2; ++i) { int R, C; stage_rc(tid * 16 + i * 8192, R, C); const int Rb = (R & ~31) + perm32(R & 31);
        voffA[i] = (unsigned)(R * lda + C) * 2u; voffB[i] = (unsigned)(Rb * K + C) * 2u; }
    const size_t kstep = (size_t)(BK * 2);
    const size_t hstepA = (size_t)HALF * lda * 2, tstepA = 2 * hstepA;
    const size_t hstepB = (size_t)HALF * K * 2, tstepB = 2 * hstepB;
    const unsigned ldsw = (unsigned)wid * 1024u;
    const int aoff = lds_byte(wr * 64 + fr, fq * 8), boff = lds_byte(wc * 32 + fr, fq * 8);
#define PG8_SA(b, h) (((b) * 2 + (h)) * HTB)
#define PG8_SB(b, h) ((4 + (b) * 2 + (h)) * HTB)
#define PG8_STAGE(bufoff, gbase, voff) do { _Pragma("unroll") for (int _i = 0; _i < 2; ++_i) \
        __builtin_amdgcn_global_load_lds((const unsigned*)((const char*)(gbase) + (voff)[_i]), (LAS unsigned*)(lds + (bufoff) + ldsw + _i * 8192), 16, 0, 0); } while (0)
#define PG8_LDA(dst, b, h) do { _Pragma("unroll") for (int m = 0; m < 4; ++m) _Pragma("unroll") for (int k = 0; k < 2; ++k) dst[m][k] = *(const LAS bf16x8*)(lds + PG8_SA(b, h) + aoff + m * 2048 + k * 1024); } while (0)
#define PG8_LDB(dst, b, h) do { _Pragma("unroll") for (int n = 0; n < 2; ++n) _Pragma("unroll") for (int k = 0; k < 2; ++k) dst[n][k] = *(const LAS bf16x8*)(lds + PG8_SB(b, h) + boff + n * 2048 + k * 1024); } while (0)
#define PG8_MMA(ai, bj, At, Bt) do { __builtin_amdgcn_s_setprio(1); _Pragma("unroll") for (int m = 0; m < 4; ++m) _Pragma("unroll") for (int n = 0; n < 2; ++n) _Pragma("unroll") for (int k = 0; k < 2; ++k) \
        acc[ai][bj][m][n] = __builtin_amdgcn_mfma_f32_16x16x32_bf16(Bt[n][k], At[m][k], acc[ai][bj][m][n], 0, 0, 0); __builtin_amdgcn_s_setprio(0); } while (0)
#define PG8_WAIT_V(n) asm volatile("s_waitcnt vmcnt(" #n ")" ::: "memory")
#define PG8_WAIT_L(n) asm volatile("s_waitcnt lgkmcnt(" #n ")" ::: "memory")
#define PG8_BAR __builtin_amdgcn_s_barrier()
#define PG8_SCHED __builtin_amdgcn_sched_barrier(0)
    Unit cur, nxt; int ui = 0;
    if (!S.next(0, cur)) return;
    f32x4 acc[2][2][4][2];
#pragma unroll
    for (int a = 0; a < 2; ++a)
#pragma unroll
        for (int b = 0; b < 2; ++b)
#pragma unroll
            for (int m = 0; m < 4; ++m)
#pragma unroll
                for (int n = 0; n < 2; ++n) acc[a][b][m][n] = (f32x4){0.f, 0.f, 0.f, 0.f};
    bf16x8 At[4][2], B0[2][2], B1[2][2];
    const char* cA = (const char*)g.A + (size_t)cur.pm * tstepA; const char* cB = (const char*)g.Bt + (size_t)cur.pn * tstepB;
    PG8_STAGE(PG8_SB(0, 0), cB, voffB); PG8_STAGE(PG8_SB(0, 1), cB + hstepB, voffB); PG8_STAGE(PG8_SA(0, 0), cA, voffA); PG8_STAGE(PG8_SA(0, 1), cA + hstepA, voffA);
    if (wr == 1) PG8_BAR;
    PG8_WAIT_V(2); PG8_BAR;
    PG8_STAGE(PG8_SB(1, 0), cB + kstep, voffB); PG8_STAGE(PG8_SA(1, 0), cA + kstep, voffA); PG8_STAGE(PG8_SB(1, 1), cB + hstepB + kstep, voffB);
    PG8_WAIT_V(6); PG8_BAR;
    for (;;) {
        const bool has_next = S.next(ui + 1, nxt);
        const char* nA = has_next ? (const char*)g.A + (size_t)nxt.pm * tstepA : cA; const char* nB = has_next ? (const char*)g.Bt + (size_t)nxt.pn * tstepB : cB;
#pragma unroll 1
        for (int t = 0; t < nt; t += 2) {
            const bool last = (t == nt - 2);
            const char* a1 = cA + (size_t)(t + 1) * kstep;
            const char* a2 = last ? nA : cA + (size_t)(t + 2) * kstep; const char* b2 = last ? nB : cB + (size_t)(t + 2) * kstep;
            const char* a3 = a2 + kstep; const char* b3 = b2 + kstep;
            PG8_LDB(B0, 0, 0); PG8_LDB(B1, 0, 1); PG8_SCHED; PG8_LDA(At, 0, 0); PG8_STAGE(PG8_SA(1, 1), a1 + hstepA, voffA);
            PG8_WAIT_V(8); PG8_WAIT_L(0); PG8_BAR; PG8_MMA(0, 0, At, B0); PG8_MMA(0, 1, At, B1); PG8_BAR; PG8_SCHED;
            PG8_LDA(At, 0, 1); PG8_STAGE(PG8_SB(0, 0), b2, voffB); PG8_STAGE(PG8_SB(0, 1), b2 + hstepB, voffB); PG8_STAGE(PG8_SA(0, 0), a2, voffA);
            PG8_WAIT_V(8); PG8_WAIT_L(0); PG8_BAR; PG8_MMA(1, 0, At, B0); PG8_MMA(1, 1, At, B1); PG8_BAR; PG8_SCHED;
            PG8_LDB(B0, 1, 0); PG8_LDB(B1, 1, 1); PG8_SCHED; PG8_LDA(At, 1, 0); PG8_STAGE(PG8_SA(0, 1), a2 + hstepA, voffA);
            PG8_WAIT_V(8); PG8_WAIT_L(0); PG8_BAR; PG8_MMA(0, 0, At, B0); PG8_MMA(0, 1, At, B1); PG8_BAR; PG8_SCHED;
            PG8_LDA(At, 1, 1); PG8_STAGE(PG8_SB(1, 0), b3, voffB); PG8_STAGE(PG8_SB(1, 1), b3 + hstepB, voffB); PG8_STAGE(PG8_SA(1, 0), a3, voffA);
            PG8_WAIT_V(8); PG8_WAIT_L(0); PG8_BAR; PG8_MMA(1, 0, At, B0); PG8_MMA(1, 1, At, B1); PG8_BAR; PG8_SCHED;
        }
        if constexpr (ALIGN_EPI) { if (wr == 0) PG8_BAR; }
        E(acc, cur, wr, wc, fr, fq);
        if (!has_next) break;
#pragma unroll
        for (int a = 0; a < 2; ++a)
#pragma unroll
            for (int b = 0; b < 2; ++b)
#pragma unroll
                for (int m = 0; m < 4; ++m)
#pragma unroll
                    for (int n = 0; n < 2; ++n) acc[a][b][m][n] = (f32x4){0.f, 0.f, 0.f, 0.f};
        cur = nxt; cA = nA; cB = nB; ++ui;
        if constexpr (ALIGN_EPI) { if (wr == 1) PG8_BAR; }
    }
    PG8_WAIT_V(0);
    if constexpr (!ALIGN_EPI) { if (wr == 0) PG8_BAR; }
    PG8_BAR;
#undef PG8_SA
#undef PG8_SB
#undef PG8_STAGE
#undef PG8_LDA
#undef PG8_LDB
#undef PG8_MMA
#undef PG8_WAIT_V
#undef PG8_WAIT_L
#undef PG8_BAR
#undef PG8_SCHED
}

typedef const f32x4 (&AccRef)[2][2][4][2];
__device__ __forceinline__ u32x4 pack8(f32x4 v0, f32x4 v1) { u32x4 w; w.x = cvt_pk_bf16(v0[0], v0[1]); w.y = cvt_pk_bf16(v0[2], v0[3]); w.z = cvt_pk_bf16(v1[0], v1[1]); w.w = cvt_pk_bf16(v1[2], v1[3]); return w; }

struct EpiProj {
    bf16_t *PA, *PZ, *PC, *PG;
    __device__ __forceinline__ void operator()(AccRef acc, const Unit& u, int wr, int wc, int fr, int fq) const {
        bf16_t* base; int ldc, colt, act;
        if (u.pn < 3) { base = PA; ldc = 768; colt = u.pn * 256; act = 0; }
        else if (u.pn < 7) { base = PZ; ldc = 1024; colt = (u.pn - 3) * 256; act = 1; }
        else if (u.pn < 10) { base = PC; ldc = 768; colt = (u.pn - 7) * 256; act = 0; }
        else { base = PG; ldc = 2048; colt = (u.pn - 10) * 256; act = 2; }
        const int row0 = u.pm * BM + wr * 64 + fr, col0 = colt + wc * 32 + 8 * fq;
#pragma unroll
        for (int ai = 0; ai < 2; ++ai)
#pragma unroll
            for (int m = 0; m < 4; ++m) { bf16_t* rowp = base + (size_t)(row0 + ai * HALF + m * 16) * ldc + col0;
#pragma unroll
                for (int bj = 0; bj < 2; ++bj) { f32x4 v0 = acc[ai][bj][m][0], v1 = acc[ai][bj][m][1];
                    if (act != 0) {
#pragma unroll
                        for (int e = 0; e < 4; ++e) { const float s0 = sigmoidf_fast(v0[e]), s1 = sigmoidf_fast(v1[e]); v0[e] = (act == 1) ? v0[e] * s0 : s0; v1[e] = (act == 1) ? v1[e] * s1 : s1; }
                    }
                    *(u32x4*)(rowp + bj * HALF) = pack8(v0, v1); } }
    }
};
struct EpiQ {
    bf16_t* QB; const float* rs; const f32x2* rope;
    __device__ __forceinline__ void operator()(AccRef acc, const Unit& u, int wr, int wc, int fr, int fq) const {
        const int row0 = u.pm * BM + wr * 64 + fr; const int colb = u.pn * BM + wc * 32 + 8 * fq;
        const int dp0 = colb % 96, dp1 = (colb + HALF) % 96;
#pragma unroll
        for (int ai = 0; ai < 2; ++ai)
#pragma unroll
            for (int m = 0; m < 4; ++m) { const int row = row0 + ai * HALF + m * 16; const float r = rs[row]; const f32x2* tr = rope + (size_t)pos_of_row(row) * 16;
#pragma unroll
                for (int bj = 0; bj < 2; ++bj) { const int dp = bj ? dp1 : dp0;
                    f32x4 v0 = acc[ai][bj][m][0] * r, v1 = acc[ai][bj][m][1] * r;
                    if (dp >= 64) { const f32x4* tp = (const f32x4*)(tr + ((dp - 64) >> 1)); const f32x4 c0 = tp[0], c1 = tp[1];
                        f32x4 w0, w1;
                        w0[0] = v0[0] * c0[0] - v0[1] * c0[1]; w0[1] = v0[0] * c0[1] + v0[1] * c0[0];
                        w0[2] = v0[2] * c0[2] - v0[3] * c0[3]; w0[3] = v0[2] * c0[3] + v0[3] * c0[2];
                        w1[0] = v1[0] * c1[0] - v1[1] * c1[1]; w1[1] = v1[0] * c1[1] + v1[1] * c1[0];
                        w1[2] = v1[2] * c1[2] - v1[3] * c1[3]; w1[3] = v1[2] * c1[3] + v1[3] * c1[2];
                        v0 = w0; v1 = w1; }
                    *(u32x4*)(QB + (size_t)row * 768 + colb + bj * HALF) = pack8(v0, v1); }
                asm volatile("" ::: "memory"); }
    }
};
struct EpiKV {
    bf16_t *KN, *VB; const float* rs;
    __device__ __forceinline__ void operator()(AccRef acc, const Unit& u, int wr, int wc, int fr, int fq) const {
        bf16_t* base = (u.pn < 2) ? KN : VB; const int colt = (u.pn & 1) * 256;
        const int row0 = u.pm * BM + wr * 64 + fr, col0 = colt + wc * 32 + 8 * fq;
#pragma unroll
        for (int ai = 0; ai < 2; ++ai)
#pragma unroll
            for (int m = 0; m < 4; ++m) { const int row = row0 + ai * HALF + m * 16; const float r = rs[row]; bf16_t* rowp = base + (size_t)row * 512 + col0;
#pragma unroll
                for (int bj = 0; bj < 2; ++bj) *(u32x4*)(rowp + bj * HALF) = pack8(acc[ai][bj][m][0] * r, acc[ai][bj][m][1] * r); }
    }
};
template <bool FIRST> struct EpiGate {
    bf16_t* T; const bf16_t* PG; int goff;
    __device__ __forceinline__ void operator()(AccRef acc, const Unit& u, int wr, int wc, int fr, int fq) const {
        const int row0 = u.pm * BM + wr * 64 + fr, col0 = u.pn * BM + wc * 32 + 8 * fq;
#pragma unroll
        for (int ai = 0; ai < 2; ++ai)
#pragma unroll
            for (int m = 0; m < 4; ++m) { const int row = row0 + ai * HALF + m * 16;
#pragma unroll
                for (int bj = 0; bj < 2; ++bj) { const int col = col0 + bj * HALF;
                    const u32x4 gw = *(const u32x4*)(PG + (size_t)row * 2048 + goff + col);
                    f32x4 v0 = acc[ai][bj][m][0], v1 = acc[ai][bj][m][1];
                    v0[0] *= bf_lo(gw.x); v0[1] *= bf_hi(gw.x); v0[2] *= bf_lo(gw.y); v0[3] *= bf_hi(gw.y);
                    v1[0] *= bf_lo(gw.z); v1[1] *= bf_hi(gw.z); v1[2] *= bf_lo(gw.w); v1[3] *= bf_hi(gw.w);
                    bf16_t* tp = T + (size_t)row * 1024 + col;
                    if (!FIRST) { const u32x4 tw = *(const u32x4*)tp;
                        v0[0] += bf_lo(tw.x); v0[1] += bf_hi(tw.x); v0[2] += bf_lo(tw.y); v0[3] += bf_hi(tw.y);
                        v1[0] += bf_lo(tw.z); v1[1] += bf_hi(tw.z); v1[2] += bf_lo(tw.w); v1[3] += bf_hi(tw.w); }
                    *(u32x4*)tp = pack8(v0, v1); } }
    }
};
struct EpiOut {
    const float *xp, *xs; float* out; const float* mod; const float* b_ada;
    __device__ __forceinline__ void operator()(AccRef acc, const Unit& u, int wr, int wc, int fr, int fq) const {
        const int rowt = u.pm * BM; const int b = batch_of_row(rowt);
        const float* xbase = rowt < M_P ? xp + (size_t)rowt * DM : xs + (size_t)(rowt - M_P) * DM;
        float* obase = out + (size_t)rowt * DM;
        const int col0 = u.pn * BM + wc * 32 + 8 * fq;
        f32x4 g[2][2];
#pragma unroll
        for (int bj = 0; bj < 2; ++bj)
#pragma unroll
            for (int n = 0; n < 2; ++n) g[bj][n] = *(const f32x4*)(mod + (size_t)b * 3 * DM + 2 * DM + col0 + bj * HALF + 4 * n) + *(const f32x4*)(b_ada + 2 * DM + col0 + bj * HALF + 4 * n);
#pragma unroll
        for (int ai = 0; ai < 2; ++ai)
#pragma unroll
            for (int m = 0; m < 4; ++m) { const size_t off = (size_t)(wr * 64 + fr + ai * HALF + m * 16) * DM + col0;
#pragma unroll
                for (int bj = 0; bj < 2; ++bj)
#pragma unroll
                    for (int n = 0; n < 2; ++n) { const f32x4 xv = *(const f32x4*)(xbase + off + bj * HALF + 4 * n);
                        *(f32x4*)(obase + off + bj * HALF + 4 * n) = xv + g[bj][n] * acc[ai][bj][m][n]; } }
    }
};
}

namespace att {
constexpr int NW = 8, QBLK = 32, KVBLK = 64;
constexpr int SHM_V = 8192, SHM_KN = 8192, SHM_KR = 4096;
constexpr int OFF_V = 0, OFF_KN = 2 * SHM_V, OFF_KR = OFF_KN + 2 * SHM_KN, OFF_WS = OFF_KR + 2 * SHM_KR, LDS_BYTES = OFF_WS + NW * 64 * 4;
constexpr float THR2 = 8.0f;
#define SBAR() __builtin_amdgcn_sched_barrier(0)
__device__ __forceinline__ int crow(int r, int hi) { return (r & 3) + 8 * (r >> 2) + 4 * hi; }
__device__ __forceinline__ int v_st(int k, int c) { const int kk = (k & ~0xC) | ((k & 4) << 1) | ((k & 8) >> 1); return ((kk >> 3) * 2 + (c >> 5)) * 512 + ((kk & 7) * 32 + (c & 31)) * 2; }
__device__ __forceinline__ int v_rd_base(int lane) { return ((lane & 3) << 3) | (((lane >> 2) & 3) << 6) | (((lane >> 4) & 1) << 5) | (((lane >> 5) & 1) << 8); }
constexpr int v_rd_off(int d0, int ks, int half) { return d0 * 512 + ks * 2048 + half * 1024; }
template <int OFF> __device__ __forceinline__ s16x4 tr_read(int vb) { s16x4 r; asm volatile("ds_read_b64_tr_b16 %0, %1 offset:%2" : "=&v"(r) : "v"(vb), "i"(OFF) : "memory"); return r; }
template <int D0> __device__ __forceinline__ void pv_one(f32x16& od, int vb, bf16x8 pa0, bf16x8 pa1, bf16x8 pa2, bf16x8 pa3) {
    const s16x4 l0 = tr_read<v_rd_off(D0, 0, 0)>(vb), h0 = tr_read<v_rd_off(D0, 0, 1)>(vb), l1 = tr_read<v_rd_off(D0, 1, 0)>(vb), h1 = tr_read<v_rd_off(D0, 1, 1)>(vb);
    const s16x4 l2 = tr_read<v_rd_off(D0, 2, 0)>(vb), h2 = tr_read<v_rd_off(D0, 2, 1)>(vb), l3 = tr_read<v_rd_off(D0, 3, 0)>(vb), h3 = tr_read<v_rd_off(D0, 3, 1)>(vb);
    asm volatile("s_waitcnt lgkmcnt(0)" ::: "memory"); SBAR();
#define PK(L, H) (bf16x8){L[0], L[1], L[2], L[3], H[0], H[1], H[2], H[3]}
    od = __builtin_amdgcn_mfma_f32_32x32x16_bf16(pa0, PK(l0, h0), od, 0, 0, 0);
    od = __builtin_amdgcn_mfma_f32_32x32x16_bf16(pa1, PK(l1, h1), od, 0, 0, 0);
    od = __builtin_amdgcn_mfma_f32_32x32x16_bf16(pa2, PK(l2, h2), od, 0, 0, 0);
    od = __builtin_amdgcn_mfma_f32_32x32x16_bf16(pa3, PK(l3, h3), od, 0, 0, 0);
#undef PK
}
__device__ __forceinline__ void pv_d0(f32x16* o, int vb, bf16x8 pa0, bf16x8 pa1, bf16x8 pa2, bf16x8 pa3) { pv_one<0>(o[0], vb, pa0, pa1, pa2, pa3); pv_one<1>(o[1], vb, pa0, pa1, pa2, pa3); }

template <int DQK> __device__ __forceinline__ void qkt(f32x16& p0, f32x16& p1, const char* Kn_s, const char* Kr_s, const bf16x8* qr, int r32, int hi) {
    p0 = f32x16{}; p1 = f32x16{};
    const int keyn = (r32 >> 1) & 7, keyr = (r32 >> 2) & 3;
#pragma unroll
    for (int d0 = 0; d0 < 4; ++d0) { const int off = r32 * 128 + (((2 * d0 + hi) ^ keyn) << 4);
        const bf16x8 b0 = *reinterpret_cast<const bf16x8*>(Kn_s + off), b1 = *reinterpret_cast<const bf16x8*>(Kn_s + off + 32 * 128);
        p0 = __builtin_amdgcn_mfma_f32_32x32x16_bf16(b0, qr[d0], p0, 0, 0, 0);
        p1 = __builtin_amdgcn_mfma_f32_32x32x16_bf16(b1, qr[d0], p1, 0, 0, 0); }
    if constexpr (DQK == 96) {
#pragma unroll
        for (int d0 = 0; d0 < 2; ++d0) { const int off = r32 * 64 + (((2 * d0 + hi) ^ keyr) << 4);
            const bf16x8 b0 = *reinterpret_cast<const bf16x8*>(Kr_s + off), b1 = *reinterpret_cast<const bf16x8*>(Kr_s + off + 32 * 64);
            p0 = __builtin_amdgcn_mfma_f32_32x32x16_bf16(b0, qr[4 + d0], p0, 0, 0, 0);
            p1 = __builtin_amdgcn_mfma_f32_32x32x16_bf16(b1, qr[4 + d0], p1, 0, 0, 0); }
    }
}
template <bool WIN> __device__ __forceinline__ void partialSM(f32x16& p0, f32x16& p1, float& m_reg, float& alpha, int drel, float slope2, int hi) {
    if constexpr (WIN) {
#pragma unroll
        for (int r = 0; r < 16; ++r) { const int d0_ = drel + crow(r, hi), d1_ = d0_ + 32; const float a0 = fabsf((float)d0_), a1 = fabsf((float)d1_);
            p0[r] = (a0 <= 128.f) ? p0[r] - slope2 * a0 : -1e30f; p1[r] = (a1 <= 128.f) ? p1[r] - slope2 * a1 : -1e30f; }
    }
    float pmax = p0[0];
#pragma unroll
    for (int r = 1; r < 16; ++r) pmax = fmaxf(pmax, p0[r]);
#pragma unroll
    for (int r = 0; r < 16; ++r) pmax = fmaxf(pmax, p1[r]);
    { auto rr = __builtin_amdgcn_permlane32_swap(__float_as_uint(pmax), __float_as_uint(pmax), false, false); pmax = fmaxf(__uint_as_float(rr[0]), __uint_as_float(rr[1])); }
    float mn;
    if (__builtin_expect(__all(pmax - m_reg <= THR2), 1)) { mn = m_reg; alpha = 1.f; }
    else { mn = fmaxf(m_reg, pmax); alpha = __builtin_amdgcn_exp2f(m_reg - mn); m_reg = mn; }
#pragma unroll
    for (int r = 0; r < 16; ++r) { p0[r] = p0[r] - mn; p1[r] = p1[r] - mn; }
#pragma unroll
    for (int r = 0; r < 16; ++r) p0[r] = __builtin_amdgcn_exp2f(p0[r]);
}
__device__ __forceinline__ void finishSM(f32x16& p0, f32x16& p1, float alpha, float& l_reg, bf16x8& pa0, bf16x8& pa1, bf16x8& pa2, bf16x8& pa3) {
#pragma unroll
    for (int r = 0; r < 16; ++r) p1[r] = __builtin_amdgcn_exp2f(p1[r]);
    float ps = 0;
#pragma unroll
    for (int r = 0; r < 16; ++r) ps += p0[r];
#pragma unroll
    for (int r = 0; r < 16; ++r) ps += p1[r];
    { auto rr = __builtin_amdgcn_permlane32_swap(__float_as_uint(ps), __float_as_uint(ps), false, false); ps = __uint_as_float(rr[0]) + __uint_as_float(rr[1]); }
    l_reg = l_reg * alpha + ps;
#define PK4(P, BASE, OUT) do { unsigned a0 = cvt_pk_bf16(P[BASE + 0], P[BASE + 1]), a1 = cvt_pk_bf16(P[BASE + 2], P[BASE + 3]);   \
    unsigned b0 = cvt_pk_bf16(P[BASE + 4], P[BASE + 5]), b1 = cvt_pk_bf16(P[BASE + 6], P[BASE + 7]);                              \
    auto r0 = __builtin_amdgcn_permlane32_swap(a0, b0, false, false); auto r1 = __builtin_amdgcn_permlane32_swap(a1, b1, false, false); \
    u32x4 w = {r0[0], r1[0], r0[1], r1[1]}; OUT = *reinterpret_cast<bf16x8*>(&w); } while (0)
    PK4(p0, 0, pa0); PK4(p0, 8, pa1); PK4(p1, 0, pa2); PK4(p1, 8, pa3);
#undef PK4
}

template <int DQK, bool WIN>
__device__ __forceinline__ void attn_unit(const bf16_t* __restrict__ Qb, int ldq, const bf16_t* __restrict__ Kn, int ldk, const bf16_t* __restrict__ Kr,
                                          const bf16_t* __restrict__ Vh, int ldv, const bf16_t* __restrict__ Zb, int ldz, bf16_t* __restrict__ Ob, int ldo,
                                          int t0, int NT, int qpos0, float slope2, float sink2, char* lds) {
    constexpr int ND0 = DQK / 16;
    int tid = threadIdx.x; asm volatile("" : "+v"(tid));
    const int wid = __builtin_amdgcn_readfirstlane(tid >> 6), lane = tid & 63, r32 = lane & 31, hi = lane >> 5;
    char* V_lds = lds + OFF_V; char* Kn_lds = lds + OFF_KN; char* Kr_lds = lds + OFF_KR;
    float* ws = (float*)(lds + OFF_WS) + wid * 64; float* li_l = ws; float* al_l = ws + 32;
    float m_reg = WIN ? sink2 : -1e30f, l_reg = WIN ? 1.f : 0.f; f32x16 o[2] = {}; bf16x8 qr[ND0];
    const bf16_t* Qw = Qb + (size_t)(wid * QBLK + r32) * ldq + hi * 8;
#pragma unroll
    for (int d0 = 0; d0 < ND0; ++d0) qr[d0] = *reinterpret_cast<const bf16x8*>(Qw + d0 * 16);
    const int sr = tid >> 3, sc = (tid & 7) * 8;
    const int vst = v_st(sr, sc), knst = sr * 128 + (((tid & 7) ^ ((sr >> 1) & 7)) << 4);
    const int rr_ = (tid >> 2) & 63, rc_ = tid & 3, krst = rr_ * 64 + ((rc_ ^ ((rr_ >> 2) & 3)) << 4);
    const bool do_kr = (DQK == 96) && (wid < 4);
    const int vb0 = (int)(uintptr_t)V_lds + v_rd_base(lane);
    const int qposl = qpos0 + wid * QBLK + r32;
    struct { bf16x8 vs, ks, rs; } st_[2];
    const bf16_t* Vp = Vh + (size_t)t0 * KVBLK * ldv + (size_t)sr * ldv + sc;
    const bf16_t* Kp = Kn + (size_t)t0 * KVBLK * ldk + (size_t)sr * ldk + sc;
    const bf16_t* Rp = Kr + (size_t)t0 * KVBLK * 32 + (size_t)rr_ * 32 + rc_ * 8;
#define SLOAD(i, t) do { st_[i].vs = *reinterpret_cast<const bf16x8*>(Vp + (size_t)(t) * KVBLK * ldv); st_[i].ks = *reinterpret_cast<const bf16x8*>(Kp + (size_t)(t) * KVBLK * ldk); \
        if (do_kr) st_[i].rs = *reinterpret_cast<const bf16x8*>(Rp + (size_t)(t) * KVBLK * 32); } while (0)
#define SWRITE(b, i) do { *(bf16x8*)(V_lds + (b) * SHM_V + vst) = st_[i].vs; *(bf16x8*)(Kn_lds + (b) * SHM_KN + knst) = st_[i].ks; \
        if (do_kr) *(bf16x8*)(Kr_lds + (b) * SHM_KR + krst) = st_[i].rs; } while (0)
#define SWAIT() do { if (do_kr) asm volatile("s_waitcnt vmcnt(3)" ::: "memory"); else asm volatile("s_waitcnt vmcnt(2)" ::: "memory"); } while (0)
#define RESC(a) do { if (__any((a) < 1.f)) { if (hi == 0) al_l[r32] = (a); asm volatile("s_waitcnt lgkmcnt(0)" ::: "memory"); \
        _Pragma("unroll") for (int d = 0; d < 2; ++d) _Pragma("unroll") for (int r = 0; r < 16; ++r) o[d][r] *= al_l[crow(r, hi)]; } } while (0)
#define DREL(t) ((t0 + (t)) * KVBLK - qposl)
    f32x16 pA0, pA1, pB0, pB1; float alA = 1.f, alB = 1.f; bf16x8 pa0, pa1, pa2, pa3;
    const int wq_lo = qpos0 + wid * QBLK - 128, wq_hi = qpos0 + wid * QBLK + QBLK - 1 + 128;
#define ACT(t) (!WIN || (((t0 + (t)) * KVBLK + KVBLK - 1 >= wq_lo) && ((t0 + (t)) * KVBLK <= wq_hi)))
    SLOAD(0, 0); asm volatile("s_waitcnt vmcnt(0)" ::: "memory"); SWRITE(0, 0); __syncthreads();
    if (ACT(0)) { qkt<DQK>(pA0, pA1, Kn_lds, Kr_lds, qr, r32, hi); partialSM<WIN>(pA0, pA1, m_reg, alA, DREL(0), slope2, hi); }
    SLOAD(1, 1); if (2 < NT) SLOAD(0, 2);
    SWAIT(); SWRITE(1, 1); __syncthreads();
    for (int j = 1; j + 1 < NT; j += 2) {
        const bool a0 = ACT(j - 1), a1 = ACT(j), a2 = ACT(j + 1);
        SBAR(); if (a1) qkt<DQK>(pB0, pB1, Kn_lds + SHM_KN, Kr_lds + SHM_KR, qr, r32, hi);
        if (a0) finishSM(pA0, pA1, alA, l_reg, pa0, pa1, pa2, pa3); SBAR();
        SLOAD(1, j + 2); SBAR();
        if (a0) pv_d0(o, vb0, pa0, pa1, pa2, pa3); alB = 1.f; if (a1) partialSM<WIN>(pB0, pB1, m_reg, alB, DREL(j), slope2, hi);
        __syncthreads(); SWAIT(); SWRITE(0, 0);
        RESC(alB); __syncthreads();
        SBAR(); if (a2) qkt<DQK>(pA0, pA1, Kn_lds, Kr_lds, qr, r32, hi);
        if (a1) finishSM(pB0, pB1, alB, l_reg, pa0, pa1, pa2, pa3); SBAR();
        if (j + 3 < NT) SLOAD(0, j + 3); SBAR();
        if (a1) pv_d0(o, vb0 + SHM_V, pa0, pa1, pa2, pa3); alA = 1.f; if (a2) partialSM<WIN>(pA0, pA1, m_reg, alA, DREL(j + 1), slope2, hi);
        __syncthreads(); SWAIT(); SWRITE(1, 1);
        RESC(alA); __syncthreads();
    }
    { const bool a0 = ACT(NT - 2), a1 = ACT(NT - 1);
    SBAR(); if (a1) qkt<DQK>(pB0, pB1, Kn_lds + SHM_KN, Kr_lds + SHM_KR, qr, r32, hi);
    if (a0) finishSM(pA0, pA1, alA, l_reg, pa0, pa1, pa2, pa3); SBAR();
    if (a0) pv_d0(o, vb0, pa0, pa1, pa2, pa3); alB = 1.f; if (a1) partialSM<WIN>(pB0, pB1, m_reg, alB, DREL(NT - 1), slope2, hi);
    __syncthreads(); RESC(alB);
    if (a1) { finishSM(pB0, pB1, alB, l_reg, pa0, pa1, pa2, pa3); SBAR();
    pv_d0(o, vb0 + SHM_V, pa0, pa1, pa2, pa3); } }
#undef ACT
    if (hi == 0) li_l[r32] = l_reg; asm volatile("s_waitcnt lgkmcnt(0)" ::: "memory");
#pragma unroll
    for (int r = 0; r < 16; ++r) { const int orow = wid * QBLK + crow(r, hi); const float rl = __builtin_amdgcn_rcpf(li_l[crow(r, hi)]);
#pragma unroll
        for (int d0 = 0; d0 < 2; ++d0) { const float z = __uint_as_float((unsigned)Zb[(size_t)orow * ldz + d0 * 32 + r32] << 16);
            const unsigned w = cvt_pk_bf16(o[d0][r] * rl * z, 0.f); Ob[(size_t)orow * ldo + d0 * 32 + r32] = (bf16_t)(w & 0xffffu); } }
    __syncthreads();
#undef SLOAD
#undef SWRITE
#undef SWAIT
#undef RESC
#undef DREL
}
#undef SBAR
}

namespace mla {
constexpr int NW = 8, KSLOT = 12288, VSLOT = 8192, NKS = 4, NVS = 3;
constexpr int LDS_K = 0, LDS_V = NKS * KSLOT, LDS_WS = LDS_V + NVS * VSLOT, LDS_OST = LDS_WS + NW * 256, LDS_BYTES = LDS_OST + NW * 4096;
#define SBAR() __builtin_amdgcn_sched_barrier(0)
#define PIN(x) asm volatile("" : "+v"(x))
#define MFMA(a, b, c) __builtin_amdgcn_mfma_f32_32x32x16_bf16(a, b, c, 0, 0, 0)
#define WAIT_BAR(N) asm volatile("s_waitcnt vmcnt(" #N ") lgkmcnt(0)\n\ts_barrier" ::: "memory")
__device__ __forceinline__ int crow(int r, int hi) { return (r & 3) + 8 * (r >> 2) + 4 * hi; }
__device__ __forceinline__ unsigned cvtpk(float lo, float hi) { unsigned r; asm("v_cvt_pk_bf16_f32 %0, %1, %2" : "=v"(r) : "v"(lo), "v"(hi)); return r; }
__device__ __forceinline__ void glds16(const void* g, unsigned lds_base) {
    unsigned sv; asm volatile("s_mov_b32 %0, m0\n\ts_mov_b32 m0, %2\n\ts_nop 0\n\tglobal_load_lds_dwordx4 %1, off\n\ts_mov_b32 m0, %0" : "=&s"(sv) : "v"(g), "s"(lds_base) : "memory"); }
typedef __attribute__((address_space(3))) const char* lds_cptr;
typedef short v4i16_t __attribute__((ext_vector_type(4)));
__device__ __forceinline__ bf16x8 kld(lds_cptr p) { return *(const __attribute__((address_space(3))) bf16x8*)p; }
__device__ __forceinline__ s16x4 vtr(lds_cptr p) { return __builtin_bit_cast(s16x4, __builtin_amdgcn_ds_read_tr16_b64_v4i16((__attribute__((address_space(3))) v4i16_t*)p)); }

__device__ __forceinline__ void mla_unit(const bf16_t* __restrict__ Qu, const bf16_t* __restrict__ Knh, const bf16_t* __restrict__ Krs, const bf16_t* __restrict__ Vhh,
                                         const bf16_t* __restrict__ Zu, bf16_t* __restrict__ Ou, int NT, float kmax, char* lds) {
    int tid = threadIdx.x; asm volatile("" : "+v"(tid));
    const int lane = tid & 63, r32 = lane & 31, hi = lane >> 5; const int wid = __builtin_amdgcn_readfirstlane(tid >> 6); const bool wlow = wid < 4;
    const unsigned lds0 = (unsigned)(uintptr_t)lds; float* wsf = (float*)(lds + LDS_WS) + wid * 64;
    const bf16_t* ksrc = Knh + (size_t)lane * 512 + wid * 8;
    const bf16_t* rsrc = Krs + (size_t)lane * 32 + (wid & 3) * 8;
    const bf16_t* vsrc = Vhh + (size_t)(16 * (wid & 3) + (lane >> 2)) * 512 + (wid >> 2) * 32 + (lane & 3) * 8;
    const unsigned kdst = lds0 + LDS_K + wid * 1024, rdst = lds0 + LDS_K + (8 + (wid & 3)) * 1024, vdst = lds0 + LDS_V + wid * 1024;
#define DMA_K(t, slot) do { glds16(ksrc + (size_t)(t) * 64 * 512, (unsigned)__builtin_amdgcn_readfirstlane(kdst + (slot))); \
        if (wlow) glds16(rsrc + (size_t)(t) * 64 * 32, (unsigned)__builtin_amdgcn_readfirstlane(rdst + (slot))); } while (0)
#define DMA_V(t, slot) glds16(vsrc + (size_t)(t) * 64 * 512, (unsigned)__builtin_amdgcn_readfirstlane(vdst + (slot)))
#define WAITB(NHI, NLO) do { if (wlow) { WAIT_BAR(NLO); } else { WAIT_BAR(NHI); } } while (0)
    const lds_cptr vp0 = (lds_cptr)lds + LDS_V + ((lane >> 4) & 1) * 32 + (lane & 3) * 8 + (4 * hi + ((lane & 15) >> 2)) * 64;
    const lds_cptr kp0 = (lds_cptr)lds + LDS_K + hi * 1024 + r32 * 16;
    DMA_K(0, 0); DMA_V(0, 0); DMA_K(1, KSLOT);
    bf16x8 qr[6];
    const bf16_t* Qw = Qu + (size_t)(wid * 32 + r32) * 768 + hi * 8;
#pragma unroll
    for (int d0 = 0; d0 < 6; ++d0) qr[d0] = *reinterpret_cast<const bf16x8*>(Qw + d0 * 16);
    DMA_K(2, 2 * KSLOT);
    float qs = 0.f;
#pragma unroll
    for (int d0 = 0; d0 < 6; ++d0)
#pragma unroll
        for (int e = 0; e < 8; ++e) { const float v = __uint_as_float((unsigned)(unsigned short)qr[d0][e] << 16); qs += v * v; }
    { auto rr = __builtin_amdgcn_permlane32_swap(__float_as_uint(qs), __float_as_uint(qs), false, false); qs = __uint_as_float(rr[0]) + __uint_as_float(rr[1]); }
    const float mrow = sqrtf(qs) * kmax * 1.001f + 1e-3f;
    f32x16 negm;
#pragma unroll
    for (int r = 0; r < 16; ++r) negm[r] = -mrow;
    PIN(negm);
    float l_reg = 0.f; f32x16 o[2]; o[0] = f32x16{}; o[1] = f32x16{};
    f32x16 pA0, pA1, pB0, pB1; bf16x8 kf[12]; s16x4 vlo[8], vhi[8]; u32x4 pw0, pw1, pw2, pw3;
    int vs_prev = 0, vs_cur = 0, vs_next = VSLOT;
#define ROT() do { vs_prev = vs_cur; vs_cur = vs_next; vs_next = (vs_next == 2 * VSLOT) ? 0 : vs_next + VSLOT; } while (0)
#define KS(t) (((t) & 3) * KSLOT)
#define EX(v) __builtin_amdgcn_exp2f(v)
    WAITB(3, 5);
#pragma unroll
    for (int i = 0; i < 12; ++i) kf[i] = kld(kp0 + (i >> 1) * 2048 + (i & 1) * 512);
    pA0 = MFMA(kf[0], qr[0], negm); pA1 = MFMA(kf[1], qr[0], negm);
#pragma unroll
    for (int d0 = 1; d0 < 6; ++d0) { pA0 = MFMA(kf[2 * d0], qr[d0], pA0); pA1 = MFMA(kf[2 * d0 + 1], qr[d0], pA1); }
#pragma unroll
    for (int r = 0; r < 16; ++r) { pA0[r] = EX(pA0[r]); pA1[r] = EX(pA1[r]); }
    WAIT_BAR(0);
    DMA_K(3, 3 * KSLOT); DMA_V(1, VSLOT); ROT();
    kf[0] = kld(kp0 + KS(1)); kf[1] = kld(kp0 + KS(1) + 512);
#define PKW(P, i) cvtpk(P[i], P[i + 1])
#define PAF(k) __builtin_bit_cast(bf16x8, pw##k)
#define VFR(i) (bf16x8){vlo[i][0], vlo[i][1], vlo[i][2], vlo[i][3], vhi[i][0], vhi[i][1], vhi[i][2], vhi[i][3]}
#define VRD(i) do { vlo[i] = vtr(vp_ + (((i) >> 2) * 4096 + ((i) & 3) * 1024)); vhi[i] = vtr(vp_ + (((i) >> 2) * 4096 + ((i) & 3) * 1024 + 512)); } while (0)
#define KRD(i) do { kf[i] = kld(kp_ + ((i) >> 1) * 2048 + ((i) & 1) * 512); } while (0)
#define GAPA3(MF, a0, a1, a2, W0, PW) do { MF; sacc += a0; sacc += a1; sacc += a2; W0; PIN(PW); PIN(sacc); SBAR(); } while (0)
#define GAPA2(MF, a0, a1, W0, W1, PW) do { MF; sacc += a0; sacc += a1; W0; W1; PIN(PW); PIN(sacc); SBAR(); } while (0)
#define GAPB(MF, X, i) do { MF; X[i] = EX(X[i]); X[i + 1] = EX(X[i + 1]); X[i + 2] = EX(X[i + 2]); X[i + 3] = EX(X[i + 3]); PIN(X); SBAR(); } while (0)
#define STEP(C0, C1, P0, P1, t, GK, GV, GL) do { SBAR(); \
    const lds_cptr kp_ = kp0 + KS(t); const lds_cptr vp_ = vp0 + vs_prev; float sacc = P0[0] + P0[1]; \
    KRD(2);  SBAR(); GAPA3(C0 = MFMA(kf[0],  qr[0], negm), P0[2],  P0[3],  P0[4],  pw0[0] = PKW(P0, 0),  pw0); \
    KRD(3);  SBAR(); GAPA3(C1 = MFMA(kf[1],  qr[0], negm), P0[5],  P0[6],  P0[7],  pw0[1] = PKW(P0, 2),  pw0); \
    KRD(4);  SBAR(); GAPA3(C0 = MFMA(kf[2],  qr[1], C0),   P0[8],  P0[9],  P0[10], pw0[2] = PKW(P0, 4),  pw0); \
    KRD(5);  SBAR(); GAPA3(C1 = MFMA(kf[3],  qr[1], C1),   P0[11], P0[12], P0[13], pw0[3] = PKW(P0, 6),  pw0); \
    KRD(6);  SBAR(); GAPA3(C0 = MFMA(kf[4],  qr[2], C0),   P0[14], P0[15], P1[0],  pw1[0] = PKW(P0, 8),  pw1); \
    KRD(7);  SBAR(); GAPA3(C1 = MFMA(kf[5],  qr[2], C1),   P1[1],  P1[2],  P1[3],  pw1[1] = PKW(P0, 10), pw1); \
    KRD(8);  SBAR(); GAPA3(C0 = MFMA(kf[6],  qr[3], C0),   P1[4],  P1[5],  P1[6],  pw1[2] = PKW(P0, 12), pw1); \
    KRD(9);  SBAR(); GAPA3(C1 = MFMA(kf[7],  qr[3], C1),   P1[7],  P1[8],  P1[9],  pw1[3] = PKW(P0, 14), pw1); \
    KRD(10); SBAR(); GAPA2(C0 = MFMA(kf[8],  qr[4], C0),   P1[10], P1[11], pw2[0] = PKW(P1, 0),  pw2[1] = PKW(P1, 2),  pw2); \
    KRD(11); SBAR(); GAPA2(C1 = MFMA(kf[9],  qr[4], C1),   P1[12], P1[13], pw2[2] = PKW(P1, 4),  pw2[3] = PKW(P1, 6),  pw2); \
    VRD(0);  SBAR(); GAPA2(C0 = MFMA(kf[10], qr[5], C0),   P1[14], P1[15], pw3[0] = PKW(P1, 8),  pw3[1] = PKW(P1, 10), pw3); \
    VRD(4);  SBAR(); GAPA2(C1 = MFMA(kf[11], qr[5], C1),   0.f,    0.f,    pw3[2] = PKW(P1, 12), pw3[3] = PKW(P1, 14), pw3); \
    l_reg += sacc; \
    if (GK) DMA_K((t) + 3, KS((t) + 3)); if (GV) DMA_V((t) + 1, vs_next); \
    SBAR(); \
    VRD(1); SBAR(); GAPB(o[0] = MFMA(PAF(0), VFR(0), o[0]), C0, 0); \
    VRD(5); SBAR(); GAPB(o[1] = MFMA(PAF(0), VFR(4), o[1]), C0, 4); \
    VRD(2); SBAR(); GAPB(o[0] = MFMA(PAF(1), VFR(1), o[0]), C0, 8); \
    VRD(6); SBAR(); GAPB(o[1] = MFMA(PAF(1), VFR(5), o[1]), C0, 12); \
    VRD(3); SBAR(); GAPB(o[0] = MFMA(PAF(2), VFR(2), o[0]), C1, 0); \
    VRD(7); SBAR(); GAPB(o[1] = MFMA(PAF(2), VFR(6), o[1]), C1, 4); \
    if (GL) { kf[0] = kld(kp0 + KS((t) + 1)); kf[1] = kld(kp0 + KS((t) + 1) + 512); } SBAR(); \
                    GAPB(o[0] = MFMA(PAF(3), VFR(3), o[0]), C1, 8); \
                    GAPB(o[1] = MFMA(PAF(3), VFR(7), o[1]), C1, 12); \
    } while (0)
    int t = 1;
    for (; t + 4 < NT; t += 2) {
        STEP(pB0, pB1, pA0, pA1, t, true, true, true);     WAITB(2, 3); ROT();
        STEP(pA0, pA1, pB0, pB1, t + 1, true, true, true); WAITB(2, 3); ROT();
    }
    STEP(pB0, pB1, pA0, pA1, t, false, true, true);      WAIT_BAR(1); ROT();
    STEP(pA0, pA1, pB0, pB1, t + 1, false, true, true);  WAIT_BAR(0); ROT();
    STEP(pB0, pB1, pA0, pA1, t + 2, false, false, false);
    { float sacc = pB0[0] + pB0[1];
#pragma unroll
      for (int r = 2; r < 16; ++r) sacc += pB0[r];
#pragma unroll
      for (int r = 0; r < 16; ++r) sacc += pB1[r];
      l_reg += sacc;
      pw0 = (u32x4){PKW(pB0, 0), PKW(pB0, 2), PKW(pB0, 4), PKW(pB0, 6)}; pw1 = (u32x4){PKW(pB0, 8), PKW(pB0, 10), PKW(pB0, 12), PKW(pB0, 14)};
      pw2 = (u32x4){PKW(pB1, 0), PKW(pB1, 2), PKW(pB1, 4), PKW(pB1, 6)}; pw3 = (u32x4){PKW(pB1, 8), PKW(pB1, 10), PKW(pB1, 12), PKW(pB1, 14)};
      const lds_cptr vp_ = vp0 + vs_cur; VRD(0); VRD(4); VRD(1); VRD(5); VRD(2); VRD(6); VRD(3); VRD(7);
      o[0] = MFMA(PAF(0), VFR(0), o[0]); o[1] = MFMA(PAF(0), VFR(4), o[1]); o[0] = MFMA(PAF(1), VFR(1), o[0]); o[1] = MFMA(PAF(1), VFR(5), o[1]);
      o[0] = MFMA(PAF(2), VFR(2), o[0]); o[1] = MFMA(PAF(2), VFR(6), o[1]); o[0] = MFMA(PAF(3), VFR(3), o[0]); o[1] = MFMA(PAF(3), VFR(7), o[1]); }
    { auto rr = __builtin_amdgcn_permlane32_swap(__float_as_uint(l_reg), __float_as_uint(l_reg), false, false); l_reg = __uint_as_float(rr[0]) + __uint_as_float(rr[1]); }
    if (hi == 0) wsf[32 + r32] = l_reg; asm volatile("s_waitcnt lgkmcnt(0)" ::: "memory");
    bf16_t* stg = (bf16_t*)(lds + LDS_OST) + wid * 2048;
    const bf16_t* Zw = Zu + (size_t)(wid * 32) * 1024; bf16_t* Ow = Ou + (size_t)(wid * 32) * 512;
#pragma unroll
    for (int r = 0; r < 16; ++r) { const int orow = crow(r, hi); const float rl = __builtin_amdgcn_rcpf(wsf[32 + orow]);
#pragma unroll
        for (int d0 = 0; d0 < 2; ++d0) { const float z = __uint_as_float((unsigned)Zw[(size_t)orow * 1024 + d0 * 32 + r32] << 16);
            stg[orow * 64 + d0 * 32 + r32] = (bf16_t)(cvtpk(o[d0][r] * rl * z, 0.f) & 0xffffu); } }
    asm volatile("s_waitcnt lgkmcnt(0)" ::: "memory");
#pragma unroll
    for (int i = 0; i < 4; ++i) { const int row = i * 8 + (lane >> 3), ch = lane & 7; *(u32x4*)(Ow + (size_t)row * 512 + ch * 8) = *(const u32x4*)(stg + row * 64 + ch * 8); }
    asm volatile("s_waitcnt lgkmcnt(0)\n\ts_barrier" ::: "memory");
#undef DMA_K
#undef DMA_V
#undef WAITB
#undef ROT
#undef KS
#undef EX
#undef PKW
#undef PAF
#undef VFR
#undef VRD
#undef KRD
#undef GAPA3
#undef GAPA2
#undef GAPB
#undef STEP
}
#undef SBAR
#undef PIN
#undef MFMA
#undef WAIT_BAR
}

constexpr int NWAVES = 8;
constexpr int LDS_BYTES = 147456;
static_assert(pg8::STAGE_BYTES <= 131072 && att::LDS_BYTES <= 131072 && mla::LDS_BYTES <= 131072, "LDS map");


#define XB_TMO      128
#define XB_XCNT(j)  (256  + 64 * (j))
#define XB_XSUB(j)  (1280 + 64 * (j))
#define XB_XGEN(j)  (2304 + 64 * (j))
#define XB_TOP      3328
#define XB_TOPGEN   3392
#define XCD_BAR_WORDS 3456
#define XB_SPIN_CAP (1u << 18)
__device__ __forceinline__ unsigned xb_ld(unsigned* p)              { return __hip_atomic_load(p, __ATOMIC_RELAXED, __HIP_MEMORY_SCOPE_AGENT); }
__device__ __forceinline__ unsigned xb_add(unsigned* p, unsigned v) { return __hip_atomic_fetch_add(p, v, __ATOMIC_RELAXED, __HIP_MEMORY_SCOPE_AGENT); }
__device__ __forceinline__ unsigned xb_xcc_id() { return (unsigned)__builtin_amdgcn_s_getreg((3 << 11) | 20) & 0xFu; }
#define XB_SPIN(cond, bar) do { unsigned _sp = 0; while (cond) { __builtin_amdgcn_s_sleep(1); \
    if ((++_sp & 255u) == 0u) { if (xb_ld(&(bar)[XB_TMO])) break; if (_sp > XB_SPIN_CAP) { atomicAdd(&(bar)[XB_TMO], 1u); break; } } } } while (0)
struct XcdBarrier { unsigned* bar; unsigned x; volatile LAS unsigned* st; };
__device__ __forceinline__ XcdBarrier xcd_barrier_post(unsigned* bar, volatile LAS unsigned* st) {
    XcdBarrier b; b.bar = bar; b.x = xb_xcc_id(); b.st = st;
    if (threadIdx.x == 0) (void)xb_add(&bar[XB_XCNT(b.x)], 1u);
    return b;
}
__device__ __forceinline__ void xcd_barrier_complete(unsigned* bar, unsigned x, unsigned& nloc, unsigned& nx) {
    const unsigned G = gridDim.x * gridDim.y * gridDim.z;
    unsigned sum, cnt, mine, sp = 0u;
    for (;;) {
        sum = 0u; cnt = 0u; mine = 0u;
#pragma unroll
        for (unsigned j = 0; j < 16; ++j) { const unsigned c = xb_ld(&bar[XB_XCNT(j)]); sum += c; cnt += (c > 0u) ? 1u : 0u; mine = (j == x) ? c : mine; }
        if (sum == G) break;
        __builtin_amdgcn_s_sleep(1);
        if ((++sp & 255u) == 0u) { if (xb_ld(&bar[XB_TMO])) break; if (sp > XB_SPIN_CAP) { atomicAdd(&bar[XB_TMO], 1u); break; } }
    }
    nloc = mine > 0u ? mine : 1u; nx = cnt > 0u ? cnt : 1u;
}
__device__ __forceinline__ void xcd_barrier(const XcdBarrier& b) {
    asm volatile("s_waitcnt vmcnt(0)" ::: "memory");
    __syncthreads();
    if (threadIdx.x == 0) {
        unsigned* bar = b.bar;
        __builtin_amdgcn_s_waitcnt(0);
        unsigned nloc = b.st[0], nx = b.st[1];
        if (nloc == 0u) { xcd_barrier_complete(bar, b.x, nloc, nx); b.st[0] = nloc; b.st[1] = nx; }
        const unsigned old = xb_add(&bar[XB_XSUB(b.x)], 1u);
        const unsigned gen = old / nloc;
        if (old + 1u == (gen + 1u) * nloc) {
            __builtin_amdgcn_fence(__ATOMIC_RELEASE, "agent");
            asm volatile("s_waitcnt vmcnt(0)" ::: "memory");
            const unsigned og = xb_add(&bar[XB_TOP], 1u);
            const unsigned tg = og / nx;
            if (og + 1u == (tg + 1u) * nx) xb_add(&bar[XB_TOPGEN], 1u);
            else XB_SPIN(xb_ld(&bar[XB_TOPGEN]) == tg, bar);
            __builtin_amdgcn_fence(__ATOMIC_ACQUIRE, "agent");
            xb_add(&bar[XB_XGEN(b.x)], 1u);
            asm volatile("s_waitcnt vmcnt(0)" ::: "memory");
        } else {
            XB_SPIN(xb_ld(&bar[XB_XGEN(b.x)]) == gen, bar);
            __builtin_amdgcn_fence(__ATOMIC_ACQUIRE, "agent");
            asm volatile("s_waitcnt vmcnt(0)" ::: "memory");
        }
    }
    __syncthreads();
}

struct Params { const float* in[17]; float* out; unsigned char* ws; int ph_lo, ph_hi; };

__device__ const double ROPE_INV[16] = {1.0, 0.5623413251903491, 0.31622776601683794, 0.1778279410038923, 0.1, 0.05623413251903491, 0.03162277660168379, 0.01778279410038923,
                                        0.01, 0.005623413251903491, 0.0031622776601683794, 0.0017782794100389228, 0.001, 0.0005623413251903491, 0.00031622776601683794, 0.00017782794100389227};

__device__ __forceinline__ unsigned f2bf(float f) { unsigned u = __builtin_bit_cast(unsigned, f); return (u + 0x7fffu + ((u >> 16) & 1u)) >> 16; }
__device__ __forceinline__ unsigned pk2(float lo, float hi) { return f2bf(lo) | (f2bf(hi) << 16); }

__device__ __forceinline__ int wsrc_col(int kind, int n, float& cs) {
    cs = 1.f;
    if (kind == 0) {
        if (n < 1280) { if (n < 512) cs = QA_SCALE; return n; }
        if (n < 1792) return n - 1280 + 1952;
        if (n < 2432) return n - 1792 + 1280;
        if (n < 2464) { const int j = n - 2432; return 1920 + (j >> 1) + 16 * (j & 1); }
        if (n < 2560) return -1;
        return n - 2560 + 2464;
    } else if (kind == 1) {
        cs = QB_SCALE; const int h = n / 96, d = n % 96;
        if (d < 64) return h * 96 + d;
        const int j = d - 64; return h * 96 + 64 + (j >> 1) + 16 * (j & 1);
    } else if (kind == 2) {
        if (n < 512) return (n >> 6) * 128 + (n & 63);
        const int q = n - 512; return (q >> 6) * 128 + 64 + (q & 63);
    }
    return n;
}
__device__ __forceinline__ void transpose_item(const float* W, int K, int Nsrc, int Ndst, int kind, const float* kgain, bf16_t* WT, LAS float* scr, int item, int lane) {
    const int nblk = Ndst / 32, kb = item / nblk, nb = item % nblk, k0 = 64 * kb, n0 = 32 * nb;
    float cs; const int src = wsrc_col(kind, n0 + (lane & 31), cs);
#pragma unroll 8
    for (int i = 0; i < 32; ++i) { const int kk = 2 * i + (lane >> 5); float v = 0.f;
        if (src >= 0) { v = W[(size_t)(k0 + kk) * Nsrc + src] * cs; if (kgain) v *= kgain[k0 + kk]; }
        scr[kk * 33 + (lane & 31)] = v; }
    asm volatile("s_waitcnt lgkmcnt(0)" ::: "memory");
    const int c = lane & 7;
#pragma unroll
    for (int j = 0; j < 4; ++j) { const int n = (lane >> 3) + 8 * j; const LAS float* s = scr + (8 * c) * 33 + n;
        u32x4 o; o.x = pk2(s[0 * 33], s[1 * 33]); o.y = pk2(s[2 * 33], s[3 * 33]); o.z = pk2(s[4 * 33], s[5 * 33]); o.w = pk2(s[6 * 33], s[7 * 33]);
        *(u32x4*)(WT + (size_t)(n0 + n) * K + k0 + 8 * c) = o; }
    asm volatile("s_waitcnt lgkmcnt(0)" ::: "memory");
}

__global__ void __launch_bounds__(NWAVES * 64, 2) mk_fwd(Params p) {
    extern __shared__ __attribute__((aligned(16))) unsigned char lds[];
    cg::grid_group grid = cg::this_grid();
    volatile LAS unsigned* bst = (volatile LAS unsigned*)((LAS unsigned char*)lds + LDS_BYTES - 64);
    if (threadIdx.x < 16) bst[threadIdx.x] = 0u;
    __syncthreads();
    const XcdBarrier xbar = xcd_barrier_post((unsigned*)(p.ws + WS_BAR), bst);
    const int G = gridDim.x, bx = blockIdx.x;
    const int vcu = (G % 8 == 0) ? (bx % 8) * (G / 8) + bx / 8 : bx;
    const int NGW = G * NWAVES;
    typedef const __attribute__((address_space(4))) Params* KP;
    const KP PP = (KP)__builtin_amdgcn_kernarg_segment_ptr();
#define PHASE_PTRS() KP q_ = PP; asm volatile("" : "+s"(q_)); unsigned char* ws = q_->ws; (void)ws; \
    const float *x_p = q_->in[0], *x_s = q_->in[1], *c_p = q_->in[2], *c_s = q_->in[3], *w_ada = q_->in[4], *b_ada = q_->in[5], *g_norm = q_->in[6], *w_in = q_->in[7], *g_q = q_->in[8], *w_uq = q_->in[9], \
                *g_kv = q_->in[10], *w_ukv = q_->in[11], *sink = q_->in[12], *w_oa = q_->in[13], *w_ob = q_->in[14], *w_out = q_->in[15], *g_final = q_->in[16]; float* outp = q_->out; \
    (void)x_p; (void)x_s; (void)c_p; (void)c_s; (void)w_ada; (void)b_ada; (void)g_norm; (void)w_in; (void)g_q; (void)w_uq; (void)g_kv; (void)w_ukv; (void)sink; (void)w_oa; (void)w_ob; (void)w_out; (void)g_final; (void)outp; \
    int tid = threadIdx.x; asm volatile("" : "+v"(tid)); const int lane = tid & 63, wave = __builtin_amdgcn_readfirstlane(tid >> 6), gw = vcu * NWAVES + wave; (void)lane; (void)wave; (void)gw; \
    float* mod = (float*)(ws + WS_MOD); f32x2* rope = (f32x2*)(ws + WS_ROPE); (void)mod; (void)rope; \
    bf16_t *Win_t = (bf16_t*)(ws + WS_WIN), *Wuq_t = (bf16_t*)(ws + WS_WUQ), *Wukv_t = (bf16_t*)(ws + WS_WUKV), *Woa_t = (bf16_t*)(ws + WS_WOA), *Wob_t = (bf16_t*)(ws + WS_WOB), *Wout_t = (bf16_t*)(ws + WS_WOUT); \
    (void)Win_t; (void)Wuq_t; (void)Wukv_t; (void)Woa_t; (void)Wob_t; (void)Wout_t; \
    float *RSQ = (float*)(ws + WS_RSQ), *RSKV = (float*)(ws + WS_RSKV); (void)RSQ; (void)RSKV; \
    bf16_t *HB = (bf16_t*)(ws + WS_R1), *YA = (bf16_t*)(ws + WS_R1), *YB = (bf16_t*)(ws + WS_R1 + 48 * MiB); (void)HB; (void)YA; (void)YB; \
    bf16_t *PA = (bf16_t*)(ws + WS_R2), *QB = (bf16_t*)(ws + WS_R2); (void)PA; (void)QB; \
    bf16_t *PZ = (bf16_t*)(ws + WS_R3), *TM = (bf16_t*)(ws + WS_R3); (void)PZ; (void)TM; \
    bf16_t *PC = (bf16_t*)(ws + WS_R4), *KN = (bf16_t*)(ws + WS_KN), *VB = (bf16_t*)(ws + WS_VB), *KR = (bf16_t*)(ws + WS_KR); (void)PC; (void)KN; (void)VB; (void)KR; \
    bf16_t* PG = (bf16_t*)outp; (void)PG;
    const int lo = p.ph_lo, hi = p.ph_hi;
#ifndef PH_MASK
#define PH_MASK 0x3ff
#endif
#define IN(k) (((PH_MASK >> (k)) & 1) && lo <= (k) && (k) < hi)
#define GBAR() xcd_barrier(xbar)
#define SEAM(k) do { if (IN(k) && IN((k) + 1)) { if ((k) == 0) grid.sync(); else GBAR(); } } while (0)
#ifndef REP_MASK
#define REP_MASK 0
#endif
#define REPS(k) (1 + ((REP_MASK >> (k)) & 1))
#define REPSYNC() do { if (rep_) GBAR(); } while (0)

    if (IN(0)) { PHASE_PTRS();
        LAS float* scr = (LAS float*)((LAS unsigned char*)lds + wave * 16384);
        constexpr int I_IN = (DM / 64) * (N_IN / 32), I_UQ = (384 / 64) * (768 / 32), I_UKV = (256 / 64) * (1024 / 32), I_OA = (512 / 64) * (1024 / 32), I_OUT = (1024 / 64) * (1024 / 32);
        constexpr int NITEMS = I_IN + I_UQ + I_UKV + 2 * I_OA + I_OUT;
        for (int it = gw; it < NITEMS; it += NGW) {
            int r = it;
            if (r < I_IN) { transpose_item(w_in, DM, D_IN, N_IN, 0, nullptr, Win_t, scr, r, lane); continue; } r -= I_IN;
            if (r < I_UQ) { transpose_item(w_uq, 384, 768, 768, 1, g_q, Wuq_t, scr, r, lane); continue; } r -= I_UQ;
            if (r < I_UKV) { transpose_item(w_ukv, 256, 1024, 1024, 2, g_kv, Wukv_t, scr, r, lane); continue; } r -= I_UKV;
            if (r < I_OA) { transpose_item(w_oa, 512, 1024, 1024, 3, nullptr, Woa_t, scr, r, lane); continue; } r -= I_OA;
            if (r < I_OA) { transpose_item(w_ob, 512, 1024, 1024, 3, nullptr, Wob_t, scr, r, lane); continue; } r -= I_OA;
            transpose_item(w_out, 1024, 1024, 1024, 3, nullptr, Wout_t, scr, r, lane);
        }
        for (int it = gw; it < 16 * 48; it += NGW) { const int ks = it / 48, cgp = it % 48, col = cgp * 64 + lane; float a[NBATCH];
#pragma unroll
            for (int b = 0; b < NBATCH; ++b) a[b] = 0.f;
            for (int k = ks * 64; k < ks * 64 + 64; ++k) { const float w = w_ada[(size_t)k * 3 * DM + col];
#pragma unroll
                for (int b = 0; b < NBATCH; ++b) { const float c = (b < NB_P) ? c_p[b * DM + k] : c_s[(b - NB_P) * DM + k]; a[b] += c * sigmoidf_fast(c) * w; } }
#pragma unroll
            for (int b = 0; b < NBATCH; ++b) atomicAdd(mod + b * 3 * DM + col, a[b]);
        }
        for (int e = gw * 64 + lane; e < S_S * 16; e += NGW * 64) { const int pos = e >> 4, i = e & 15;
            const double ang = (double)pos * ROPE_INV[i]; const double n = rint(ang * 0.6366197723675814);
            const double r = (ang - n * 1.5707963267948966) - n * 6.123233995736766e-17; const double r2 = r * r;
            const double sn = r * (1.0 + r2 * (-1.0 / 6 + r2 * (1.0 / 120 + r2 * (-1.0 / 5040 + r2 * (1.0 / 362880 + r2 * (-1.0 / 39916800 + r2 * (1.0 / 6227020800.0)))))));
            const double cn = 1.0 + r2 * (-0.5 + r2 * (1.0 / 24 + r2 * (-1.0 / 720 + r2 * (1.0 / 40320 + r2 * (-1.0 / 3628800 + r2 * (1.0 / 479001600.0))))));
            const int q = (int)((long long)n & 3); double cs_, sn_;
            if (q == 0) { cs_ = cn; sn_ = sn; } else if (q == 1) { cs_ = -sn; sn_ = cn; } else if (q == 2) { cs_ = -cn; sn_ = -sn; } else { cs_ = sn; sn_ = -cn; }
            rope[e] = (f32x2){(float)cs_, (float)sn_}; }
    }
    SEAM(0);
    for (int rep_ = 0; rep_ < REPS(1); ++rep_) { REPSYNC();
    if (IN(1)) { PHASE_PTRS();
        constexpr int RPW = 24;
        for (int base = gw * RPW; base < M; base += NGW * RPW) {
            int cb = -1; f32x4 ga[4], sh[4];
            for (int row = base; row < base + RPW && row < M; row += 2) {
                const int b = batch_of_row(row);
                if (b != cb) { cb = b;
#pragma unroll
                    for (int j = 0; j < 4; ++j) { const int c = 4 * lane + 256 * j;
                        const f32x4 sc = *(const f32x4*)(mod + b * 3 * DM + DM + c) + *(const f32x4*)(b_ada + DM + c);
                        sh[j] = *(const f32x4*)(mod + b * 3 * DM + c) + *(const f32x4*)(b_ada + c);
                        ga[j] = *(const f32x4*)(g_norm + c) * (sc + 1.0f); } }
                const float* xr = row < M_P ? x_p + (size_t)row * DM : x_s + (size_t)(row - M_P) * DM;
                f32x4 v[2][4]; float s0 = 0.f, s1 = 0.f;
#pragma unroll
                for (int j = 0; j < 4; ++j) { v[0][j] = *(const f32x4*)(xr + 4 * lane + 256 * j); v[1][j] = *(const f32x4*)(xr + DM + 4 * lane + 256 * j); }
#pragma unroll
                for (int j = 0; j < 4; ++j) { s0 += (v[0][j].x * v[0][j].x + v[0][j].y * v[0][j].y) + (v[0][j].z * v[0][j].z + v[0][j].w * v[0][j].w);
                                              s1 += (v[1][j].x * v[1][j].x + v[1][j].y * v[1][j].y) + (v[1][j].z * v[1][j].z + v[1][j].w * v[1][j].w); }
                const float r0 = 1.0f / sqrtf(wave_sum(s0) * (1.f / DM) + EPS), r1 = 1.0f / sqrtf(wave_sum(s1) * (1.f / DM) + EPS);
#pragma unroll
                for (int j = 0; j < 4; ++j) { const f32x4 h0 = v[0][j] * r0 * ga[j] + sh[j], h1 = v[1][j] * r1 * ga[j] + sh[j]; u32x2 w0, w1;
                    w0.x = cvt_pk_bf16(h0.x, h0.y); w0.y = cvt_pk_bf16(h0.z, h0.w); w1.x = cvt_pk_bf16(h1.x, h1.y); w1.y = cvt_pk_bf16(h1.z, h1.w);
                    *(u32x2*)(HB + (size_t)row * DM + 4 * lane + 256 * j) = w0; *(u32x2*)(HB + (size_t)(row + 1) * DM + 4 * lane + 256 * j) = w1; }
            }
        }
    }
    }
    SEAM(1);
    for (int rep_ = 0; rep_ < REPS(2); ++rep_) { REPSYNC();
    if (IN(2)) { PHASE_PTRS();
        pg8::Gemm g{HB, Win_t, M, N_IN, DM, DM}; pg8::StaticOrder S; S.init(M, N_IN, G, bx);
        pg8::EpiProj E{PA, PZ, PC, PG};
        pg8::gemm_phase<pg8::EpiProj, 1024, 1024>((LAS unsigned char*)lds, g, S, E);
    }
    }
    SEAM(2);
    for (int rep_ = 0; rep_ < REPS(3); ++rep_) { REPSYNC();
    if (IN(3)) { PHASE_PTRS();
        for (int row = gw; row < M; row += NGW) {
            const bf16_t* pr = PC + (size_t)row * 768;
            const u32x4 a = *(const u32x4*)(pr + lane * 8); u32x4 b = (u32x4){0u, 0u, 0u, 0u};
            if (lane < 20) b = *(const u32x4*)(pr + 512 + lane * 8);
            float sa = 0.f, sb = 0.f;
#pragma unroll
            for (int e = 0; e < 4; ++e) { const float l0 = bf_lo(a[e]), h0 = bf_hi(a[e]); sa += l0 * l0 + h0 * h0; }
            if (lane < 16) {
#pragma unroll
                for (int e = 0; e < 4; ++e) { const float l0 = bf_lo(b[e]), h0 = bf_hi(b[e]); sb += l0 * l0 + h0 * h0; } }
            float sq = (lane < 48) ? sa : 0.f, skv = (lane < 48) ? 0.f : sa; skv += sb;
            sq = wave_sum(sq); skv = wave_sum(skv);
            if (lane == 0) { RSQ[row] = 1.0f / sqrtf(sq * (1.f / 384.f) + EPS); RSKV[row] = 1.0f / sqrtf(skv * (1.f / 256.f) + EPS); }
            if (lane >= 16 && lane < 20) { const int i0 = (lane - 16) * 4; const f32x4* tp = (const f32x4*)(rope + (size_t)pos_of_row(row) * 16 + i0); const f32x4 c0 = tp[0], c1 = tp[1];
                const float x0 = bf_lo(b.x), y0 = bf_hi(b.x), x1 = bf_lo(b.y), y1 = bf_hi(b.y), x2 = bf_lo(b.z), y2 = bf_hi(b.z), x3 = bf_lo(b.w), y3 = bf_hi(b.w);
                u32x4 w; w.x = cvt_pk_bf16(x0 * c0[0] - y0 * c0[1], x0 * c0[1] + y0 * c0[0]); w.y = cvt_pk_bf16(x1 * c0[2] - y1 * c0[3], x1 * c0[3] + y1 * c0[2]);
                w.z = cvt_pk_bf16(x2 * c1[0] - y2 * c1[1], x2 * c1[1] + y2 * c1[0]); w.w = cvt_pk_bf16(x3 * c1[2] - y3 * c1[3], x3 * c1[3] + y3 * c1[2]);
                *(u32x4*)(KR + (size_t)row * 32 + (lane - 16) * 8) = w; }
        }
        for (int U = vcu; U < (M / 256) * 8; U += G) { const int rb = U >> 3, h = U & 7, kvh = h >> 2; const int row0 = rb * 256;
            const int S = row0 < M_P ? S_P : S_S; const int qpos0 = pos_of_row(row0); const int seq0 = row0 - qpos0;
            const int ks = qpos0 - 128 < 0 ? 0 : qpos0 - 128, ke = qpos0 + 384 > S ? S : qpos0 + 384;
            const float slope2 = exp2f(-(float)(h + 1)) * LOG2E, sink2 = sink[h] * LOG2E;
            att::attn_unit<64, true>(PA + (size_t)row0 * 768 + h * 64, 768, PA + (size_t)seq0 * 768 + 512 + kvh * 64, 768, nullptr, PA + (size_t)seq0 * 768 + 640 + kvh * 64, 768,
                                     PZ + (size_t)row0 * 1024 + h * 64, 1024, YA + (size_t)row0 * 512 + h * 64, 512, ks / 64, (ke - ks) / 64, qpos0, slope2, sink2, (char*)lds);
        }
    }
    }
    SEAM(3);
    for (int rep_ = 0; rep_ < REPS(4); ++rep_) { REPSYNC();
    if (IN(4)) { PHASE_PTRS();
#ifndef NO_Q
        { pg8::Gemm g{PC, Wuq_t, M, 768, 384, 768}; pg8::StaticOrder S; S.init(M, 768, G, bx); pg8::EpiQ E{QB, RSQ, rope};
          pg8::gemm_phase<pg8::EpiQ, 384, 768>((LAS unsigned char*)lds, g, S, E); }
#endif
#ifndef NO_KV
        { pg8::Gemm g{PC + 384, Wukv_t, M, 1024, 256, 768}; pg8::StaticOrder S; S.init(M, 1024, G, bx); pg8::EpiKV E{KN, VB, RSKV};
          pg8::gemm_phase<pg8::EpiKV, 256, 768>((LAS unsigned char*)lds, g, S, E); }
#endif
    }
    }
    SEAM(4);
    for (int rep_ = 0; rep_ < REPS(5); ++rep_) { REPSYNC();
    if (IN(5)) { PHASE_PTRS();
        { unsigned* KMAX = (unsigned*)(ws + WS_KMAX); constexpr int RPW = 24;
          for (int base = gw * RPW; base < M; base += NGW * RPW) { int cb = -1; float mx = 0.f;
            for (int row = base; row < base + RPW && row < M; ++row) { const int b = batch_of_row(row);
                if (b != cb) { if (cb >= 0 && (lane & 7) == 0) atomicMax(KMAX + cb * 8 + (lane >> 3), __float_as_uint(mx)); cb = b; mx = 0.f; }
                const u32x4 a = *(const u32x4*)(KN + (size_t)row * 512 + lane * 8); const u32x4 r4 = *(const u32x4*)(KR + (size_t)row * 32 + (lane & 3) * 8);
                float sn = 0.f, sr = 0.f;
#pragma unroll
                for (int e = 0; e < 4; ++e) { const float l0 = bf_lo(a[e]), h0 = bf_hi(a[e]), l1 = bf_lo(r4[e]), h1 = bf_hi(r4[e]); sn += l0 * l0 + h0 * h0; sr += l1 * l1 + h1 * h1; }
                sn += __shfl_xor(sn, 1); sn += __shfl_xor(sn, 2); sn += __shfl_xor(sn, 4); sr += __shfl_xor(sr, 1); sr += __shfl_xor(sr, 2);
                mx = fmaxf(mx, sn + sr); }
            if (cb >= 0 && (lane & 7) == 0) atomicMax(KMAX + cb * 8 + (lane >> 3), __float_as_uint(mx)); }
        }
        GBAR();
        for (int U = vcu; U < 1536; U += G) {
            int row0, seq0, S, h, b;
            if (U < 1024) { const int i = U >> 8, v = U & 255, xcd = v >> 5, c = v & 31; const int bh = 2 * xcd + (i >> 1), qb = (i & 1) * 32 + c; b = bh >> 3; h = bh & 7;
                S = S_S; seq0 = M_P + b * S_S; row0 = seq0 + qb * 256; b += NB_P; }
            else { const int U2 = U - 1024; const int j = U2 >> 8, v = U2 & 255, xcd = v >> 5, c = v & 31; const int bh = 4 * xcd + 2 * j + (c >> 4), qb = c & 15; b = bh >> 3; h = bh & 7;
                S = S_P; seq0 = b * S_P; row0 = seq0 + qb * 256; }
            const float kmax = sqrtf(__uint_as_float(__hip_atomic_load((unsigned*)(ws + WS_KMAX) + b * 8 + h, __ATOMIC_RELAXED, __HIP_MEMORY_SCOPE_AGENT)));
            mla::mla_unit(QB + (size_t)row0 * 768 + h * 96, KN + (size_t)seq0 * 512 + h * 64, KR + (size_t)seq0 * 32, VB + (size_t)seq0 * 512 + h * 64,
                          PZ + (size_t)row0 * 1024 + 512 + h * 64, YB + (size_t)row0 * 512 + h * 64, S / 64, kmax, (char*)lds);
        }
    }
    }
    SEAM(5);
    for (int rep_ = 0; rep_ < REPS(6); ++rep_) { REPSYNC();
    if (IN(6)) { PHASE_PTRS(); pg8::Gemm g{YA, Woa_t, M, 1024, 512, 512}; pg8::StaticOrder S; S.init(M, 1024, G, bx); pg8::EpiGate<true> E{TM, PG, 0};
        pg8::gemm_phase<pg8::EpiGate<true>, 512, 512>((LAS unsigned char*)lds, g, S, E); }
    SEAM(6);
    if (IN(7)) { PHASE_PTRS(); pg8::Gemm g{YB, Wob_t, M, 1024, 512, 512}; pg8::StaticOrder S; S.init(M, 1024, G, bx); pg8::EpiGate<false> E{TM, PG, 1024};
        pg8::gemm_phase<pg8::EpiGate<false>, 512, 512>((LAS unsigned char*)lds, g, S, E); }
    SEAM(7);
    }
    for (int rep_ = 0; rep_ < REPS(8); ++rep_) { REPSYNC();
    if (IN(8)) { PHASE_PTRS(); pg8::Gemm g{TM, Wout_t, M, 1024, 1024, 1024}; pg8::StaticOrder S; S.init(M, 1024, G, bx); pg8::EpiOut E{x_p, x_s, outp, mod, b_ada};
        pg8::gemm_phase<pg8::EpiOut, 1024, 1024>((LAS unsigned char*)lds, g, S, E); }
    SEAM(8);
    if (IN(9)) { PHASE_PTRS();
        f32x4 gf[4];
#pragma unroll
        for (int j = 0; j < 4; ++j) gf[j] = *(const f32x4*)(g_final + 4 * lane + 256 * j);
        for (int row = 2 * gw; row < M; row += 2 * NGW) { float* orow = outp + (size_t)row * DM; f32x4 v[2][4]; float s0 = 0.f, s1 = 0.f;
#pragma unroll
            for (int j = 0; j < 4; ++j) { v[0][j] = *(const f32x4*)(orow + 4 * lane + 256 * j); v[1][j] = *(const f32x4*)(orow + DM + 4 * lane + 256 * j); }
#pragma unroll
            for (int j = 0; j < 4; ++j) { s0 += (v[0][j].x * v[0][j].x + v[0][j].y * v[0][j].y) + (v[0][j].z * v[0][j].z + v[0][j].w * v[0][j].w);
                                          s1 += (v[1][j].x * v[1][j].x + v[1][j].y * v[1][j].y) + (v[1][j].z * v[1][j].z + v[1][j].w * v[1][j].w); }
            const float r0 = 1.0f / sqrtf(wave_sum(s0) * (1.f / DM) + EPS), r1 = 1.0f / sqrtf(wave_sum(s1) * (1.f / DM) + EPS);
#pragma unroll
            for (int j = 0; j < 4; ++j) { *(f32x4*)(orow + 4 * lane + 256 * j) = v[0][j] * r0 * gf[j]; *(f32x4*)(orow + DM + 4 * lane + 256 * j) = v[1][j] * r1 * gf[j]; }
        }
    }
    }
#undef IN
#undef SEAM
#undef PHASE_PTRS
}

extern "C" void kernel_launch(void* const* d_in, const int* in_sizes, int n_in, void* d_out, int out_size, void* d_ws, size_t ws_size, hipStream_t stream) {
    static int grid = 0;
    if (grid == 0) {
        if (n_in != 17 || out_size != M * DM || ws_size < WS_END) { fprintf(stderr, "kernel_launch: unexpected shapes: n_in %d out %d ws %zu (need %zu)\n", n_in, out_size, ws_size, (size_t)WS_END); grid = -1; return; }
        int dev = 0, cus = 0, per_cu = 0;
        hipGetDevice(&dev); hipDeviceGetAttribute(&cus, hipDeviceAttributeMultiprocessorCount, dev);
        if (hipFuncSetAttribute((const void*)mk_fwd, hipFuncAttributeMaxDynamicSharedMemorySize, LDS_BYTES) != hipSuccess) { fprintf(stderr, "kernel_launch: hipFuncSetAttribute failed\n"); grid = -1; return; }
        if (hipOccupancyMaxActiveBlocksPerMultiprocessor(&per_cu, (const void*)mk_fwd, NWAVES * 64, LDS_BYTES) != hipSuccess || per_cu < 1) { fprintf(stderr, "kernel_launch: occupancy query says %d\n", per_cu); per_cu = 1; }
        (void)hipGetLastError();
        grid = cus;
    }
    if (grid < 0) return;
    hipMemsetAsync((char*)d_ws + WS_MOD, 0, ZERO_BYTES, stream);
    Params p{};
    for (int i = 0; i < 17; ++i) p.in[i] = (const float*)d_in[i];
    p.out = (float*)d_out; p.ws = (unsigned char*)d_ws;
#if MK_N_LAUNCHES == 1
    p.ph_lo = 0; p.ph_hi = 10;
    void* args[] = {&p};
    hipError_t e = hipLaunchCooperativeKernel((const void*)mk_fwd, dim3(grid), dim3(NWAVES * 64), args, LDS_BYTES, stream);
    if (e != hipSuccess) fprintf(stderr, "cooperative launch failed: %s (grid %d)\n", hipGetErrorString(e), grid);
#else
    for (int ph = 0; ph < 10; ++ph) { p.ph_lo = ph; p.ph_hi = ph + 1; hipLaunchKernelGGL(mk_fwd, dim3(grid), dim3(NWAVES * 64), LDS_BYTES, stream, p); }
#endif
}
```

```cpp
#include <hip/hip_runtime.h>
#include <hip/hip_cooperative_groups.h>
#include <cstdio>
#include <cstdint>
namespace cg = cooperative_groups;

#ifndef MK_N_LAUNCHES
#define MK_N_LAUNCHES 1
#endif

constexpr int DM = 1024;
constexpr int NB_P = 4, S_P = 4096, NB_S = 2, S_S = 16384;
constexpr int M_P = NB_P * S_P, M_S = NB_S * S_S, M = M_P + M_S;
constexpr int D_IN = 4512, N_IN = 4608;
constexpr int NBATCH = NB_P + NB_S;
constexpr float EPS = 1e-6f;
constexpr float LOG2E = 1.4426950408889634f;
constexpr float QA_SCALE = 0.125f * LOG2E;
constexpr float QB_SCALE = 0.10206207261596575f * LOG2E;

constexpr size_t MiB = 1u << 20;
constexpr size_t WS_MOD = 0;
constexpr size_t MOD_BYTES = (size_t)NBATCH * 3 * DM * 4;
constexpr size_t WS_KMX = WS_MOD + MOD_BYTES;
constexpr size_t WS_KMR = WS_KMX + 512;
constexpr size_t WS_BAR = 80 * 1024;
constexpr size_t WS_SSQ = 128 * 1024;
constexpr size_t WS_SSKV = WS_SSQ + (size_t)M * 4;
constexpr size_t ZERO_BYTES = 512 * 1024;
static_assert(WS_SSKV + (size_t)M * 4 <= ZERO_BYTES && WS_BAR + 3456 * 4 <= WS_SSQ, "zeroed region");
constexpr size_t WS_ROPE = ZERO_BYTES;
constexpr size_t WS_WIN = WS_ROPE + 2 * MiB;
constexpr size_t WS_WUQ = WS_WIN + (size_t)N_IN * DM * 2;
constexpr size_t WS_WUKV = WS_WUQ + (size_t)768 * 384 * 2;
constexpr size_t WS_WOA = WS_WUKV + (size_t)1024 * 256 * 2;
constexpr size_t WS_WOB = WS_WOA + (size_t)1024 * 512 * 2;
constexpr size_t WS_WOUT = WS_WOB + (size_t)1024 * 512 * 2;
static_assert(WS_WOUT + (size_t)1024 * 1024 * 2 <= 20 * MiB, "small region");
constexpr size_t WS_PA = 20 * MiB;
constexpr size_t WS_PZ = WS_PA + 72 * MiB;
constexpr size_t WS_PC = WS_PZ + 96 * MiB;
constexpr size_t WS_QB = WS_PC + 72 * MiB;
constexpr size_t WS_KN = WS_QB + 72 * MiB;
constexpr size_t WS_VB = WS_KN + 48 * MiB;
constexpr size_t WS_KR = WS_VB + 48 * MiB;
constexpr size_t WS_YA = WS_KR + 3 * MiB;
constexpr size_t WS_END = WS_YA + 48 * MiB;

typedef unsigned short bf16_t;
typedef short bf16x8 __attribute__((ext_vector_type(8)));
typedef short s16x4 __attribute__((ext_vector_type(4)));
typedef float f32x4 __attribute__((ext_vector_type(4)));
typedef float f32x2 __attribute__((ext_vector_type(2)));
typedef float f32x16 __attribute__((ext_vector_type(16)));
typedef unsigned u32x4 __attribute__((ext_vector_type(4)));
typedef unsigned u32x2 __attribute__((ext_vector_type(2)));
#define LAS __attribute__((address_space(3)))

__device__ __forceinline__ unsigned cvt_pk_bf16(float lo, float hi) { unsigned r; asm volatile("v_cvt_pk_bf16_f32 %0, %1, %2" : "=v"(r) : "v"(lo), "v"(hi)); return r; }
__device__ __forceinline__ float bf_lo(unsigned w) { return __uint_as_float(w << 16); }
__device__ __forceinline__ float bf_hi(unsigned w) { return __uint_as_float(w & 0xffff0000u); }
__device__ __forceinline__ float sigmoidf_fast(float v) { return __builtin_amdgcn_rcpf(1.0f + __builtin_amdgcn_exp2f(-v * LOG2E)); }
__device__ __forceinline__ float wave_sum(float v) {
#pragma unroll
    for (int o = 1; o < 64; o <<= 1) v += __shfl_xor(v, o);
    return v;
}
__device__ __forceinline__ int batch_of_row(int row) { return row < M_P ? (row >> 12) : NB_P + ((row - M_P) >> 14); }
__device__ __forceinline__ int pos_of_row(int row) { return row < M_P ? (row & (S_P - 1)) : ((row - M_P) & (S_S - 1)); }

namespace pg8 {
constexpr int BM = 256, BK = 64, HALF = 128, HTB = HALF * BK * 2, STAGE_BYTES = 8 * HTB, NXCD = 8, WGM = 8;
__host__ __device__ __forceinline__ int lds_byte(int r, int c) { const int st = (r >> 4) * 2 + (c >> 5), rr = r & 15, cc = c & 31, ob = rr * 64 + cc * 2; return st * 1024 + (ob ^ (((ob >> 9) & 1) << 5)); }
__host__ __device__ __forceinline__ void stage_rc(int b, int& R, int& C) { const int st = b / 1024, sb = b % 1024, swz = sb ^ (((sb >> 9) & 1) << 5); R = (st >> 1) * 16 + swz / 64; C = (st & 1) * 32 + (swz % 64) / 2; }
__host__ __device__ __forceinline__ int perm32(int rho) { const int n = rho >> 4, i = rho & 15; return 8 * (i >> 2) + 4 * n + (i & 3); }

struct Unit { int pm, pn; };
struct Gemm { const bf16_t* A; const bf16_t* Bt; int M, N, K, lda; };

struct StaticOrder {
    int nM, nN, nwg, G, c;
    __device__ void init(int M_, int N_, int G_, int c_) { nM = M_ / BM; nN = N_ / BM; nwg = nM * nN; G = G_; c = c_; }
    __device__ bool next(int i, Unit& u) const {
        const long L = (long)i * G + c; if (L >= nwg) return false;
        int wgid = (int)L; { const int q = nwg / NXCD, r = nwg % NXCD, xcd = wgid % NXCD, off = wgid / NXCD; wgid = (xcd < r ? xcd * (q + 1) : r * (q + 1) + (xcd - r) * q) + off; }
        const int nig = WGM * nN, gid = wgid / nig, fm = gid * WGM, gsz = (nM - fm) < WGM ? (nM - fm) : WGM;
        u.pm = fm + ((wgid % nig) % gsz); u.pn = (wgid % nig) / gsz; return true;
    }
};

template <class Epi, int K, int LDA, bool ALIGN_EPI = true>
__device__ __forceinline__ void gemm_phase(LAS unsigned char* lds, const Gemm g, const StaticOrder& S, const Epi& E) {
    int tid = threadIdx.x; asm volatile("" : "+v"(tid));
    const int wid = __builtin_amdgcn_readfirstlane(tid >> 6), lane = tid & 63, wr = wid >> 2, wc = wid & 3, fr = lane & 15, fq = lane >> 4;
    constexpr int nt = K / BK, lda = LDA;
    unsigned voffA[2], voffB[2];
#pragma unroll
    for (int i = 0; i < 2; ++i) { int R, C; stage_rc(tid * 16 + i * 8192, R, C); const int Rb = (R & ~31) + perm32(R & 31);
        voffA[i] = (unsigned)(R * lda + C) * 2u; voffB[i] = (unsigned)(Rb * K + C) * 2u; }
    const size_t kstep = (size_t)(BK * 2);
    const size_t hstepA = (size_t)HALF * lda * 2, tstepA = 2 * hstepA;
    const size_t hstepB = (size_t)HALF * K * 2, tstepB = 2 * hstepB;
    const unsigned ldsw = (unsigned)wid * 1024u;
    const int aoff = lds_byte(wr * 64 + fr, fq * 8), boff = lds_byte(wc * 32 + fr, fq * 8);
#define PG8_SA(b, h) (((b) * 2 + (h)) * HTB)
#define PG8_SB(b, h) ((4 + (b) * 2 + (h)) * HTB)
#define PG8_STAGE(bufoff, gbase, voff) do { _Pragma("unroll") for (int _i = 0; _i < 2; ++_i) \
        __builtin_amdgcn_global_load_lds((const unsigned*)((const char*)(gbase) + (voff)[_i]), (LAS unsigned*)(lds + (bufoff) + ldsw + _i * 8192), 16, 0, 0); } while (0)
#define PG8_LDA(dst, b, h) do { _Pragma("unroll") for (int m = 0; m < 4; ++m) _Pragma("unroll") for (int k = 0; k < 2; ++k) dst[m][k] = *(const LAS bf16x8*)(lds + PG8_SA(b, h) + aoff + m * 2048 + k * 1024); } while (0)
#define PG8_LDB(dst, b, h) do { _Pragma("unroll") for (int n = 0; n < 2; ++n) _Pragma("unroll") for (int k = 0; k < 2; ++k) dst[n][k] = *(const LAS bf16x8*)(lds + PG8_SB(b, h) + boff + n * 2048 + k * 1024); } while (0)
#define PG8_MMA(ai, bj, At, Bt) do { __builtin_amdgcn_s_setprio(1); _Pragma("unroll") for (int m = 0; m < 4; ++m) _Pragma("unroll") for (int n = 0; n < 2; ++n) _Pragma("unroll") for (int k = 0; k < 2; ++k) \
        acc[ai][bj][m][n] = __builtin_amdgcn_mfma_f32_16x16x32_bf16(Bt[n][k], At[m][k], acc[ai][bj][m][n], 0, 0, 0); __builtin_amdgcn_s_setprio(0); } while (0)
#define PG8_WAIT_V(n) asm volatile("s_waitcnt vmcnt(" #n ")" ::: "memory")
#define PG8_WAIT_L(n) asm volatile("s_waitcnt lgkmcnt(" #n ")" ::: "memory")
#define PG8_BAR __builtin_amdgcn_s_barrier()
#define PG8_SCHED __builtin_amdgcn_sched_barrier(0)
    Unit cur, nxt; int ui = 0;
    if (!S.next(0, cur)) return;
    f32x4 acc[2][2][4][2];
#pragma unroll
    for (int a = 0; a < 2; ++a)
#pragma unroll
        for (int b = 0; b < 2; ++b)
#pragma unroll
            for (int m = 0; m < 4; ++m)
#pragma unroll
                for (int n = 0; n < 2; ++n) acc[a][b][m][n] = (f32x4){0.f, 0.f, 0.f, 0.f};
    bf16x8 At[4][2], B0[2][2], B1[2][2];
    const char* cA = (const char*)g.A + (size_t)cur.pm * tstepA; const char* cB = (const char*)g.Bt + (size_t)cur.pn * tstepB;
    PG8_STAGE(PG8_SB(0, 0), cB, voffB); PG8_STAGE(PG8_SB(0, 1), cB + hstepB, voffB); PG8_STAGE(PG8_SA(0, 0), cA, voffA); PG8_STAGE(PG8_SA(0, 1), cA + hstepA, voffA);
    if (wr == 1) PG8_BAR;
    PG8_WAIT_V(2); PG8_BAR;
    PG8_STAGE(PG8_SB(1, 0), cB + kstep, voffB); PG8_STAGE(PG8_SA(1, 0), cA + kstep, voffA); PG8_STAGE(PG8_SB(1, 1), cB + hstepB + kstep, voffB);
    PG8_WAIT_V(6); PG8_BAR;
    for (;;) {
        const bool has_next = S.next(ui + 1, nxt);
        const char* nA = has_next ? (const char*)g.A + (size_t)nxt.pm * tstepA : cA; const char* nB = has_next ? (const char*)g.Bt + (size_t)nxt.pn * tstepB : cB;
#pragma unroll 1
        for (int t = 0; t < nt; t += 2) {
            const bool last = (t == nt - 2);
            const char* a1 = cA + (size_t)(t + 1) * kstep;
            const char* a2 = last ? nA : cA + (size_t)(t + 2) * kstep; const char* b2 = last ? nB : cB + (size_t)(t + 2) * kstep;
            const char* a3 = a2 + kstep; const char* b3 = b2 + kstep;
            PG8_LDB(B0, 0, 0); PG8_LDB(B1, 0, 1); PG8_SCHED; PG8_LDA(At, 0, 0); PG8_STAGE(PG8_SA(1, 1), a1 + hstepA, voffA);
            PG8_WAIT_V(8); PG8_WAIT_L(0); PG8_BAR; PG8_MMA(0, 0, At, B0); PG8_MMA(0, 1, At, B1); PG8_BAR; PG8_SCHED;
            PG8_LDA(At, 0, 1); PG8_STAGE(PG8_SB(0, 0), b2, voffB); PG8_STAGE(PG8_SB(0, 1), b2 + hstepB, voffB); PG8_STAGE(PG8_SA(0, 0), a2, voffA);
            PG8_WAIT_V(8); PG8_WAIT_L(0); PG8_BAR; PG8_MMA(1, 0, At, B0); PG8_MMA(1, 1, At, B1); PG8_BAR; PG8_SCHED;
            PG8_LDB(B0, 1, 0); PG8_LDB(B1, 1, 1); PG8_SCHED; PG8_LDA(At, 1, 0); PG8_STAGE(PG8_SA(0, 1), a2 + hstepA, voffA);
            PG8_WAIT_V(8); PG8_WAIT_L(0); PG8_BAR; PG8_MMA(0, 0, At, B0); PG8_MMA(0, 1, At, B1); PG8_BAR; PG8_SCHED;
            PG8_LDA(At, 1, 1); PG8_STAGE(PG8_SB(1, 0), b3, voffB); PG8_STAGE(PG8_SB(1, 1), b3 + hstepB, voffB); PG8_STAGE(PG8_SA(1, 0), a3, voffA);
            PG8_WAIT_V(8); PG8_WAIT_L(0); PG8_BAR; PG8_MMA(1, 0, At, B0); PG8_MMA(1, 1, At, B1); PG8_BAR; PG8_SCHED;
        }
        if constexpr (ALIGN_EPI) { if (wr == 0) PG8_BAR; }
        E(acc, cur, wr, wc, fr, fq);
        if (!has_next) break;
#pragma unroll
        for (int a = 0; a < 2; ++a)
#pragma unroll
            for (int b = 0; b < 2; ++b)
#pragma unroll
                for (int m = 0; m < 4; ++m)
#pragma unroll
                    for (int n = 0; n < 2; ++n) acc[a][b][m][n] = (f32x4){0.f, 0.f, 0.f, 0.f};
        cur = nxt; cA = nA; cB = nB; ++ui;
        if constexpr (ALIGN_EPI) { if (wr == 1) PG8_BAR; }
    }
    PG8_WAIT_V(0);
    if constexpr (!ALIGN_EPI) { if (wr == 0) PG8_BAR; }
    PG8_BAR;
#undef PG8_SA
#undef PG8_SB
#undef PG8_STAGE
#undef PG8_LDA
#undef PG8_LDB
#undef PG8_MMA
#undef PG8_WAIT_V
#undef PG8_WAIT_L
#undef PG8_BAR
#undef PG8_SCHED
}

typedef const f32x4 (&AccRef)[2][2][4][2];
__device__ __forceinline__ u32x4 pack8(f32x4 v0, f32x4 v1) { u32x4 w; w.x = cvt_pk_bf16(v0[0], v0[1]); w.y = cvt_pk_bf16(v0[2], v0[3]); w.z = cvt_pk_bf16(v1[0], v1[1]); w.w = cvt_pk_bf16(v1[2], v1[3]); return w; }

struct EpiProj {
    bf16_t *PA, *PZ, *PC, *PG, *KR; float *SSQ, *SSKV; unsigned* KMR; const f32x2* rope;
    __device__ __forceinline__ void operator()(AccRef acc, const Unit& u, int wr, int wc, int fr, int fq) const {
        bf16_t* base; int ldc, colt, act;
        if (u.pn < 3) { base = PA; ldc = 768; colt = u.pn * 256; act = 0; }
        else if (u.pn < 7) { base = PZ; ldc = 1024; colt = (u.pn - 3) * 256; act = 1; }
        else if (u.pn < 10) { base = PC; ldc = 768; colt = (u.pn - 7) * 256; act = 0; }
        else { base = PG; ldc = 2048; colt = (u.pn - 10) * 256; act = 2; }
        const int row0 = u.pm * BM + wr * 64 + fr, col0 = colt + wc * 32 + 8 * fq;
        const bool ispc = (u.pn >= 7) && (u.pn < 10);
        float rmax = 0.f;
#pragma unroll
        for (int ai = 0; ai < 2; ++ai)
#pragma unroll
            for (int m = 0; m < 4; ++m) { const int row = row0 + ai * HALF + m * 16; bf16_t* rowp = base + (size_t)row * ldc + col0;
#pragma unroll
                for (int bj = 0; bj < 2; ++bj) { f32x4 v0 = acc[ai][bj][m][0], v1 = acc[ai][bj][m][1];
                    if (act != 0) {
#pragma unroll
                        for (int e = 0; e < 4; ++e) { const float s0 = sigmoidf_fast(v0[e]), s1 = sigmoidf_fast(v1[e]); v0[e] = (act == 1) ? v0[e] * s0 : s0; v1[e] = (act == 1) ? v1[e] * s1 : s1; }
                    }
                    *(u32x4*)(rowp + bj * HALF) = pack8(v0, v1);
                    if (ispc) { const int cg = colt + bj * HALF + wc * 32;
                        if (cg < 672) {
                            float ss = (v0[0] * v0[0] + v0[1] * v0[1]) + (v0[2] * v0[2] + v0[3] * v0[3]) + (v1[0] * v1[0] + v1[1] * v1[1]) + (v1[2] * v1[2] + v1[3] * v1[3]);
                            ss += __shfl_xor(ss, 16); ss += __shfl_xor(ss, 32);
                            if (cg < 640) { if (fq == 0) atomicAdd((cg < 384 ? SSQ : SSKV) + row, ss); }
                            else { rmax = fmaxf(rmax, ss);
                                const f32x4* tp = (const f32x4*)(rope + (size_t)pos_of_row(row) * 16 + 4 * fq); const f32x4 c0 = tp[0], c1 = tp[1];
                                f32x4 w0, w1;
                                w0[0] = v0[0] * c0[0] - v0[1] * c0[1]; w0[1] = v0[0] * c0[1] + v0[1] * c0[0];
                                w0[2] = v0[2] * c0[2] - v0[3] * c0[3]; w0[3] = v0[2] * c0[3] + v0[3] * c0[2];
                                w1[0] = v1[0] * c1[0] - v1[1] * c1[1]; w1[1] = v1[0] * c1[1] + v1[1] * c1[0];
                                w1[2] = v1[2] * c1[2] - v1[3] * c1[3]; w1[3] = v1[2] * c1[3] + v1[3] * c1[2];
                                *(u32x4*)(KR + (size_t)row * 32 + 8 * fq) = pack8(w0, w1); } } } }
                asm volatile("" ::: "memory"); }
        if (u.pn == 9 && wc == 0) {
            rmax = fmaxf(rmax, __shfl_xor(rmax, 1)); rmax = fmaxf(rmax, __shfl_xor(rmax, 2)); rmax = fmaxf(rmax, __shfl_xor(rmax, 4)); rmax = fmaxf(rmax, __shfl_xor(rmax, 8));
            if (fr == 0 && fq == 0) atomicMax(KMR + batch_of_row(u.pm * BM), __float_as_uint(rmax)); }
    }
};
struct EpiQ {
    bf16_t* QB; const float* ssq; const f32x2* rope;
    __device__ __forceinline__ void operator()(AccRef acc, const Unit& u, int wr, int wc, int fr, int fq) const {
        const int row0 = u.pm * BM + wr * 64 + fr; const int colb = u.pn * BM + wc * 32 + 8 * fq;
        const int dp0 = colb % 96, dp1 = (colb + HALF) % 96;
#pragma unroll
        for (int ai = 0; ai < 2; ++ai)
#pragma unroll
            for (int m = 0; m < 4; ++m) { const int row = row0 + ai * HALF + m * 16; const float r = 1.0f / sqrtf(ssq[row] * (1.f / 384.f) + EPS); const f32x2* tr = rope + (size_t)pos_of_row(row) * 16;
#pragma unroll
                for (int bj = 0; bj < 2; ++bj) { const int dp = bj ? dp1 : dp0;
                    f32x4 v0 = acc[ai][bj][m][0] * r, v1 = acc[ai][bj][m][1] * r;
                    if (dp >= 64) { const f32x4* tp = (const f32x4*)(tr + ((dp - 64) >> 1)); const f32x4 c0 = tp[0], c1 = tp[1];
                        f32x4 w0, w1;
                        w0[0] = v0[0] * c0[0] - v0[1] * c0[1]; w0[1] = v0[0] * c0[1] + v0[1] * c0[0];
                        w0[2] = v0[2] * c0[2] - v0[3] * c0[3]; w0[3] = v0[2] * c0[3] + v0[3] * c0[2];
                        w1[0] = v1[0] * c1[0] - v1[1] * c1[1]; w1[1] = v1[0] * c1[1] + v1[1] * c1[0];
                        w1[2] = v1[2] * c1[2] - v1[3] * c1[3]; w1[3] = v1[2] * c1[3] + v1[3] * c1[2];
                        v0 = w0; v1 = w1; }
                    *(u32x4*)(QB + (size_t)row * 768 + colb + bj * HALF) = pack8(v0, v1); }
                asm volatile("" ::: "memory"); }
    }
};
struct EpiKV {
    bf16_t *KN, *VB; const float* sskv; unsigned* KMX;
    __device__ __forceinline__ void operator()(AccRef acc, const Unit& u, int wr, int wc, int fr, int fq) const {
        bf16_t* base = (u.pn < 2) ? KN : VB; const int colt = (u.pn & 1) * 256;
        const int row0 = u.pm * BM + wr * 64 + fr, col0 = colt + wc * 32 + 8 * fq;
        float mx0 = 0.f, mx1 = 0.f;
#pragma unroll
        for (int ai = 0; ai < 2; ++ai)
#pragma unroll
            for (int m = 0; m < 4; ++m) { const int row = row0 + ai * HALF + m * 16; const float r = 1.0f / sqrtf(sskv[row] * (1.f / 256.f) + EPS); bf16_t* rowp = base + (size_t)row * 512 + col0;
#pragma unroll
                for (int bj = 0; bj < 2; ++bj) { const f32x4 v0 = acc[ai][bj][m][0] * r, v1 = acc[ai][bj][m][1] * r; *(u32x4*)(rowp + bj * HALF) = pack8(v0, v1);
                    if (u.pn < 2) { float ss = (v0[0] * v0[0] + v0[1] * v0[1]) + (v0[2] * v0[2] + v0[3] * v0[3]) + (v1[0] * v1[0] + v1[1] * v1[1]) + (v1[2] * v1[2] + v1[3] * v1[3]);
                        ss += __shfl_xor(ss, 16); ss += __shfl_xor(ss, 32); if (bj == 0) mx0 = fmaxf(mx0, ss); else mx1 = fmaxf(mx1, ss); } } }
        if (u.pn < 2) {
#pragma unroll
            for (int o = 1; o < 16; o <<= 1) { mx0 = fmaxf(mx0, __shfl_xor(mx0, o)); mx1 = fmaxf(mx1, __shfl_xor(mx1, o)); }
            if (fr == 0 && fq == 0) { unsigned* kp = KMX + batch_of_row(u.pm * BM) * 16 + (u.pn & 1) * 8 + wc; atomicMax(kp, __float_as_uint(mx0)); atomicMax(kp + 4, __float_as_uint(mx1)); } }
    }
};
template <bool FIRST> struct EpiGate {
    bf16_t* T; const bf16_t* PG; int goff;
    __device__ __forceinline__ void operator()(AccRef acc, const Unit& u, int wr, int wc, int fr, int fq) const {
        const int row0 = u.pm * BM + wr * 64 + fr, col0 = u.pn * BM + wc * 32 + 8 * fq;
#pragma unroll
        for (int ai = 0; ai < 2; ++ai)
#pragma unroll
            for (int m = 0; m < 4; ++m) { const int row = row0 + ai * HALF + m * 16;
#pragma unroll
                for (int bj = 0; bj < 2; ++bj) { const int col = col0 + bj * HALF;
                    const u32x4 gw = *(const u32x4*)(PG + (size_t)row * 2048 + goff + col);
                    f32x4 v0 = acc[ai][bj][m][0], v1 = acc[ai][bj][m][1];
                    v0[0] *= bf_lo(gw.x); v0[1] *= bf_hi(gw.x); v0[2] *= bf_lo(gw.y); v0[3] *= bf_hi(gw.y);
                    v1[0] *= bf_lo(gw.z); v1[1] *= bf_hi(gw.z); v1[2] *= bf_lo(gw.w); v1[3] *= bf_hi(gw.w);
                    bf16_t* tp = T + (size_t)row * 1024 + col;
                    if (!FIRST) { const u32x4 tw = *(const u32x4*)tp;
                        v0[0] += bf_lo(tw.x); v0[1] += bf_hi(tw.x); v0[2] += bf_lo(tw.y); v0[3] += bf_hi(tw.y);
                        v1[0] += bf_lo(tw.z); v1[1] += bf_hi(tw.z); v1[2] += bf_lo(tw.w); v1[3] += bf_hi(tw.w); }
                    *(u32x4*)tp = pack8(v0, v1); } }
    }
};
struct EpiOut {
    const float *xp, *xs; float* out; const float* mod; const float* b_ada;
    __device__ __forceinline__ void operator()(AccRef acc, const Unit& u, int wr, int wc, int fr, int fq) const {
        const int rowt = u.pm * BM; const int b = batch_of_row(rowt);
        const float* xbase = rowt < M_P ? xp + (size_t)rowt * DM : xs + (size_t)(rowt - M_P) * DM;
        float* obase = out + (size_t)rowt * DM;
        const int col0 = u.pn * BM + wc * 32 + 8 * fq;
        f32x4 g[2][2];
#pragma unroll
        for (int bj = 0; bj < 2; ++bj)
#pragma unroll
            for (int n = 0; n < 2; ++n) g[bj][n] = *(const f32x4*)(mod + (size_t)b * 3 * DM + 2 * DM + col0 + bj * HALF + 4 * n) + *(const f32x4*)(b_ada + 2 * DM + col0 + bj * HALF + 4 * n);
#pragma unroll
        for (int ai = 0; ai < 2; ++ai)
#pragma unroll
            for (int m = 0; m < 4; ++m) { const size_t off = (size_t)(wr * 64 + fr + ai * HALF + m * 16) * DM + col0;
#pragma unroll
                for (int bj = 0; bj < 2; ++bj)
#pragma unroll
                    for (int n = 0; n < 2; ++n) { const f32x4 xv = *(const f32x4*)(xbase + off + bj * HALF + 4 * n);
                        *(f32x4*)(obase + off + bj * HALF + 4 * n) = xv + g[bj][n] * acc[ai][bj][m][n]; } }
    }
};
}

namespace att {
constexpr int NW = 8, QBLK = 32, KVBLK = 64;
constexpr int SHM_V = 8192, SHM_KN = 8192, SHM_KR = 4096;
constexpr int OFF_V = 0, OFF_KN = 2 * SHM_V, OFF_KR = OFF_KN + 2 * SHM_KN, OFF_WS = OFF_KR + 2 * SHM_KR, LDS_BYTES = OFF_WS + NW * 64 * 4;
constexpr float THR2 = 8.0f;
#define SBAR() __builtin_amdgcn_sched_barrier(0)
__device__ __forceinline__ int crow(int r, int hi) { return (r & 3) + 8 * (r >> 2) + 4 * hi; }
__device__ __forceinline__ int v_st(int k, int c) { const int kk = (k & ~0xC) | ((k & 4) << 1) | ((k & 8) >> 1); return ((kk >> 3) * 2 + (c >> 5)) * 512 + ((kk & 7) * 32 + (c & 31)) * 2; }
__device__ __forceinline__ int v_rd_base(int lane) { return ((lane & 3) << 3) | (((lane >> 2) & 3) << 6) | (((lane >> 4) & 1) << 5) | (((lane >> 5) & 1) << 8); }
constexpr int v_rd_off(int d0, int ks, int half) { return d0 * 512 + ks * 2048 + half * 1024; }
template <int OFF> __device__ __forceinline__ s16x4 tr_read(int vb) { s16x4 r; asm volatile("ds_read_b64_tr_b16 %0, %1 offset:%2" : "=&v"(r) : "v"(vb), "i"(OFF) : "memory"); return r; }
template <int D0> __device__ __forceinline__ void pv_one(f32x16& od, int vb, bf16x8 pa0, bf16x8 pa1, bf16x8 pa2, bf16x8 pa3) {
    const s16x4 l0 = tr_read<v_rd_off(D0, 0, 0)>(vb), h0 = tr_read<v_rd_off(D0, 0, 1)>(vb), l1 = tr_read<v_rd_off(D0, 1, 0)>(vb), h1 = tr_read<v_rd_off(D0, 1, 1)>(vb);
    const s16x4 l2 = tr_read<v_rd_off(D0, 2, 0)>(vb), h2 = tr_read<v_rd_off(D0, 2, 1)>(vb), l3 = tr_read<v_rd_off(D0, 3, 0)>(vb), h3 = tr_read<v_rd_off(D0, 3, 1)>(vb);
    asm volatile("s_waitcnt lgkmcnt(0)" ::: "memory"); SBAR();
#define PK(L, H) (bf16x8){L[0], L[1], L[2], L[3], H[0], H[1], H[2], H[3]}
    od = __builtin_amdgcn_mfma_f32_32x32x16_bf16(pa0, PK(l0, h0), od, 0, 0, 0);
    od = __builtin_amdgcn_mfma_f32_32x32x16_bf16(pa1, PK(l1, h1), od, 0, 0, 0);
    od = __builtin_amdgcn_mfma_f32_32x32x16_bf16(pa2, PK(l2, h2), od, 0, 0, 0);
    od = __builtin_amdgcn_mfma_f32_32x32x16_bf16(pa3, PK(l3, h3), od, 0, 0, 0);
#undef PK
}
__device__ __forceinline__ void pv_d0(f32x16* o, int vb, bf16x8 pa0, bf16x8 pa1, bf16x8 pa2, bf16x8 pa3) { pv_one<0>(o[0], vb, pa0, pa1, pa2, pa3); pv_one<1>(o[1], vb, pa0, pa1, pa2, pa3); }

template <int DQK> __device__ __forceinline__ void qkt(f32x16& p0, f32x16& p1, const char* Kn_s, const char* Kr_s, const bf16x8* qr, int r32, int hi) {
    p0 = f32x16{}; p1 = f32x16{};
    const int keyn = (r32 >> 1) & 7, keyr = (r32 >> 2) & 3;
#pragma unroll
    for (int d0 = 0; d0 < 4; ++d0) { const int off = r32 * 128 + (((2 * d0 + hi) ^ keyn) << 4);
        const bf16x8 b0 = *reinterpret_cast<const bf16x8*>(Kn_s + off), b1 = *reinterpret_cast<const bf16x8*>(Kn_s + off + 32 * 128);
        p0 = __builtin_amdgcn_mfma_f32_32x32x16_bf16(b0, qr[d0], p0, 0, 0, 0);
        p1 = __builtin_amdgcn_mfma_f32_32x32x16_bf16(b1, qr[d0], p1, 0, 0, 0); }
    if constexpr (DQK == 96) {
#pragma unroll
        for (int d0 = 0; d0 < 2; ++d0) { const int off = r32 * 64 + (((2 * d0 + hi) ^ keyr) << 4);
            const bf16x8 b0 = *reinterpret_cast<const bf16x8*>(Kr_s + off), b1 = *reinterpret_cast<const bf16x8*>(Kr_s + off + 32 * 64);
            p0 = __builtin_amdgcn_mfma_f32_32x32x16_bf16(b0, qr[4 + d0], p0, 0, 0, 0);
            p1 = __builtin_amdgcn_mfma_f32_32x32x16_bf16(b1, qr[4 + d0], p1, 0, 0, 0); }
    }
}
template <bool WIN> __device__ __forceinline__ void partialSM(f32x16& p0, f32x16& p1, float& m_reg, float& alpha, int drel, float slope2, int hi) {
    if constexpr (WIN) {
#pragma unroll
        for (int r = 0; r < 16; ++r) { const int d0_ = drel + crow(r, hi), d1_ = d0_ + 32; const float a0 = fabsf((float)d0_), a1 = fabsf((float)d1_);
            p0[r] = (a0 <= 128.f) ? p0[r] - slope2 * a0 : -1e30f; p1[r] = (a1 <= 128.f) ? p1[r] - slope2 * a1 : -1e30f; }
    }
    float pmax = p0[0];
#pragma unroll
    for (int r = 1; r < 16; ++r) pmax = fmaxf(pmax, p0[r]);
#pragma unroll
    for (int r = 0; r < 16; ++r) pmax = fmaxf(pmax, p1[r]);
    { auto rr = __builtin_amdgcn_permlane32_swap(__float_as_uint(pmax), __float_as_uint(pmax), false, false); pmax = fmaxf(__uint_as_float(rr[0]), __uint_as_float(rr[1])); }
    float mn;
    if (__builtin_expect(__all(pmax - m_reg <= THR2), 1)) { mn = m_reg; alpha = 1.f; }
    else { mn = fmaxf(m_reg, pmax); alpha = __builtin_amdgcn_exp2f(m_reg - mn); m_reg = mn; }
#pragma unroll
    for (int r = 0; r < 16; ++r) { p0[r] = p0[r] - mn; p1[r] = p1[r] - mn; }
#pragma unroll
    for (int r = 0; r < 16; ++r) p0[r] = __builtin_amdgcn_exp2f(p0[r]);
}
__device__ __forceinline__ void finishSM(f32x16& p0, f32x16& p1, float alpha, float& l_reg, bf16x8& pa0, bf16x8& pa1, bf16x8& pa2, bf16x8& pa3) {
#pragma unroll
    for (int r = 0; r < 16; ++r) p1[r] = __builtin_amdgcn_exp2f(p1[r]);
    float ps = 0;
#pragma unroll
    for (int r = 0; r < 16; ++r) ps += p0[r];
#pragma unroll
    for (int r = 0; r < 16; ++r) ps += p1[r];
    { auto rr = __builtin_amdgcn_permlane32_swap(__float_as_uint(ps), __float_as_uint(ps), false, false); ps = __uint_as_float(rr[0]) + __uint_as_float(rr[1]); }
    l_reg = l_reg * alpha + ps;
#define PK4(P, BASE, OUT) do { unsigned a0 = cvt_pk_bf16(P[BASE + 0], P[BASE + 1]), a1 = cvt_pk_bf16(P[BASE + 2], P[BASE + 3]);   \
    unsigned b0 = cvt_pk_bf16(P[BASE + 4], P[BASE + 5]), b1 = cvt_pk_bf16(P[BASE + 6], P[BASE + 7]);                              \
    auto r0 = __builtin_amdgcn_permlane32_swap(a0, b0, false, false); auto r1 = __builtin_amdgcn_permlane32_swap(a1, b1, false, false); \
    u32x4 w = {r0[0], r1[0], r0[1], r1[1]}; OUT = *reinterpret_cast<bf16x8*>(&w); } while (0)
    PK4(p0, 0, pa0); PK4(p0, 8, pa1); PK4(p1, 0, pa2); PK4(p1, 8, pa3);
#undef PK4
}

template <int DQK, bool WIN>
__device__ __forceinline__ void attn_unit(const bf16_t* __restrict__ Qb, int ldq, const bf16_t* __restrict__ Kn, int ldk, const bf16_t* __restrict__ Kr,
                                          const bf16_t* __restrict__ Vh, int ldv, const bf16_t* __restrict__ Zb, int ldz, bf16_t* __restrict__ Ob, int ldo,
                                          int t0, int NT, int qpos0, float slope2, float sink2, char* lds) {
    constexpr int ND0 = DQK / 16;
    int tid = threadIdx.x; asm volatile("" : "+v"(tid));
    const int wid = __builtin_amdgcn_readfirstlane(tid >> 6), lane = tid & 63, r32 = lane & 31, hi = lane >> 5;
    char* V_lds = lds + OFF_V; char* Kn_lds = lds + OFF_KN; char* Kr_lds = lds + OFF_KR;
    float* ws = (float*)(lds + OFF_WS) + wid * 64; float* li_l = ws; float* al_l = ws + 32;
    float m_reg = WIN ? sink2 : -1e30f, l_reg = WIN ? 1.f : 0.f; f32x16 o[2] = {}; bf16x8 qr[ND0];
    const bf16_t* Qw = Qb + (size_t)(wid * QBLK + r32) * ldq + hi * 8;
#pragma unroll
    for (int d0 = 0; d0 < ND0; ++d0) qr[d0] = *reinterpret_cast<const bf16x8*>(Qw + d0 * 16);
    const int sr = tid >> 3, sc = (tid & 7) * 8;
    const int vst = v_st(sr, sc), knst = sr * 128 + (((tid & 7) ^ ((sr >> 1) & 7)) << 4);
    const int rr_ = (tid >> 2) & 63, rc_ = tid & 3, krst = rr_ * 64 + ((rc_ ^ ((rr_ >> 2) & 3)) << 4);
    const bool do_kr = (DQK == 96) && (wid < 4);
    const int vb0 = (int)(uintptr_t)V_lds + v_rd_base(lane);
    const int qposl = qpos0 + wid * QBLK + r32;
    struct { bf16x8 vs, ks, rs; } st_[2];
    const bf16_t* Vp = Vh + (size_t)t0 * KVBLK * ldv + (size_t)sr * ldv + sc;
    const bf16_t* Kp = Kn + (size_t)t0 * KVBLK * ldk + (size_t)sr * ldk + sc;
    const bf16_t* Rp = Kr + (size_t)t0 * KVBLK * 32 + (size_t)rr_ * 32 + rc_ * 8;
#define SLOAD(i, t) do { st_[i].vs = *reinterpret_cast<const bf16x8*>(Vp + (size_t)(t) * KVBLK * ldv); st_[i].ks = *reinterpret_cast<const bf16x8*>(Kp + (size_t)(t) * KVBLK * ldk); \
        if (do_kr) st_[i].rs = *reinterpret_cast<const bf16x8*>(Rp + (size_t)(t) * KVBLK * 32); } while (0)
#define SWRITE(b, i) do { *(bf16x8*)(V_lds + (b) * SHM_V + vst) = st_[i].vs; *(bf16x8*)(Kn_lds + (b) * SHM_KN + knst) = st_[i].ks; \
        if (do_kr) *(bf16x8*)(Kr_lds + (b) * SHM_KR + krst) = st_[i].rs; } while (0)
#define SWAIT() do { if (do_kr) asm volatile("s_waitcnt vmcnt(3)" ::: "memory"); else asm volatile("s_waitcnt vmcnt(2)" ::: "memory"); } while (0)
#define RESC(a) do { if (__any((a) < 1.f)) { if (hi == 0) al_l[r32] = (a); asm volatile("s_waitcnt lgkmcnt(0)" ::: "memory"); \
        _Pragma("unroll") for (int d = 0; d < 2; ++d) _Pragma("unroll") for (int r = 0; r < 16; ++r) o[d][r] *= al_l[crow(r, hi)]; } } while (0)
#define DREL(t) ((t0 + (t)) * KVBLK - qposl)
    f32x16 pA0, pA1, pB0, pB1; float alA = 1.f, alB = 1.f; bf16x8 pa0, pa1, pa2, pa3;
    const int wq_lo = qpos0 + wid * QBLK - 128, wq_hi = qpos0 + wid * QBLK + QBLK - 1 + 128;
#define ACT(t) (!WIN || (((t0 + (t)) * KVBLK + KVBLK - 1 >= wq_lo) && ((t0 + (t)) * KVBLK <= wq_hi)))
    SLOAD(0, 0); asm volatile("s_waitcnt vmcnt(0)" ::: "memory"); SWRITE(0, 0); __syncthreads();
    if (ACT(0)) { qkt<DQK>(pA0, pA1, Kn_lds, Kr_lds, qr, r32, hi); partialSM<WIN>(pA0, pA1, m_reg, alA, DREL(0), slope2, hi); }
    SLOAD(1, 1); if (2 < NT) SLOAD(0, 2);
    SWAIT(); SWRITE(1, 1); __syncthreads();
    for (int j = 1; j + 1 < NT; j += 2) {
        const bool a0 = ACT(j - 1), a1 = ACT(j), a2 = ACT(j + 1);
        SBAR(); if (a1) qkt<DQK>(pB0, pB1, Kn_lds + SHM_KN, Kr_lds + SHM_KR, qr, r32, hi);
        if (a0) finishSM(pA0, pA1, alA, l_reg, pa0, pa1, pa2, pa3); SBAR();
        SLOAD(1, j + 2); SBAR();
        if (a0) pv_d0(o, vb0, pa0, pa1, pa2, pa3); alB = 1.f; if (a1) partialSM<WIN>(pB0, pB1, m_reg, alB, DREL(j), slope2, hi);
        __syncthreads(); SWAIT(); SWRITE(0, 0);
        RESC(alB); __syncthreads();
        SBAR(); if (a2) qkt<DQK>(pA0, pA1, Kn_lds, Kr_lds, qr, r32, hi);
        if (a1) finishSM(pB0, pB1, alB, l_reg, pa0, pa1, pa2, pa3); SBAR();
        if (j + 3 < NT) SLOAD(0, j + 3); SBAR();
        if (a1) pv_d0(o, vb0 + SHM_V, pa0, pa1, pa2, pa3); alA = 1.f; if (a2) partialSM<WIN>(pA0, pA1, m_reg, alA, DREL(j + 1), slope2, hi);
        __syncthreads(); SWAIT(); SWRITE(1, 1);
        RESC(alA); __syncthreads();
    }
    { const bool a0 = ACT(NT - 2), a1 = ACT(NT - 1);
    SBAR(); if (a1) qkt<DQK>(pB0, pB1, Kn_lds + SHM_KN, Kr_lds + SHM_KR, qr, r32, hi);
    if (a0) finishSM(pA0, pA1, alA, l_reg, pa0, pa1, pa2, pa3); SBAR();
    if (a0) pv_d0(o, vb0, pa0, pa1, pa2, pa3); alB = 1.f; if (a1) partialSM<WIN>(pB0, pB1, m_reg, alB, DREL(NT - 1), slope2, hi);
    __syncthreads(); RESC(alB);
    if (a1) { finishSM(pB0, pB1, alB, l_reg, pa0, pa1, pa2, pa3); SBAR();
    pv_d0(o, vb0 + SHM_V, pa0, pa1, pa2, pa3); } }
#undef ACT
    if (hi == 0) li_l[r32] = l_reg; asm volatile("s_waitcnt lgkmcnt(0)" ::: "memory");
#pragma unroll
    for (int r = 0; r < 16; ++r) { const int orow = wid * QBLK + crow(r, hi); const float rl = __builtin_amdgcn_rcpf(li_l[crow(r, hi)]);
#pragma unroll
        for (int d0 = 0; d0 < 2; ++d0) { const float z = __uint_as_float((unsigned)Zb[(size_t)orow * ldz + d0 * 32 + r32] << 16);
            const unsigned w = cvt_pk_bf16(o[d0][r] * rl * z, 0.f); Ob[(size_t)orow * ldo + d0 * 32 + r32] = (bf16_t)(w & 0xffffu); } }
    __syncthreads();
#undef SLOAD
#undef SWRITE
#undef SWAIT
#undef RESC
#undef DREL
}
#undef SBAR
}

namespace mla {
constexpr int NW = 8, KSLOT = 12288, VSLOT = 8192, NKS = 4, NVS = 3;
constexpr int LDS_K = 0, LDS_V = NKS * KSLOT, LDS_WS = LDS_V + NVS * VSLOT, LDS_OST = LDS_WS + NW * 256, LDS_BYTES = LDS_OST + NW * 4096;
#define SBAR() __builtin_amdgcn_sched_barrier(0)
#define PIN(x) asm volatile("" : "+v"(x))
#define MFMA(a, b, c) __builtin_amdgcn_mfma_f32_32x32x16_bf16(a, b, c, 0, 0, 0)
#define WAIT_BAR(N) asm volatile("s_waitcnt vmcnt(" #N ") lgkmcnt(0)\n\ts_barrier" ::: "memory")
__device__ __forceinline__ int crow(int r, int hi) { return (r & 3) + 8 * (r >> 2) + 4 * hi; }
__device__ __forceinline__ unsigned cvtpk(float lo, float hi) { unsigned r; asm("v_cvt_pk_bf16_f32 %0, %1, %2" : "=v"(r) : "v"(lo), "v"(hi)); return r; }
__device__ __forceinline__ void glds16(const void* g, unsigned lds_base) {
    unsigned sv; asm volatile("s_mov_b32 %0, m0\n\ts_mov_b32 m0, %2\n\ts_nop 0\n\tglobal_load_lds_dwordx4 %1, off\n\ts_mov_b32 m0, %0" : "=&s"(sv) : "v"(g), "s"(lds_base) : "memory"); }
typedef __attribute__((address_space(3))) const char* lds_cptr;
typedef short v4i16_t __attribute__((ext_vector_type(4)));
__device__ __forceinline__ bf16x8 kld(lds_cptr p) { return *(const __attribute__((address_space(3))) bf16x8*)p; }
__device__ __forceinline__ s16x4 vtr(lds_cptr p) { return __builtin_bit_cast(s16x4, __builtin_amdgcn_ds_read_tr16_b64_v4i16((__attribute__((address_space(3))) v4i16_t*)p)); }

__device__ __forceinline__ void mla_unit(const bf16_t* __restrict__ Qu, const bf16_t* __restrict__ Knh, const bf16_t* __restrict__ Krs, const bf16_t* __restrict__ Vhh,
                                         const bf16_t* __restrict__ Zu, bf16_t* __restrict__ Ou, int NT, float kmax, char* lds) {
    int tid = threadIdx.x; asm volatile("" : "+v"(tid));
    const int lane = tid & 63, r32 = lane & 31, hi = lane >> 5; const int wid = __builtin_amdgcn_readfirstlane(tid >> 6); const bool wlow = wid < 4;
    const unsigned lds0 = (unsigned)(uintptr_t)lds; float* wsf = (float*)(lds + LDS_WS) + wid * 64;
    const bf16_t* ksrc = Knh + (size_t)lane * 512 + wid * 8;
    const bf16_t* rsrc = Krs + (size_t)lane * 32 + (wid & 3) * 8;
    const bf16_t* vsrc = Vhh + (size_t)(16 * (wid & 3) + (lane >> 2)) * 512 + (wid >> 2) * 32 + (lane & 3) * 8;
    const unsigned kdst = lds0 + LDS_K + wid * 1024, rdst = lds0 + LDS_K + (8 + (wid & 3)) * 1024, vdst = lds0 + LDS_V + wid * 1024;
#define DMA_K(t, slot) do { glds16(ksrc + (size_t)(t) * 64 * 512, (unsigned)__builtin_amdgcn_readfirstlane(kdst + (slot))); \
        if (wlow) glds16(rsrc + (size_t)(t) * 64 * 32, (unsigned)__builtin_amdgcn_readfirstlane(rdst + (slot))); } while (0)
#define DMA_V(t, slot) glds16(vsrc + (size_t)(t) * 64 * 512, (unsigned)__builtin_amdgcn_readfirstlane(vdst + (slot)))
#define WAITB(NHI, NLO) do { if (wlow) { WAIT_BAR(NLO); } else { WAIT_BAR(NHI); } } while (0)
    const lds_cptr vp0 = (lds_cptr)lds + LDS_V + ((lane >> 4) & 1) * 32 + (lane & 3) * 8 + (4 * hi + ((lane & 15) >> 2)) * 64;
    const lds_cptr kp0 = (lds_cptr)lds + LDS_K + hi * 1024 + r32 * 16;
    DMA_K(0, 0); DMA_V(0, 0); DMA_K(1, KSLOT);
    bf16x8 qr[6];
    const bf16_t* Qw = Qu + (size_t)(wid * 32 + r32) * 768 + hi * 8;
#pragma unroll
    for (int d0 = 0; d0 < 6; ++d0) qr[d0] = *reinterpret_cast<const bf16x8*>(Qw + d0 * 16);
    DMA_K(2, 2 * KSLOT);
    float qs = 0.f;
#pragma unroll
    for (int d0 = 0; d0 < 6; ++d0)
#pragma unroll
        for (int e = 0; e < 8; ++e) { const float v = __uint_as_float((unsigned)(unsigned short)qr[d0][e] << 16); qs += v * v; }
    { auto rr = __builtin_amdgcn_permlane32_swap(__float_as_uint(qs), __float_as_uint(qs), false, false); qs = __uint_as_float(rr[0]) + __uint_as_float(rr[1]); }
    const float mrow = sqrtf(qs) * kmax * 1.001f + 1e-3f;
    f32x16 negm;
#pragma unroll
    for (int r = 0; r < 16; ++r) negm[r] = -mrow;
    PIN(negm);
    float l_reg = 0.f; f32x16 o[2]; o[0] = f32x16{}; o[1] = f32x16{};
    f32x16 pA0, pA1, pB0, pB1; bf16x8 kf[12]; s16x4 vlo[8], vhi[8]; u32x4 pw0, pw1, pw2, pw3;
    int vs_prev = 0, vs_cur = 0, vs_next = VSLOT;
#define ROT() do { vs_prev = vs_cur; vs_cur = vs_next; vs_next = (vs_next == 2 * VSLOT) ? 0 : vs_next + VSLOT; } while (0)
#define KS(t) (((t) & 3) * KSLOT)
#define EX(v) __builtin_amdgcn_exp2f(v)
    WAITB(3, 5);
#pragma unroll
    for (int i = 0; i < 12; ++i) kf[i] = kld(kp0 + (i >> 1) * 2048 + (i & 1) * 512);
    pA0 = MFMA(kf[0], qr[0], negm); pA1 = MFMA(kf[1], qr[0], negm);
#pragma unroll
    for (int d0 = 1; d0 < 6; ++d0) { pA0 = MFMA(kf[2 * d0], qr[d0], pA0); pA1 = MFMA(kf[2 * d0 + 1], qr[d0], pA1); }
#pragma unroll
    for (int r = 0; r < 16; ++r) { pA0[r] = EX(pA0[r]); pA1[r] = EX(pA1[r]); }
    WAIT_BAR(0);
    DMA_K(3, 3 * KSLOT); DMA_V(1, VSLOT); ROT();
    kf[0] = kld(kp0 + KS(1)); kf[1] = kld(kp0 + KS(1) + 512);
#define PKW(P, i) cvtpk(P[i], P[i + 1])
#define PAF(k) __builtin_bit_cast(bf16x8, pw##k)
#define VFR(i) (bf16x8){vlo[i][0], vlo[i][1], vlo[i][2], vlo[i][3], vhi[i][0], vhi[i][1], vhi[i][2], vhi[i][3]}
#define VRD(i) do { vlo[i] = vtr(vp_ + (((i) >> 2) * 4096 + ((i) & 3) * 1024)); vhi[i] = vtr(vp_ + (((i) >> 2) * 4096 + ((i) & 3) * 1024 + 512)); } while (0)
#define KRD(i) do { kf[i] = kld(kp_ + ((i) >> 1) * 2048 + ((i) & 1) * 512); } while (0)
#define GAPA3(MF, a0, a1, a2, W0, PW) do { MF; sacc += a0; sacc += a1; sacc += a2; W0; PIN(PW); PIN(sacc); SBAR(); } while (0)
#define GAPA2(MF, a0, a1, W0, W1, PW) do { MF; sacc += a0; sacc += a1; W0; W1; PIN(PW); PIN(sacc); SBAR(); } while (0)
#define GAPB(MF, X, i) do { MF; X[i] = EX(X[i]); X[i + 1] = EX(X[i + 1]); X[i + 2] = EX(X[i + 2]); X[i + 3] = EX(X[i + 3]); PIN(X); SBAR(); } while (0)
#define STEP(C0, C1, P0, P1, t, GK, GV, GL) do { SBAR(); \
    const lds_cptr kp_ = kp0 + KS(t); const lds_cptr vp_ = vp0 + vs_prev; float sacc = P0[0] + P0[1]; \
    KRD(2);  SBAR(); GAPA3(C0 = MFMA(kf[0],  qr[0], negm), P0[2],  P0[3],  P0[4],  pw0[0] = PKW(P0, 0),  pw0); \
    KRD(3);  SBAR(); GAPA3(C1 = MFMA(kf[1],  qr[0], negm), P0[5],  P0[6],  P0[7],  pw0[1] = PKW(P0, 2),  pw0); \
    KRD(4);  SBAR(); GAPA3(C0 = MFMA(kf[2],  qr[1], C0),   P0[8],  P0[9],  P0[10], pw0[2] = PKW(P0, 4),  pw0); \
    KRD(5);  SBAR(); GAPA3(C1 = MFMA(kf[3],  qr[1], C1),   P0[11], P0[12], P0[13], pw0[3] = PKW(P0, 6),  pw0); \
    KRD(6);  SBAR(); GAPA3(C0 = MFMA(kf[4],  qr[2], C0),   P0[14], P0[15], P1[0],  pw1[0] = PKW(P0, 8),  pw1); \
    KRD(7);  SBAR(); GAPA3(C1 = MFMA(kf[5],  qr[2], C1),   P1[1],  P1[2],  P1[3],  pw1[1] = PKW(P0, 10), pw1); \
    KRD(8);  SBAR(); GAPA3(C0 = MFMA(kf[6],  qr[3], C0),   P1[4],  P1[5],  P1[6],  pw1[2] = PKW(P0, 12), pw1); \
    KRD(9);  SBAR(); GAPA3(C1 = MFMA(kf[7],  qr[3], C1),   P1[7],  P1[8],  P1[9],  pw1[3] = PKW(P0, 14), pw1); \
    KRD(10); SBAR(); GAPA2(C0 = MFMA(kf[8],  qr[4], C0),   P1[10], P1[11], pw2[0] = PKW(P1, 0),  pw2[1] = PKW(P1, 2),  pw2); \
    KRD(11); SBAR(); GAPA2(C1 = MFMA(kf[9],  qr[4], C1),   P1[12], P1[13], pw2[2] = PKW(P1, 4),  pw2[3] = PKW(P1, 6),  pw2); \
    VRD(0);  SBAR(); GAPA2(C0 = MFMA(kf[10], qr[5], C0),   P1[14], P1[15], pw3[0] = PKW(P1, 8),  pw3[1] = PKW(P1, 10), pw3); \
    VRD(4);  SBAR(); GAPA2(C1 = MFMA(kf[11], qr[5], C1),   0.f,    0.f,    pw3[2] = PKW(P1, 12), pw3[3] = PKW(P1, 14), pw3); \
    l_reg += sacc; \
    if (GK) DMA_K((t) + 3, KS((t) + 3)); if (GV) DMA_V((t) + 1, vs_next); \
    SBAR(); \
    VRD(1); SBAR(); GAPB(o[0] = MFMA(PAF(0), VFR(0), o[0]), C0, 0); \
    VRD(5); SBAR(); GAPB(o[1] = MFMA(PAF(0), VFR(4), o[1]), C0, 4); \
    VRD(2); SBAR(); GAPB(o[0] = MFMA(PAF(1), VFR(1), o[0]), C0, 8); \
    VRD(6); SBAR(); GAPB(o[1] = MFMA(PAF(1), VFR(5), o[1]), C0, 12); \
    VRD(3); SBAR(); GAPB(o[0] = MFMA(PAF(2), VFR(2), o[0]), C1, 0); \
    VRD(7); SBAR(); GAPB(o[1] = MFMA(PAF(2), VFR(6), o[1]), C1, 4); \
    if (GL) { kf[0] = kld(kp0 + KS((t) + 1)); kf[1] = kld(kp0 + KS((t) + 1) + 512); } SBAR(); \
                    GAPB(o[0] = MFMA(PAF(3), VFR(3), o[0]), C1, 8); \
                    GAPB(o[1] = MFMA(PAF(3), VFR(7), o[1]), C1, 12); \
    } while (0)
    int t = 1;
    for (; t + 4 < NT; t += 2) {
        STEP(pB0, pB1, pA0, pA1, t, true, true, true);     WAITB(2, 3); ROT();
        STEP(pA0, pA1, pB0, pB1, t + 1, true, true, true); WAITB(2, 3); ROT();
    }
    STEP(pB0, pB1, pA0, pA1, t, false, true, true);      WAIT_BAR(1); ROT();
    STEP(pA0, pA1, pB0, pB1, t + 1, false, true, true);  WAIT_BAR(0); ROT();
    STEP(pB0, pB1, pA0, pA1, t + 2, false, false, false);
    { float sacc = pB0[0] + pB0[1];
#pragma unroll
      for (int r = 2; r < 16; ++r) sacc += pB0[r];
#pragma unroll
      for (int r = 0; r < 16; ++r) sacc += pB1[r];
      l_reg += sacc;
      pw0 = (u32x4){PKW(pB0, 0), PKW(pB0, 2), PKW(pB0, 4), PKW(pB0, 6)}; pw1 = (u32x4){PKW(pB0, 8), PKW(pB0, 10), PKW(pB0, 12), PKW(pB0, 14)};
      pw2 = (u32x4){PKW(pB1, 0), PKW(pB1, 2), PKW(pB1, 4), PKW(pB1, 6)}; pw3 = (u32x4){PKW(pB1, 8), PKW(pB1, 10), PKW(pB1, 12), PKW(pB1, 14)};
      const lds_cptr vp_ = vp0 + vs_cur; VRD(0); VRD(4); VRD(1); VRD(5); VRD(2); VRD(6); VRD(3); VRD(7);
      o[0] = MFMA(PAF(0), VFR(0), o[0]); o[1] = MFMA(PAF(0), VFR(4), o[1]); o[0] = MFMA(PAF(1), VFR(1), o[0]); o[1] = MFMA(PAF(1), VFR(5), o[1]);
      o[0] = MFMA(PAF(2), VFR(2), o[0]); o[1] = MFMA(PAF(2), VFR(6), o[1]); o[0] = MFMA(PAF(3), VFR(3), o[0]); o[1] = MFMA(PAF(3), VFR(7), o[1]); }
    { auto rr = __builtin_amdgcn_permlane32_swap(__float_as_uint(l_reg), __float_as_uint(l_reg), false, false); l_reg = __uint_as_float(rr[0]) + __uint_as_float(rr[1]); }
    if (hi == 0) wsf[32 + r32] = l_reg; asm volatile("s_waitcnt lgkmcnt(0)" ::: "memory");
    bf16_t* stg = (bf16_t*)(lds + LDS_OST) + wid * 2048;
    const bf16_t* Zw = Zu + (size_t)(wid * 32) * 1024; bf16_t* Ow = Ou + (size_t)(wid * 32) * 512;
#pragma unroll
    for (int r = 0; r < 16; ++r) { const int orow = crow(r, hi); const float rl = __builtin_amdgcn_rcpf(wsf[32 + orow]);
#pragma unroll
        for (int d0 = 0; d0 < 2; ++d0) { const float z = __uint_as_float((unsigned)Zw[(size_t)orow * 1024 + d0 * 32 + r32] << 16);
            stg[orow * 64 + d0 * 32 + r32] = (bf16_t)(cvtpk(o[d0][r] * rl * z, 0.f) & 0xffffu); } }
    asm volatile("s_waitcnt lgkmcnt(0)" ::: "memory");
#pragma unroll
    for (int i = 0; i < 4; ++i) { const int row = i * 8 + (lane >> 3), ch = lane & 7; *(u32x4*)(Ow + (size_t)row * 512 + ch * 8) = *(const u32x4*)(stg + row * 64 + ch * 8); }
    asm volatile("s_waitcnt lgkmcnt(0)\n\ts_barrier" ::: "memory");
#undef DMA_K
#undef DMA_V
#undef WAITB
#undef ROT
#undef KS
#undef EX
#undef PKW
#undef PAF
#undef VFR
#undef VRD
#undef KRD
#undef GAPA3
#undef GAPA2
#undef GAPB
#undef STEP
}
#undef SBAR
#undef PIN
#undef MFMA
#undef WAIT_BAR
}

constexpr int NWAVES = 8;
constexpr int LDS_BYTES = 147456;
static_assert(pg8::STAGE_BYTES <= 131072 && att::LDS_BYTES <= 131072 && mla::LDS_BYTES <= 131072, "LDS map");


#define XB_TMO      128
#define XB_XCNT(j)  (256  + 64 * (j))
#define XB_XSUB(j)  (1280 + 64 * (j))
#define XB_XGEN(j)  (2304 + 64 * (j))
#define XB_TOP      3328
#define XB_TOPGEN   3392
#define XCD_BAR_WORDS 3456
#define XB_SPIN_CAP (1u << 18)
__device__ __forceinline__ unsigned xb_ld(unsigned* p)              { return __hip_atomic_load(p, __ATOMIC_RELAXED, __HIP_MEMORY_SCOPE_AGENT); }
__device__ __forceinline__ unsigned xb_add(unsigned* p, unsigned v) { return __hip_atomic_fetch_add(p, v, __ATOMIC_RELAXED, __HIP_MEMORY_SCOPE_AGENT); }
__device__ __forceinline__ unsigned xb_xcc_id() { return (unsigned)__builtin_amdgcn_s_getreg((3 << 11) | 20) & 0xFu; }
#define XB_SPIN(cond, bar) do { unsigned _sp = 0; while (cond) { __builtin_amdgcn_s_sleep(1); \
    if ((++_sp & 255u) == 0u) { if (xb_ld(&(bar)[XB_TMO])) break; if (_sp > XB_SPIN_CAP) { atomicAdd(&(bar)[XB_TMO], 1u); break; } } } } while (0)
struct XcdBarrier { unsigned* bar; unsigned x; volatile LAS unsigned* st; };
__device__ __forceinline__ XcdBarrier xcd_barrier_post(unsigned* bar, volatile LAS unsigned* st) {
    XcdBarrier b; b.bar = bar; b.x = xb_xcc_id(); b.st = st;
    if (threadIdx.x == 0) (void)xb_add(&bar[XB_XCNT(b.x)], 1u);
    return b;
}
__device__ __forceinline__ void xcd_barrier_complete(unsigned* bar, unsigned x, unsigned& nloc, unsigned& nx) {
    const unsigned G = gridDim.x * gridDim.y * gridDim.z;
    unsigned sum, cnt, mine, sp = 0u;
    for (;;) {
        sum = 0u; cnt = 0u; mine = 0u;
#pragma unroll
        for (unsigned j = 0; j < 16; ++j) { const unsigned c = xb_ld(&bar[XB_XCNT(j)]); sum += c; cnt += (c > 0u) ? 1u : 0u; mine = (j == x) ? c : mine; }
        if (sum == G) break;
        __builtin_amdgcn_s_sleep(1);
        if ((++sp & 255u) == 0u) { if (xb_ld(&bar[XB_TMO])) break; if (sp > XB_SPIN_CAP) { atomicAdd(&bar[XB_TMO], 1u); break; } }
    }
    nloc = mine > 0u ? mine : 1u; nx = cnt > 0u ? cnt : 1u;
}
__device__ __forceinline__ void xcd_barrier(const XcdBarrier& b) {
    asm volatile("s_waitcnt vmcnt(0)" ::: "memory");
    __syncthreads();
    if (threadIdx.x == 0) {
        unsigned* bar = b.bar;
        __builtin_amdgcn_s_waitcnt(0);
        unsigned nloc = b.st[0], nx = b.st[1];
        if (nloc == 0u) { xcd_barrier_complete(bar, b.x, nloc, nx); b.st[0] = nloc; b.st[1] = nx; }
        const unsigned old = xb_add(&bar[XB_XSUB(b.x)], 1u);
        const unsigned gen = old / nloc;
        if (old + 1u == (gen + 1u) * nloc) {
            __builtin_amdgcn_fence(__ATOMIC_RELEASE, "agent");
            asm volatile("s_waitcnt vmcnt(0)" ::: "memory");
            const unsigned og = xb_add(&bar[XB_TOP], 1u);
            const unsigned tg = og / nx;
            if (og + 1u == (tg + 1u) * nx) xb_add(&bar[XB_TOPGEN], 1u);
            else XB_SPIN(xb_ld(&bar[XB_TOPGEN]) == tg, bar);
            __builtin_amdgcn_fence(__ATOMIC_ACQUIRE, "agent");
            xb_add(&bar[XB_XGEN(b.x)], 1u);
            asm volatile("s_waitcnt vmcnt(0)" ::: "memory");
        } else {
            XB_SPIN(xb_ld(&bar[XB_XGEN(b.x)]) == gen, bar);
            __builtin_amdgcn_fence(__ATOMIC_ACQUIRE, "agent");
            asm volatile("s_waitcnt vmcnt(0)" ::: "memory");
        }
    }
    __syncthreads();
}

struct Params { const float* in[17]; float* out; unsigned char* ws; int ph_lo, ph_hi; };

__device__ const double ROPE_INV[16] = {1.0, 0.5623413251903491, 0.31622776601683794, 0.1778279410038923, 0.1, 0.05623413251903491, 0.03162277660168379, 0.01778279410038923,
                                        0.01, 0.005623413251903491, 0.0031622776601683794, 0.0017782794100389228, 0.001, 0.0005623413251903491, 0.00031622776601683794, 0.00017782794100389227};

__device__ __forceinline__ unsigned f2bf(float f) { unsigned u = __builtin_bit_cast(unsigned, f); return (u + 0x7fffu + ((u >> 16) & 1u)) >> 16; }
__device__ __forceinline__ unsigned pk2(float lo, float hi) { return f2bf(lo) | (f2bf(hi) << 16); }

__device__ __forceinline__ int wsrc_col(int kind, int n, float& cs) {
    cs = 1.f;
    if (kind == 0) {
        if (n < 1280) { if (n < 512) cs = QA_SCALE; return n; }
        if (n < 1792) return n - 1280 + 1952;
        if (n < 2432) return n - 1792 + 1280;
        if (n < 2464) { const int j = n - 2432; return 1920 + (j >> 1) + 16 * (j & 1); }
        if (n < 2560) return -1;
        return n - 2560 + 2464;
    } else if (kind == 1) {
        cs = QB_SCALE; const int h = n / 96, d = n % 96;
        if (d < 64) return h * 96 + d;
        const int j = d - 64; return h * 96 + 64 + (j >> 1) + 16 * (j & 1);
    } else if (kind == 2) {
        if (n < 512) return (n >> 6) * 128 + (n & 63);
        const int q = n - 512; return (q >> 6) * 128 + 64 + (q & 63);
    }
    return n;
}
__device__ __forceinline__ void transpose_item(const float* W, int K, int Nsrc, int Ndst, int kind, const float* kgain, bf16_t* WT, LAS float* scr, int item, int lane) {
    const int nblk = Ndst / 32, kb = item / nblk, nb = item % nblk, k0 = 64 * kb, n0 = 32 * nb;
    float cs; const int src = wsrc_col(kind, n0 + (lane & 31), cs);
#pragma unroll 8
    for (int i = 0; i < 32; ++i) { const int kk = 2 * i + (lane >> 5); float v = 0.f;
        if (src >= 0) { v = W[(size_t)(k0 + kk) * Nsrc + src] * cs; if (kgain) v *= kgain[k0 + kk]; }
        scr[kk * 33 + (lane & 31)] = v; }
    asm volatile("s_waitcnt lgkmcnt(0)" ::: "memory");
    const int c = lane & 7;
#pragma unroll
    for (int j = 0; j < 4; ++j) { const int n = (lane >> 3) + 8 * j; const LAS float* s = scr + (8 * c) * 33 + n;
        u32x4 o; o.x = pk2(s[0 * 33], s[1 * 33]); o.y = pk2(s[2 * 33], s[3 * 33]); o.z = pk2(s[4 * 33], s[5 * 33]); o.w = pk2(s[6 * 33], s[7 * 33]);
        *(u32x4*)(WT + (size_t)(n0 + n) * K + k0 + 8 * c) = o; }
    asm volatile("s_waitcnt lgkmcnt(0)" ::: "memory");
}

__global__ void __launch_bounds__(NWAVES * 64, 2) mk_fwd(Params p) {
    extern __shared__ __attribute__((aligned(16))) unsigned char lds[];
    cg::grid_group grid = cg::this_grid();
    volatile LAS unsigned* bst = (volatile LAS unsigned*)((LAS unsigned char*)lds + LDS_BYTES - 64);
    if (threadIdx.x < 16) bst[threadIdx.x] = 0u;
    __syncthreads();
    const XcdBarrier xbar = xcd_barrier_post((unsigned*)(p.ws + WS_BAR), bst);
    const int G = gridDim.x, bx = blockIdx.x;
    const int vcu = (G % 8 == 0) ? (bx % 8) * (G / 8) + bx / 8 : bx;
    const int NGW = G * NWAVES;
    typedef const __attribute__((address_space(4))) Params* KP;
    const KP PP = (KP)__builtin_amdgcn_kernarg_segment_ptr();
#define PHASE_PTRS() KP q_ = PP; asm volatile("" : "+s"(q_)); unsigned char* ws = q_->ws; (void)ws; \
    const float *x_p = q_->in[0], *x_s = q_->in[1], *c_p = q_->in[2], *c_s = q_->in[3], *w_ada = q_->in[4], *b_ada = q_->in[5], *g_norm = q_->in[6], *w_in = q_->in[7], *g_q = q_->in[8], *w_uq = q_->in[9], \
                *g_kv = q_->in[10], *w_ukv = q_->in[11], *sink = q_->in[12], *w_oa = q_->in[13], *w_ob = q_->in[14], *w_out = q_->in[15], *g_final = q_->in[16]; float* outp = q_->out; \
    (void)x_p; (void)x_s; (void)c_p; (void)c_s; (void)w_ada; (void)b_ada; (void)g_norm; (void)w_in; (void)g_q; (void)w_uq; (void)g_kv; (void)w_ukv; (void)sink; (void)w_oa; (void)w_ob; (void)w_out; (void)g_final; (void)outp; \
    int tid = threadIdx.x; asm volatile("" : "+v"(tid)); const int lane = tid & 63, wave = __builtin_amdgcn_readfirstlane(tid >> 6), gw = vcu * NWAVES + wave; (void)lane; (void)wave; (void)gw; \
    float* mod = (float*)(ws + WS_MOD); f32x2* rope = (f32x2*)(ws + WS_ROPE); (void)mod; (void)rope; \
    bf16_t *Win_t = (bf16_t*)(ws + WS_WIN), *Wuq_t = (bf16_t*)(ws + WS_WUQ), *Wukv_t = (bf16_t*)(ws + WS_WUKV), *Woa_t = (bf16_t*)(ws + WS_WOA), *Wob_t = (bf16_t*)(ws + WS_WOB), *Wout_t = (bf16_t*)(ws + WS_WOUT); \
    (void)Win_t; (void)Wuq_t; (void)Wukv_t; (void)Woa_t; (void)Wob_t; (void)Wout_t; \
    float *SSQ = (float*)(ws + WS_SSQ), *SSKV = (float*)(ws + WS_SSKV); unsigned *KMX = (unsigned*)(ws + WS_KMX), *KMR = (unsigned*)(ws + WS_KMR); (void)SSQ; (void)SSKV; (void)KMX; (void)KMR; \
    bf16_t *HB = (bf16_t*)(ws + WS_QB), *YA = (bf16_t*)(ws + WS_YA), *YB = (bf16_t*)(ws + WS_PA); (void)HB; (void)YA; (void)YB; \
    bf16_t *PA = (bf16_t*)(ws + WS_PA), *QB = (bf16_t*)(ws + WS_QB); (void)PA; (void)QB; \
    bf16_t *PZ = (bf16_t*)(ws + WS_PZ), *TM = (bf16_t*)(ws + WS_PZ); (void)PZ; (void)TM; \
    bf16_t *PC = (bf16_t*)(ws + WS_PC), *KN = (bf16_t*)(ws + WS_KN), *VB = (bf16_t*)(ws + WS_VB), *KR = (bf16_t*)(ws + WS_KR); (void)PC; (void)KN; (void)VB; (void)KR; \
    bf16_t* PG = (bf16_t*)outp; (void)PG;
    const int lo = p.ph_lo, hi = p.ph_hi;
    if (hi < lo) grid.sync();
#ifndef PH_MASK
#define PH_MASK 0x3ff
#endif
#define IN(k) (((PH_MASK >> (k)) & 1) && lo <= (k) && (k) < hi)
#define GBAR() xcd_barrier(xbar)
#define SEAM(k) do { if (IN(k) && IN((k) + 1)) GBAR(); } while (0)
#ifndef REP_MASK
#define REP_MASK 0
#endif
#define REPS(k) (1 + ((REP_MASK >> (k)) & 1))
#define REPSYNC() do { if (rep_) GBAR(); } while (0)

    if (IN(0)) { PHASE_PTRS();
        LAS float* scr = (LAS float*)((LAS unsigned char*)lds + wave * 16384);
        constexpr int I_IN = (DM / 64) * (N_IN / 32), I_UQ = (384 / 64) * (768 / 32), I_UKV = (256 / 64) * (1024 / 32), I_OA = (512 / 64) * (1024 / 32), I_OUT = (1024 / 64) * (1024 / 32);
        constexpr int NITEMS = I_IN + I_UQ + I_UKV + 2 * I_OA + I_OUT;
        for (int it = gw; it < NITEMS; it += NGW) {
            int r = it;
            if (r < I_IN) { transpose_item(w_in, DM, D_IN, N_IN, 0, nullptr, Win_t, scr, r, lane); continue; } r -= I_IN;
            if (r < I_UQ) { transpose_item(w_uq, 384, 768, 768, 1, g_q, Wuq_t, scr, r, lane); continue; } r -= I_UQ;
            if (r < I_UKV) { transpose_item(w_ukv, 256, 1024, 1024, 2, g_kv, Wukv_t, scr, r, lane); continue; } r -= I_UKV;
            if (r < I_OA) { transpose_item(w_oa, 512, 1024, 1024, 3, nullptr, Woa_t, scr, r, lane); continue; } r -= I_OA;
            if (r < I_OA) { transpose_item(w_ob, 512, 1024, 1024, 3, nullptr, Wob_t, scr, r, lane); continue; } r -= I_OA;
            transpose_item(w_out, 1024, 1024, 1024, 3, nullptr, Wout_t, scr, r, lane);
        }
        for (int it = gw; it < 16 * 48; it += NGW) { const int ks = it / 48, cgp = it % 48, col = cgp * 64 + lane; float a[NBATCH];
#pragma unroll
            for (int b = 0; b < NBATCH; ++b) a[b] = 0.f;
            for (int k = ks * 64; k < ks * 64 + 64; ++k) { const float w = w_ada[(size_t)k * 3 * DM + col];
#pragma unroll
                for (int b = 0; b < NBATCH; ++b) { const float c = (b < NB_P) ? c_p[b * DM + k] : c_s[(b - NB_P) * DM + k]; a[b] += c * sigmoidf_fast(c) * w; } }
#pragma unroll
            for (int b = 0; b < NBATCH; ++b) atomicAdd(mod + b * 3 * DM + col, a[b]);
        }
        for (int e = gw * 64 + lane; e < S_S * 16; e += NGW * 64) { const int pos = e >> 4, i = e & 15;
            const double ang = (double)pos * ROPE_INV[i]; const double n = rint(ang * 0.6366197723675814);
            const double r = (ang - n * 1.5707963267948966) - n * 6.123233995736766e-17; const double r2 = r * r;
            const double sn = r * (1.0 + r2 * (-1.0 / 6 + r2 * (1.0 / 120 + r2 * (-1.0 / 5040 + r2 * (1.0 / 362880 + r2 * (-1.0 / 39916800 + r2 * (1.0 / 6227020800.0)))))));
            const double cn = 1.0 + r2 * (-0.5 + r2 * (1.0 / 24 + r2 * (-1.0 / 720 + r2 * (1.0 / 40320 + r2 * (-1.0 / 3628800 + r2 * (1.0 / 479001600.0))))));
            const int q = (int)((long long)n & 3); double cs_, sn_;
            if (q == 0) { cs_ = cn; sn_ = sn; } else if (q == 1) { cs_ = -sn; sn_ = cn; } else if (q == 2) { cs_ = -cn; sn_ = -sn; } else { cs_ = sn; sn_ = -cn; }
            rope[e] = (f32x2){(float)cs_, (float)sn_}; }
    }
    SEAM(0);
    for (int rep_ = 0; rep_ < REPS(1); ++rep_) { REPSYNC();
    if (IN(1)) { PHASE_PTRS();
        constexpr int RPW = 24;
        for (int base = gw * RPW; base < M; base += NGW * RPW) {
            int cb = -1; f32x4 ga[4], sh[4];
            for (int row = base; row < base + RPW && row < M; row += 2) {
                const int b = batch_of_row(row);
                if (b != cb) { cb = b;
#pragma unroll
                    for (int j = 0; j < 4; ++j) { const int c = 4 * lane + 256 * j;
                        const f32x4 sc = *(const f32x4*)(mod + b * 3 * DM + DM + c) + *(const f32x4*)(b_ada + DM + c);
                        sh[j] = *(const f32x4*)(mod + b * 3 * DM + c) + *(const f32x4*)(b_ada + c);
                        ga[j] = *(const f32x4*)(g_norm + c) * (sc + 1.0f); } }
                const float* xr = row < M_P ? x_p + (size_t)row * DM : x_s + (size_t)(row - M_P) * DM;
                f32x4 v[2][4]; float s0 = 0.f, s1 = 0.f;
#pragma unroll
                for (int j = 0; j < 4; ++j) { v[0][j] = *(const f32x4*)(xr + 4 * lane + 256 * j); v[1][j] = *(const f32x4*)(xr + DM + 4 * lane + 256 * j); }
#pragma unroll
                for (int j = 0; j < 4; ++j) { s0 += (v[0][j].x * v[0][j].x + v[0][j].y * v[0][j].y) + (v[0][j].z * v[0][j].z + v[0][j].w * v[0][j].w);
                                              s1 += (v[1][j].x * v[1][j].x + v[1][j].y * v[1][j].y) + (v[1][j].z * v[1][j].z + v[1][j].w * v[1][j].w); }
                const float r0 = 1.0f / sqrtf(wave_sum(s0) * (1.f / DM) + EPS), r1 = 1.0f / sqrtf(wave_sum(s1) * (1.f / DM) + EPS);
#pragma unroll
                for (int j = 0; j < 4; ++j) { const f32x4 h0 = v[0][j] * r0 * ga[j] + sh[j], h1 = v[1][j] * r1 * ga[j] + sh[j]; u32x2 w0, w1;
                    w0.x = cvt_pk_bf16(h0.x, h0.y); w0.y = cvt_pk_bf16(h0.z, h0.w); w1.x = cvt_pk_bf16(h1.x, h1.y); w1.y = cvt_pk_bf16(h1.z, h1.w);
                    *(u32x2*)(HB + (size_t)row * DM + 4 * lane + 256 * j) = w0; *(u32x2*)(HB + (size_t)(row + 1) * DM + 4 * lane + 256 * j) = w1; }
            }
        }
    }
    }
    SEAM(1);
    for (int rep_ = 0; rep_ < REPS(2); ++rep_) { REPSYNC();
    if (IN(2)) { PHASE_PTRS();
        pg8::Gemm g{HB, Win_t, M, N_IN, DM, DM}; pg8::StaticOrder S; S.init(M, N_IN, G, bx);
        pg8::EpiProj E{PA, PZ, PC, PG, KR, SSQ, SSKV, KMR, rope};
        pg8::gemm_phase<pg8::EpiProj, 1024, 1024>((LAS unsigned char*)lds, g, S, E);
    }
    }
    SEAM(2);
    for (int rep_ = 0; rep_ < REPS(3); ++rep_) { REPSYNC();
    if (IN(3)) { PHASE_PTRS();
        for (int U = vcu; U < (M / 256) * 8; U += G) { const int rb = U >> 3, h = U & 7, kvh = h >> 2; const int row0 = rb * 256;
            const int S = row0 < M_P ? S_P : S_S; const int qpos0 = pos_of_row(row0); const int seq0 = row0 - qpos0;
            const int ks = qpos0 - 128 < 0 ? 0 : qpos0 - 128, ke = qpos0 + 384 > S ? S : qpos0 + 384;
            const float slope2 = exp2f(-(float)(h + 1)) * LOG2E, sink2 = sink[h] * LOG2E;
            att::attn_unit<64, true>(PA + (size_t)row0 * 768 + h * 64, 768, PA + (size_t)seq0 * 768 + 512 + kvh * 64, 768, nullptr, PA + (size_t)seq0 * 768 + 640 + kvh * 64, 768,
                                     PZ + (size_t)row0 * 1024 + h * 64, 1024, YA + (size_t)row0 * 512 + h * 64, 512, ks / 64, (ke - ks) / 64, qpos0, slope2, sink2, (char*)lds);
        }
#ifndef NO_Q
        { pg8::Gemm g{PC, Wuq_t, M, 768, 384, 768}; pg8::StaticOrder S; S.init(M, 768, G, bx); pg8::EpiQ E{QB, SSQ, rope};
          pg8::gemm_phase<pg8::EpiQ, 384, 768>((LAS unsigned char*)lds, g, S, E); }
#endif
#ifndef NO_KV
        { pg8::Gemm g{PC + 384, Wukv_t, M, 1024, 256, 768}; pg8::StaticOrder S; S.init(M, 1024, G, bx); pg8::EpiKV E{KN, VB, SSKV, KMX};
          pg8::gemm_phase<pg8::EpiKV, 256, 768>((LAS unsigned char*)lds, g, S, E); }
#endif
    }
    }
    SEAM(3);
    for (int rep_ = 0; rep_ < REPS(5); ++rep_) { REPSYNC();
    if (IN(5)) { PHASE_PTRS();
        for (int U = vcu; U < 1536; U += G) {
            int row0, seq0, S, h, b;
            if (U < 1024) { const int i = U >> 8, v = U & 255, xcd = v >> 5, c = v & 31; const int bh = 2 * xcd + (i >> 1), qb = (i & 1) * 32 + c; b = bh >> 3; h = bh & 7;
                S = S_S; seq0 = M_P + b * S_S; row0 = seq0 + qb * 256; b += NB_P; }
            else { const int U2 = U - 1024; const int j = U2 >> 8, v = U2 & 255, xcd = v >> 5, c = v & 31; const int bh = 4 * xcd + 2 * j + (c >> 4), qb = c & 15; b = bh >> 3; h = bh & 7;
                S = S_P; seq0 = b * S_P; row0 = seq0 + qb * 256; }
            const float kmax = sqrtf(1.02f * (__uint_as_float(__hip_atomic_load(KMX + b * 16 + 2 * h, __ATOMIC_RELAXED, __HIP_MEMORY_SCOPE_AGENT)) + __uint_as_float(__hip_atomic_load(KMX + b * 16 + 2 * h + 1, __ATOMIC_RELAXED, __HIP_MEMORY_SCOPE_AGENT))
                                             + __uint_as_float(__hip_atomic_load(KMR + b, __ATOMIC_RELAXED, __HIP_MEMORY_SCOPE_AGENT))));
            mla::mla_unit(QB + (size_t)row0 * 768 + h * 96, KN + (size_t)seq0 * 512 + h * 64, KR + (size_t)seq0 * 32, VB + (size_t)seq0 * 512 + h * 64,
                          PZ + (size_t)row0 * 1024 + 512 + h * 64, YB + (size_t)row0 * 512 + h * 64, S / 64, kmax, (char*)lds);
        }
    }
    }
    SEAM(5);
    for (int rep_ = 0; rep_ < REPS(6); ++rep_) { REPSYNC();
    if (IN(6)) { PHASE_PTRS(); pg8::Gemm g{YA, Woa_t, M, 1024, 512, 512}; pg8::StaticOrder S; S.init(M, 1024, G, bx); pg8::EpiGate<true> E{TM, PG, 0};
        pg8::gemm_phase<pg8::EpiGate<true>, 512, 512>((LAS unsigned char*)lds, g, S, E); }
    SEAM(6);
    if (IN(7)) { PHASE_PTRS(); pg8::Gemm g{YB, Wob_t, M, 1024, 512, 512}; pg8::StaticOrder S; S.init(M, 1024, G, bx); pg8::EpiGate<false> E{TM, PG, 1024};
        pg8::gemm_phase<pg8::EpiGate<false>, 512, 512>((LAS unsigned char*)lds, g, S, E); }
    SEAM(7);
    }
    for (int rep_ = 0; rep_ < REPS(8); ++rep_) { REPSYNC();
    if (IN(8)) { PHASE_PTRS(); pg8::Gemm g{TM, Wout_t, M, 1024, 1024, 1024}; pg8::StaticOrder S; S.init(M, 1024, G, bx); pg8::EpiOut E{x_p, x_s, outp, mod, b_ada};
        pg8::gemm_phase<pg8::EpiOut, 1024, 1024>((LAS unsigned char*)lds, g, S, E); }
    SEAM(8);
    if (IN(9)) { PHASE_PTRS();
        f32x4 gf[4];
#pragma unroll
        for (int j = 0; j < 4; ++j) gf[j] = *(const f32x4*)(g_final + 4 * lane + 256 * j);
        for (int row = 2 * gw; row < M; row += 2 * NGW) { float* orow = outp + (size_t)row * DM; f32x4 v[2][4]; float s0 = 0.f, s1 = 0.f;
#pragma unroll
            for (int j = 0; j < 4; ++j) { v[0][j] = *(const f32x4*)(orow + 4 * lane + 256 * j); v[1][j] = *(const f32x4*)(orow + DM + 4 * lane + 256 * j); }
#pragma unroll
            for (int j = 0; j < 4; ++j) { s0 += (v[0][j].x * v[0][j].x + v[0][j].y * v[0][j].y) + (v[0][j].z * v[0][j].z + v[0][j].w * v[0][j].w);
                                          s1 += (v[1][j].x * v[1][j].x + v[1][j].y * v[1][j].y) + (v[1][j].z * v[1][j].z + v[1][j].w * v[1][j].w); }
            const float r0 = 1.0f / sqrtf(wave_sum(s0) * (1.f / DM) + EPS), r1 = 1.0f / sqrtf(wave_sum(s1) * (1.f / DM) + EPS);
#pragma unroll
            for (int j = 0; j < 4; ++j) { *(f32x4*)(orow + 4 * lane + 256 * j) = v[0][j] * r0 * gf[j]; *(f32x4*)(orow + DM + 4 * lane + 256 * j) = v[1][j] * r1 * gf[j]; }
        }
    }
    }
#undef IN
#undef SEAM
#undef PHASE_PTRS
}

extern "C" void kernel_launch(void* const* d_in, const int* in_sizes, int n_in, void* d_out, int out_size, void* d_ws, size_t ws_size, hipStream_t stream) {
    static int grid = 0;
    if (grid == 0) {
        if (n_in != 17 || out_size != M * DM || ws_size < WS_END) { fprintf(stderr, "kernel_launch: unexpected shapes: n_in %d out %d ws %zu (need %zu)\n", n_in, out_size, ws_size, (size_t)WS_END); grid = -1; return; }
        int dev = 0, cus = 0, per_cu = 0;
        hipGetDevice(&dev); hipDeviceGetAttribute(&cus, hipDeviceAttributeMultiprocessorCount, dev);
        if (hipFuncSetAttribute((const void*)mk_fwd, hipFuncAttributeMaxDynamicSharedMemorySize, LDS_BYTES) != hipSuccess) { fprintf(stderr, "kernel_launch: hipFuncSetAttribute failed\n"); grid = -1; return; }
        if (hipOccupancyMaxActiveBlocksPerMultiprocessor(&per_cu, (const void*)mk_fwd, NWAVES * 64, LDS_BYTES) != hipSuccess || per_cu < 1) { fprintf(stderr, "kernel_launch: occupancy query says %d\n", per_cu); per_cu = 1; }
        (void)hipGetLastError();
        grid = cus;
    }
    if (grid < 0) return;
    hipMemsetAsync((char*)d_ws + WS_MOD, 0, ZERO_BYTES, stream);
    Params p{};
    for (int i = 0; i < 17; ++i) p.in[i] = (const float*)d_in[i];
    p.out = (float*)d_out; p.ws = (unsigned char*)d_ws;
#if MK_N_LAUNCHES == 1
    p.ph_lo = 0; p.ph_hi = 10;
    void* args[] = {&p};
    hipError_t e = hipLaunchCooperativeKernel((const void*)mk_fwd, dim3(grid), dim3(NWAVES * 64), args, LDS_BYTES, stream);
    if (e != hipSuccess) fprintf(stderr, "cooperative launch failed: %s (grid %d)\n", hipGetErrorString(e), grid);
#else
    for (int ph = 0; ph < 10; ++ph) { p.ph_lo = ph; p.ph_hi = ph + 1; hipLaunchKernelGGL(mk_fwd, dim3(grid), dim3(NWAVES * 64), LDS_BYTES, stream, p); }
#endif
}
```

```cpp
#include <hip/hip_runtime.h>
#include <hip/hip_cooperative_groups.h>
#include <cstdio>
#include <cstdint>
namespace cg = cooperative_groups;

#ifndef MK_N_LAUNCHES
#define MK_N_LAUNCHES 1
#endif

constexpr int DM = 1024;
constexpr int NB_P = 4, S_P = 4096, NB_S = 2, S_S = 16384;
constexpr int M_P = NB_P * S_P, M_S = NB_S * S_S, M = M_P + M_S;
constexpr int D_IN = 4512, N_IN = 4608;
constexpr int NBATCH = NB_P + NB_S;
constexpr float EPS = 1e-6f;
constexpr float LOG2E = 1.4426950408889634f;
constexpr float QA_SCALE = 0.125f * LOG2E;
constexpr float QB_SCALE = 0.10206207261596575f * LOG2E;

constexpr size_t MiB = 1u << 20;
constexpr size_t WS_MOD = 0;
constexpr size_t MOD_BYTES = (size_t)NBATCH * 3 * DM * 4;
constexpr size_t WS_KMX = WS_MOD + MOD_BYTES;
constexpr size_t WS_KMR = WS_KMX + 512;
constexpr size_t WS_KMA = WS_KMX + 1024;
constexpr size_t WS_BAR = 80 * 1024;
constexpr size_t WS_SSQ = 128 * 1024;
constexpr size_t WS_SSKV = WS_SSQ + (size_t)M * 4;
constexpr size_t ZERO_BYTES = 512 * 1024;
static_assert(WS_SSKV + (size_t)M * 4 <= ZERO_BYTES && WS_BAR + 3456 * 4 <= WS_SSQ, "zeroed region");
constexpr size_t WS_ROPE = ZERO_BYTES;
constexpr size_t WS_WIN = WS_ROPE + 2 * MiB;
constexpr size_t WS_WUQ = WS_WIN + (size_t)N_IN * DM * 2;
constexpr size_t WS_WUKV = WS_WUQ + (size_t)768 * 384 * 2;
constexpr size_t WS_WOA = WS_WUKV + (size_t)1024 * 256 * 2;
constexpr size_t WS_WOB = WS_WOA + (size_t)1024 * 512 * 2;
constexpr size_t WS_WOUT = WS_WOB + (size_t)1024 * 512 * 2;
static_assert(WS_WOUT + (size_t)1024 * 1024 * 2 <= 20 * MiB, "small region");
constexpr size_t WS_PA = 20 * MiB;
constexpr size_t WS_PZ = WS_PA + 72 * MiB;
constexpr size_t WS_PC = WS_PZ + 96 * MiB;
constexpr size_t WS_QB = WS_PC + 72 * MiB;
constexpr size_t WS_KN = WS_QB + 72 * MiB;
constexpr size_t WS_VB = WS_KN + 48 * MiB;
constexpr size_t WS_KR = WS_VB + 48 * MiB;
constexpr size_t WS_YA = WS_KR + 3 * MiB;
constexpr size_t WS_END = WS_YA + 48 * MiB;

typedef unsigned short bf16_t;
typedef short bf16x8 __attribute__((ext_vector_type(8)));
typedef short s16x4 __attribute__((ext_vector_type(4)));
typedef float f32x4 __attribute__((ext_vector_type(4)));
typedef float f32x2 __attribute__((ext_vector_type(2)));
typedef float f32x16 __attribute__((ext_vector_type(16)));
typedef unsigned u32x4 __attribute__((ext_vector_type(4)));
typedef unsigned u32x2 __attribute__((ext_vector_type(2)));
#define LAS __attribute__((address_space(3)))

__device__ __forceinline__ unsigned cvt_pk_bf16(float lo, float hi) { unsigned r; asm volatile("v_cvt_pk_bf16_f32 %0, %1, %2" : "=v"(r) : "v"(lo), "v"(hi)); return r; }
__device__ __forceinline__ float bf_lo(unsigned w) { return __uint_as_float(w << 16); }
__device__ __forceinline__ float bf_hi(unsigned w) { return __uint_as_float(w & 0xffff0000u); }
__device__ __forceinline__ float sigmoidf_fast(float v) { return __builtin_amdgcn_rcpf(1.0f + __builtin_amdgcn_exp2f(-v * LOG2E)); }
__device__ __forceinline__ float wave_sum(float v) {
#pragma unroll
    for (int o = 1; o < 64; o <<= 1) v += __shfl_xor(v, o);
    return v;
}
__device__ __forceinline__ int batch_of_row(int row) { return row < M_P ? (row >> 12) : NB_P + ((row - M_P) >> 14); }
__device__ __forceinline__ int pos_of_row(int row) { return row < M_P ? (row & (S_P - 1)) : ((row - M_P) & (S_S - 1)); }

namespace pg8 {
constexpr int BM = 256, BK = 64, HALF = 128, HTB = HALF * BK * 2, STAGE_BYTES = 8 * HTB, NXCD = 8, WGM = 8;
__host__ __device__ __forceinline__ int lds_byte(int r, int c) { const int st = (r >> 4) * 2 + (c >> 5), rr = r & 15, cc = c & 31, ob = rr * 64 + cc * 2; return st * 1024 + (ob ^ (((ob >> 9) & 1) << 5)); }
__host__ __device__ __forceinline__ void stage_rc(int b, int& R, int& C) { const int st = b / 1024, sb = b % 1024, swz = sb ^ (((sb >> 9) & 1) << 5); R = (st >> 1) * 16 + swz / 64; C = (st & 1) * 32 + (swz % 64) / 2; }
__host__ __device__ __forceinline__ int perm32(int rho) { const int n = rho >> 4, i = rho & 15; return 8 * (i >> 2) + 4 * n + (i & 3); }

struct Unit { int pm, pn; };
struct Gemm { const bf16_t* A; const bf16_t* Bt; int M, N, K, lda; };

struct StaticOrder {
    int nM, nN, nwg, G, c;
    __device__ void init(int M_, int N_, int G_, int c_) { nM = M_ / BM; nN = N_ / BM; nwg = nM * nN; G = G_; c = c_; }
    __device__ bool next(int i, Unit& u) const {
        const long L = (long)i * G + c; if (L >= nwg) return false;
        int wgid = (int)L; { const int q = nwg / NXCD, r = nwg % NXCD, xcd = wgid % NXCD, off = wgid / NXCD; wgid = (xcd < r ? xcd * (q + 1) : r * (q + 1) + (xcd - r) * q) + off; }
        const int nig = WGM * nN, gid = wgid / nig, fm = gid * WGM, gsz = (nM - fm) < WGM ? (nM - fm) : WGM;
        u.pm = fm + ((wgid % nig) % gsz); u.pn = (wgid % nig) / gsz; return true;
    }
};

template <class Epi, int K, int LDA, bool ALIGN_EPI = true>
__device__ __forceinline__ void gemm_phase(LAS unsigned char* lds, const Gemm g, const StaticOrder& S, const Epi& E) {
    int tid = threadIdx.x; asm volatile("" : "+v"(tid));
    const int wid = __builtin_amdgcn_readfirstlane(tid >> 6), lane = tid & 63, wr = wid >> 2, wc = wid & 3, fr = lane & 15, fq = lane >> 4;
    constexpr int nt = K / BK, lda = LDA;
    unsigned voffA[2], voffB[2];
#pragma unroll
    for (int i = 0; i < 2; ++i) { int R, C; stage_rc(tid * 16 + i * 8192, R, C); const int Rb = (R & ~31) + perm32(R & 31);
        voffA[i] = (unsigned)(R * lda + C) * 2u; voffB[i] = (unsigned)(Rb * K + C) * 2u; }
    const size_t kstep = (size_t)(BK * 2);
    const size_t hstepA = (size_t)HALF * lda * 2, tstepA = 2 * hstepA;
    const size_t hstepB = (size_t)HALF * K * 2, tstepB = 2 * hstepB;
    const unsigned ldsw = (unsigned)wid * 1024u;
    const int aoff = lds_byte(wr * 64 + fr, fq * 8), boff = lds_byte(wc * 32 + fr, fq * 8);
#define PG8_SA(b, h) (((b) * 2 + (h)) * HTB)
#define PG8_SB(b, h) ((4 + (b) * 2 + (h)) * HTB)
#define PG8_STAGE(bufoff, gbase, voff) do { _Pragma("unroll") for (int _i = 0; _i < 2; ++_i) \
        __builtin_amdgcn_global_load_lds((const unsigned*)((const char*)(gbase) + (voff)[_i]), (LAS unsigned*)(lds + (bufoff) + ldsw + _i * 8192), 16, 0, 0); } while (0)
#define PG8_LDA(dst, b, h) do { _Pragma("unroll") for (int m = 0; m < 4; ++m) _Pragma("unroll") for (int k = 0; k < 2; ++k) dst[m][k] = *(const LAS bf16x8*)(lds + PG8_SA(b, h) + aoff + m * 2048 + k * 1024); } while (0)
#define PG8_LDB(dst, b, h) do { _Pragma("unroll") for (int n = 0; n < 2; ++n) _Pragma("unroll") for (int k = 0; k < 2; ++k) dst[n][k] = *(const LAS bf16x8*)(lds + PG8_SB(b, h) + boff + n * 2048 + k * 1024); } while (0)
#define PG8_MMA(ai, bj, At, Bt) do { __builtin_amdgcn_s_setprio(1); _Pragma("unroll") for (int m = 0; m < 4; ++m) _Pragma("unroll") for (int n = 0; n < 2; ++n) _Pragma("unroll") for (int k = 0; k < 2; ++k) \
        acc[ai][bj][m][n] = __builtin_amdgcn_mfma_f32_16x16x32_bf16(Bt[n][k], At[m][k], acc[ai][bj][m][n], 0, 0, 0); __builtin_amdgcn_s_setprio(0); } while (0)
#define PG8_WAIT_V(n) asm volatile("s_waitcnt vmcnt(" #n ")" ::: "memory")
#define PG8_WAIT_L(n) asm volatile("s_waitcnt lgkmcnt(" #n ")" ::: "memory")
#define PG8_BAR __builtin_amdgcn_s_barrier()
#define PG8_SCHED __builtin_amdgcn_sched_barrier(0)
    Unit cur, nxt; int ui = 0;
    if (!S.next(0, cur)) return;
    f32x4 acc[2][2][4][2];
#pragma unroll
    for (int a = 0; a < 2; ++a)
#pragma unroll
        for (int b = 0; b < 2; ++b)
#pragma unroll
            for (int m = 0; m < 4; ++m)
#pragma unroll
                for (int n = 0; n < 2; ++n) acc[a][b][m][n] = (f32x4){0.f, 0.f, 0.f, 0.f};
    bf16x8 At[4][2], B0[2][2], B1[2][2];
    const char* cA = (const char*)g.A + (size_t)cur.pm * tstepA; const char* cB = (const char*)g.Bt + (size_t)cur.pn * tstepB;
    PG8_STAGE(PG8_SB(0, 0), cB, voffB); PG8_STAGE(PG8_SB(0, 1), cB + hstepB, voffB); PG8_STAGE(PG8_SA(0, 0), cA, voffA); PG8_STAGE(PG8_SA(0, 1), cA + hstepA, voffA);
    if (wr == 1) PG8_BAR;
    PG8_WAIT_V(2); PG8_BAR;
    PG8_STAGE(PG8_SB(1, 0), cB + kstep, voffB); PG8_STAGE(PG8_SA(1, 0), cA + kstep, voffA); PG8_STAGE(PG8_SB(1, 1), cB + hstepB + kstep, voffB);
    PG8_WAIT_V(6); PG8_BAR;
    for (;;) {
        const bool has_next = S.next(ui + 1, nxt);
        const char* nA = has_next ? (const char*)g.A + (size_t)nxt.pm * tstepA : cA; const char* nB = has_next ? (const char*)g.Bt + (size_t)nxt.pn * tstepB : cB;
#pragma unroll 1
        for (int t = 0; t < nt; t += 2) {
            const bool last = (t == nt - 2);
            const char* a1 = cA + (size_t)(t + 1) * kstep;
            const char* a2 = last ? nA : cA + (size_t)(t + 2) * kstep; const char* b2 = last ? nB : cB + (size_t)(t + 2) * kstep;
            const char* a3 = a2 + kstep; const char* b3 = b2 + kstep;
            PG8_LDB(B0, 0, 0); PG8_LDB(B1, 0, 1); PG8_SCHED; PG8_LDA(At, 0, 0); PG8_STAGE(PG8_SA(1, 1), a1 + hstepA, voffA);
            PG8_WAIT_V(8); PG8_WAIT_L(0); PG8_BAR; PG8_MMA(0, 0, At, B0); PG8_MMA(0, 1, At, B1); PG8_BAR; PG8_SCHED;
            PG8_LDA(At, 0, 1); PG8_STAGE(PG8_SB(0, 0), b2, voffB); PG8_STAGE(PG8_SB(0, 1), b2 + hstepB, voffB); PG8_STAGE(PG8_SA(0, 0), a2, voffA);
            PG8_WAIT_V(8); PG8_WAIT_L(0); PG8_BAR; PG8_MMA(1, 0, At, B0); PG8_MMA(1, 1, At, B1); PG8_BAR; PG8_SCHED;
            PG8_LDB(B0, 1, 0); PG8_LDB(B1, 1, 1); PG8_SCHED; PG8_LDA(At, 1, 0); PG8_STAGE(PG8_SA(0, 1), a2 + hstepA, voffA);
            PG8_WAIT_V(8); PG8_WAIT_L(0); PG8_BAR; PG8_MMA(0, 0, At, B0); PG8_MMA(0, 1, At, B1); PG8_BAR; PG8_SCHED;
            PG8_LDA(At, 1, 1); PG8_STAGE(PG8_SB(1, 0), b3, voffB); PG8_STAGE(PG8_SB(1, 1), b3 + hstepB, voffB); PG8_STAGE(PG8_SA(1, 0), a3, voffA);
            PG8_WAIT_V(8); PG8_WAIT_L(0); PG8_BAR; PG8_MMA(1, 0, At, B0); PG8_MMA(1, 1, At, B1); PG8_BAR; PG8_SCHED;
        }
        if constexpr (ALIGN_EPI) { if (wr == 0) PG8_BAR; }
        E(acc, cur, wr, wc, fr, fq);
        if (!has_next) break;
#pragma unroll
        for (int a = 0; a < 2; ++a)
#pragma unroll
            for (int b = 0; b < 2; ++b)
#pragma unroll
                for (int m = 0; m < 4; ++m)
#pragma unroll
                    for (int n = 0; n < 2; ++n) acc[a][b][m][n] = (f32x4){0.f, 0.f, 0.f, 0.f};
        cur = nxt; cA = nA; cB = nB; ++ui;
        if constexpr (ALIGN_EPI) { if (wr == 1) PG8_BAR; }
    }
    PG8_WAIT_V(0);
    if constexpr (!ALIGN_EPI) { if (wr == 0) PG8_BAR; }
    PG8_BAR;
#undef PG8_SA
#undef PG8_SB
#undef PG8_STAGE
#undef PG8_LDA
#undef PG8_LDB
#undef PG8_MMA
#undef PG8_WAIT_V
#undef PG8_WAIT_L
#undef PG8_BAR
#undef PG8_SCHED
}

typedef const f32x4 (&AccRef)[2][2][4][2];
__device__ __forceinline__ u32x4 pack8(f32x4 v0, f32x4 v1) { u32x4 w; w.x = cvt_pk_bf16(v0[0], v0[1]); w.y = cvt_pk_bf16(v0[2], v0[3]); w.z = cvt_pk_bf16(v1[0], v1[1]); w.w = cvt_pk_bf16(v1[2], v1[3]); return w; }

struct EpiProj {
    bf16_t *PA, *PZ, *PC, *PG, *KR; float *SSQ, *SSKV; unsigned *KMR, *KMA; const f32x2* rope;
    __device__ __forceinline__ void operator()(AccRef acc, const Unit& u, int wr, int wc, int fr, int fq) const {
        bf16_t* base; int ldc, colt, act;
        if (u.pn < 3) { base = PA; ldc = 768; colt = u.pn * 256; act = 0; }
        else if (u.pn < 7) { base = PZ; ldc = 1024; colt = (u.pn - 3) * 256; act = 1; }
        else if (u.pn < 10) { base = PC; ldc = 768; colt = (u.pn - 7) * 256; act = 0; }
        else { base = PG; ldc = 2048; colt = (u.pn - 10) * 256; act = 2; }
        const int row0 = u.pm * BM + wr * 64 + fr, col0 = colt + wc * 32 + 8 * fq;
        const bool ispc = (u.pn >= 7) && (u.pn < 10);
        float rmax = 0.f, kamax = 0.f;
#pragma unroll
        for (int ai = 0; ai < 2; ++ai)
#pragma unroll
            for (int m = 0; m < 4; ++m) { const int row = row0 + ai * HALF + m * 16; bf16_t* rowp = base + (size_t)row * ldc + col0;
#pragma unroll
                for (int bj = 0; bj < 2; ++bj) { f32x4 v0 = acc[ai][bj][m][0], v1 = acc[ai][bj][m][1];
                    if (act != 0) {
#pragma unroll
                        for (int e = 0; e < 4; ++e) { const float s0 = sigmoidf_fast(v0[e]), s1 = sigmoidf_fast(v1[e]); v0[e] = (act == 1) ? v0[e] * s0 : s0; v1[e] = (act == 1) ? v1[e] * s1 : s1; }
                    }
                    *(u32x4*)(rowp + bj * HALF) = pack8(v0, v1);
                    if (u.pn == 2 && bj == 0) {
                        float ss = (v0[0] * v0[0] + v0[1] * v0[1]) + (v0[2] * v0[2] + v0[3] * v0[3]) + (v1[0] * v1[0] + v1[1] * v1[1]) + (v1[2] * v1[2] + v1[3] * v1[3]);
                        ss += __shfl_xor(ss, 16); ss += __shfl_xor(ss, 32); kamax = fmaxf(kamax, ss); }
                    if (ispc) { const int cg = colt + bj * HALF + wc * 32;
                        if (cg < 672) {
                            float ss = (v0[0] * v0[0] + v0[1] * v0[1]) + (v0[2] * v0[2] + v0[3] * v0[3]) + (v1[0] * v1[0] + v1[1] * v1[1]) + (v1[2] * v1[2] + v1[3] * v1[3]);
                            ss += __shfl_xor(ss, 16); ss += __shfl_xor(ss, 32);
                            if (cg < 640) { if (fq == 0) atomicAdd((cg < 384 ? SSQ : SSKV) + row, ss); }
                            else { rmax = fmaxf(rmax, ss);
                                const f32x4* tp = (const f32x4*)(rope + (size_t)pos_of_row(row) * 16 + 4 * fq); const f32x4 c0 = tp[0], c1 = tp[1];
                                f32x4 w0, w1;
                                w0[0] = v0[0] * c0[0] - v0[1] * c0[1]; w0[1] = v0[0] * c0[1] + v0[1] * c0[0];
                                w0[2] = v0[2] * c0[2] - v0[3] * c0[3]; w0[3] = v0[2] * c0[3] + v0[3] * c0[2];
                                w1[0] = v1[0] * c1[0] - v1[1] * c1[1]; w1[1] = v1[0] * c1[1] + v1[1] * c1[0];
                                w1[2] = v1[2] * c1[2] - v1[3] * c1[3]; w1[3] = v1[2] * c1[3] + v1[3] * c1[2];
                                *(u32x4*)(KR + (size_t)row * 32 + 8 * fq) = pack8(w0, w1); } } } }
                asm volatile("" ::: "memory"); }
        if (u.pn == 2) {
            kamax = fmaxf(kamax, __shfl_xor(kamax, 1)); kamax = fmaxf(kamax, __shfl_xor(kamax, 2)); kamax = fmaxf(kamax, __shfl_xor(kamax, 4)); kamax = fmaxf(kamax, __shfl_xor(kamax, 8));
            if (fr == 0 && fq == 0) atomicMax(KMA + batch_of_row(u.pm * BM) * 4 + wc, __float_as_uint(kamax)); }
        if (u.pn == 9 && wc == 0) {
            rmax = fmaxf(rmax, __shfl_xor(rmax, 1)); rmax = fmaxf(rmax, __shfl_xor(rmax, 2)); rmax = fmaxf(rmax, __shfl_xor(rmax, 4)); rmax = fmaxf(rmax, __shfl_xor(rmax, 8));
            if (fr == 0 && fq == 0) atomicMax(KMR + batch_of_row(u.pm * BM), __float_as_uint(rmax)); }
    }
};
struct EpiQ {
    bf16_t* QB; const float* ssq; const f32x2* rope;
    __device__ __forceinline__ void operator()(AccRef acc, const Unit& u, int wr, int wc, int fr, int fq) const {
        const int row0 = u.pm * BM + wr * 64 + fr; const int colb = u.pn * BM + wc * 32 + 8 * fq;
        const int dp0 = colb % 96, dp1 = (colb + HALF) % 96;
#pragma unroll
        for (int ai = 0; ai < 2; ++ai)
#pragma unroll
            for (int m = 0; m < 4; ++m) { const int row = row0 + ai * HALF + m * 16; const float r = 1.0f / sqrtf(ssq[row] * (1.f / 384.f) + EPS); const f32x2* tr = rope + (size_t)pos_of_row(row) * 16;
#pragma unroll
                for (int bj = 0; bj < 2; ++bj) { const int dp = bj ? dp1 : dp0;
                    f32x4 v0 = acc[ai][bj][m][0] * r, v1 = acc[ai][bj][m][1] * r;
                    if (dp >= 64) { const f32x4* tp = (const f32x4*)(tr + ((dp - 64) >> 1)); const f32x4 c0 = tp[0], c1 = tp[1];
                        f32x4 w0, w1;
                        w0[0] = v0[0] * c0[0] - v0[1] * c0[1]; w0[1] = v0[0] * c0[1] + v0[1] * c0[0];
                        w0[2] = v0[2] * c0[2] - v0[3] * c0[3]; w0[3] = v0[2] * c0[3] + v0[3] * c0[2];
                        w1[0] = v1[0] * c1[0] - v1[1] * c1[1]; w1[1] = v1[0] * c1[1] + v1[1] * c1[0];
                        w1[2] = v1[2] * c1[2] - v1[3] * c1[3]; w1[3] = v1[2] * c1[3] + v1[3] * c1[2];
                        v0 = w0; v1 = w1; }
                    *(u32x4*)(QB + (size_t)row * 768 + colb + bj * HALF) = pack8(v0, v1); }
                asm volatile("" ::: "memory"); }
    }
};
struct EpiKV {
    bf16_t *KN, *VB; const float* sskv; unsigned* KMX;
    __device__ __forceinline__ void operator()(AccRef acc, const Unit& u, int wr, int wc, int fr, int fq) const {
        bf16_t* base = (u.pn < 2) ? KN : VB; const int colt = (u.pn & 1) * 256;
        const int row0 = u.pm * BM + wr * 64 + fr, col0 = colt + wc * 32 + 8 * fq;
        float mx0 = 0.f, mx1 = 0.f;
#pragma unroll
        for (int ai = 0; ai < 2; ++ai)
#pragma unroll
            for (int m = 0; m < 4; ++m) { const int row = row0 + ai * HALF + m * 16; const float r = 1.0f / sqrtf(sskv[row] * (1.f / 256.f) + EPS); bf16_t* rowp = base + (size_t)row * 512 + col0;
#pragma unroll
                for (int bj = 0; bj < 2; ++bj) { const f32x4 v0 = acc[ai][bj][m][0] * r, v1 = acc[ai][bj][m][1] * r; *(u32x4*)(rowp + bj * HALF) = pack8(v0, v1);
                    if (u.pn < 2) { float ss = (v0[0] * v0[0] + v0[1] * v0[1]) + (v0[2] * v0[2] + v0[3] * v0[3]) + (v1[0] * v1[0] + v1[1] * v1[1]) + (v1[2] * v1[2] + v1[3] * v1[3]);
                        ss += __shfl_xor(ss, 16); ss += __shfl_xor(ss, 32); if (bj == 0) mx0 = fmaxf(mx0, ss); else mx1 = fmaxf(mx1, ss); } } }
        if (u.pn < 2) {
#pragma unroll
            for (int o = 1; o < 16; o <<= 1) { mx0 = fmaxf(mx0, __shfl_xor(mx0, o)); mx1 = fmaxf(mx1, __shfl_xor(mx1, o)); }
            if (fr == 0 && fq == 0) { unsigned* kp = KMX + batch_of_row(u.pm * BM) * 16 + (u.pn & 1) * 8 + wc; atomicMax(kp, __float_as_uint(mx0)); atomicMax(kp + 4, __float_as_uint(mx1)); } }
    }
};
template <bool FIRST> struct EpiGate {
    bf16_t* T; const bf16_t* PG; int goff;
    __device__ __forceinline__ void operator()(AccRef acc, const Unit& u, int wr, int wc, int fr, int fq) const {
        const int row0 = u.pm * BM + wr * 64 + fr, col0 = u.pn * BM + wc * 32 + 8 * fq;
#pragma unroll
        for (int ai = 0; ai < 2; ++ai)
#pragma unroll
            for (int m = 0; m < 4; ++m) { const int row = row0 + ai * HALF + m * 16;
#pragma unroll
                for (int bj = 0; bj < 2; ++bj) { const int col = col0 + bj * HALF;
                    const u32x4 gw = *(const u32x4*)(PG + (size_t)row * 2048 + goff + col);
                    f32x4 v0 = acc[ai][bj][m][0], v1 = acc[ai][bj][m][1];
                    v0[0] *= bf_lo(gw.x); v0[1] *= bf_hi(gw.x); v0[2] *= bf_lo(gw.y); v0[3] *= bf_hi(gw.y);
                    v1[0] *= bf_lo(gw.z); v1[1] *= bf_hi(gw.z); v1[2] *= bf_lo(gw.w); v1[3] *= bf_hi(gw.w);
                    bf16_t* tp = T + (size_t)row * 1024 + col;
                    if (!FIRST) { const u32x4 tw = *(const u32x4*)tp;
                        v0[0] += bf_lo(tw.x); v0[1] += bf_hi(tw.x); v0[2] += bf_lo(tw.y); v0[3] += bf_hi(tw.y);
                        v1[0] += bf_lo(tw.z); v1[1] += bf_hi(tw.z); v1[2] += bf_lo(tw.w); v1[3] += bf_hi(tw.w); }
                    *(u32x4*)tp = pack8(v0, v1); } }
    }
};
struct EpiOut {
    const float *xp, *xs; float* out; const float* mod; const float* b_ada;
    __device__ __forceinline__ void operator()(AccRef acc, const Unit& u, int wr, int wc, int fr, int fq) const {
        const int rowt = u.pm * BM; const int b = batch_of_row(rowt);
        const float* xbase = rowt < M_P ? xp + (size_t)rowt * DM : xs + (size_t)(rowt - M_P) * DM;
        float* obase = out + (size_t)rowt * DM;
        const int col0 = u.pn * BM + wc * 32 + 8 * fq;
        f32x4 g[2][2];
#pragma unroll
        for (int bj = 0; bj < 2; ++bj)
#pragma unroll
            for (int n = 0; n < 2; ++n) g[bj][n] = *(const f32x4*)(mod + (size_t)b * 3 * DM + 2 * DM + col0 + bj * HALF + 4 * n) + *(const f32x4*)(b_ada + 2 * DM + col0 + bj * HALF + 4 * n);
#pragma unroll
        for (int ai = 0; ai < 2; ++ai)
#pragma unroll
            for (int m = 0; m < 4; ++m) { const size_t off = (size_t)(wr * 64 + fr + ai * HALF + m * 16) * DM + col0;
#pragma unroll
                for (int bj = 0; bj < 2; ++bj)
#pragma unroll
                    for (int n = 0; n < 2; ++n) { const f32x4 xv = *(const f32x4*)(xbase + off + bj * HALF + 4 * n);
                        *(f32x4*)(obase + off + bj * HALF + 4 * n) = xv + g[bj][n] * acc[ai][bj][m][n]; } }
    }
};
}

namespace att {
constexpr int NW = 8, QBLK = 32, KVBLK = 64;
constexpr int SHM_V = 8192, SHM_KN = 8192, SHM_KR = 4096;
constexpr int OFF_V = 0, OFF_KN = 2 * SHM_V, OFF_KR = OFF_KN + 2 * SHM_KN, OFF_WS = OFF_KR + 2 * SHM_KR, LDS_BYTES = OFF_WS + NW * 64 * 4;
constexpr float THR2 = 8.0f;
#define SBAR() __builtin_amdgcn_sched_barrier(0)
__device__ __forceinline__ int crow(int r, int hi) { return (r & 3) + 8 * (r >> 2) + 4 * hi; }
__device__ __forceinline__ int v_st(int k, int c) { const int kk = (k & ~0xC) | ((k & 4) << 1) | ((k & 8) >> 1); return ((kk >> 3) * 2 + (c >> 5)) * 512 + ((kk & 7) * 32 + (c & 31)) * 2; }
__device__ __forceinline__ int v_rd_base(int lane) { return ((lane & 3) << 3) | (((lane >> 2) & 3) << 6) | (((lane >> 4) & 1) << 5) | (((lane >> 5) & 1) << 8); }
constexpr int v_rd_off(int d0, int ks, int half) { return d0 * 512 + ks * 2048 + half * 1024; }
template <int OFF> __device__ __forceinline__ s16x4 tr_read(int vb) { s16x4 r; asm volatile("ds_read_b64_tr_b16 %0, %1 offset:%2" : "=&v"(r) : "v"(vb), "i"(OFF) : "memory"); return r; }
template <int D0> __device__ __forceinline__ void pv_one(f32x16& od, int vb, bf16x8 pa0, bf16x8 pa1, bf16x8 pa2, bf16x8 pa3) {
    const s16x4 l0 = tr_read<v_rd_off(D0, 0, 0)>(vb), h0 = tr_read<v_rd_off(D0, 0, 1)>(vb), l1 = tr_read<v_rd_off(D0, 1, 0)>(vb), h1 = tr_read<v_rd_off(D0, 1, 1)>(vb);
    const s16x4 l2 = tr_read<v_rd_off(D0, 2, 0)>(vb), h2 = tr_read<v_rd_off(D0, 2, 1)>(vb), l3 = tr_read<v_rd_off(D0, 3, 0)>(vb), h3 = tr_read<v_rd_off(D0, 3, 1)>(vb);
    asm volatile("s_waitcnt lgkmcnt(0)" ::: "memory"); SBAR();
#define PK(L, H) (bf16x8){L[0], L[1], L[2], L[3], H[0], H[1], H[2], H[3]}
    od = __builtin_amdgcn_mfma_f32_32x32x16_bf16(pa0, PK(l0, h0), od, 0, 0, 0);
    od = __builtin_amdgcn_mfma_f32_32x32x16_bf16(pa1, PK(l1, h1), od, 0, 0, 0);
    od = __builtin_amdgcn_mfma_f32_32x32x16_bf16(pa2, PK(l2, h2), od, 0, 0, 0);
    od = __builtin_amdgcn_mfma_f32_32x32x16_bf16(pa3, PK(l3, h3), od, 0, 0, 0);
#undef PK
}
__device__ __forceinline__ void pv_d0(f32x16* o, int vb, bf16x8 pa0, bf16x8 pa1, bf16x8 pa2, bf16x8 pa3) { pv_one<0>(o[0], vb, pa0, pa1, pa2, pa3); pv_one<1>(o[1], vb, pa0, pa1, pa2, pa3); }

template <int DQK> __device__ __forceinline__ void qkt(f32x16& p0, f32x16& p1, const char* Kn_s, const char* Kr_s, const bf16x8* qr, int r32, int hi) {
    p0 = f32x16{}; p1 = f32x16{};
    const int keyn = (r32 >> 1) & 7, keyr = (r32 >> 2) & 3;
#pragma unroll
    for (int d0 = 0; d0 < 4; ++d0) { const int off = r32 * 128 + (((2 * d0 + hi) ^ keyn) << 4);
        const bf16x8 b0 = *reinterpret_cast<const bf16x8*>(Kn_s + off), b1 = *reinterpret_cast<const bf16x8*>(Kn_s + off + 32 * 128);
        p0 = __builtin_amdgcn_mfma_f32_32x32x16_bf16(b0, qr[d0], p0, 0, 0, 0);
        p1 = __builtin_amdgcn_mfma_f32_32x32x16_bf16(b1, qr[d0], p1, 0, 0, 0); }
    if constexpr (DQK == 96) {
#pragma unroll
        for (int d0 = 0; d0 < 2; ++d0) { const int off = r32 * 64 + (((2 * d0 + hi) ^ keyr) << 4);
            const bf16x8 b0 = *reinterpret_cast<const bf16x8*>(Kr_s + off), b1 = *reinterpret_cast<const bf16x8*>(Kr_s + off + 32 * 64);
            p0 = __builtin_amdgcn_mfma_f32_32x32x16_bf16(b0, qr[4 + d0], p0, 0, 0, 0);
            p1 = __builtin_amdgcn_mfma_f32_32x32x16_bf16(b1, qr[4 + d0], p1, 0, 0, 0); }
    }
}
template <bool WIN> __device__ __forceinline__ void partialSM(f32x16& p0, f32x16& p1, float& m_reg, float& alpha, int drel, float slope2, int hi) {
    if constexpr (WIN) {
#pragma unroll
        for (int r = 0; r < 16; ++r) { const int d0_ = drel + crow(r, hi), d1_ = d0_ + 32; const float a0 = fabsf((float)d0_), a1 = fabsf((float)d1_);
            p0[r] = (a0 <= 128.f) ? p0[r] - slope2 * a0 : -1e30f; p1[r] = (a1 <= 128.f) ? p1[r] - slope2 * a1 : -1e30f; }
    }
    float pmax = p0[0];
#pragma unroll
    for (int r = 1; r < 16; ++r) pmax = fmaxf(pmax, p0[r]);
#pragma unroll
    for (int r = 0; r < 16; ++r) pmax = fmaxf(pmax, p1[r]);
    { auto rr = __builtin_amdgcn_permlane32_swap(__float_as_uint(pmax), __float_as_uint(pmax), false, false); pmax = fmaxf(__uint_as_float(rr[0]), __uint_as_float(rr[1])); }
    float mn;
    if (__builtin_expect(__all(pmax - m_reg <= THR2), 1)) { mn = m_reg; alpha = 1.f; }
    else { mn = fmaxf(m_reg, pmax); alpha = __builtin_amdgcn_exp2f(m_reg - mn); m_reg = mn; }
#pragma unroll
    for (int r = 0; r < 16; ++r) { p0[r] = p0[r] - mn; p1[r] = p1[r] - mn; }
#pragma unroll
    for (int r = 0; r < 16; ++r) p0[r] = __builtin_amdgcn_exp2f(p0[r]);
}
__device__ __forceinline__ void finishSM(f32x16& p0, f32x16& p1, float alpha, float& l_reg, bf16x8& pa0, bf16x8& pa1, bf16x8& pa2, bf16x8& pa3) {
#pragma unroll
    for (int r = 0; r < 16; ++r) p1[r] = __builtin_amdgcn_exp2f(p1[r]);
    float ps = 0;
#pragma unroll
    for (int r = 0; r < 16; ++r) ps += p0[r];
#pragma unroll
    for (int r = 0; r < 16; ++r) ps += p1[r];
    { auto rr = __builtin_amdgcn_permlane32_swap(__float_as_uint(ps), __float_as_uint(ps), false, false); ps = __uint_as_float(rr[0]) + __uint_as_float(rr[1]); }
    l_reg = l_reg * alpha + ps;
#define PK4(P, BASE, OUT) do { unsigned a0 = cvt_pk_bf16(P[BASE + 0], P[BASE + 1]), a1 = cvt_pk_bf16(P[BASE + 2], P[BASE + 3]);   \
    unsigned b0 = cvt_pk_bf16(P[BASE + 4], P[BASE + 5]), b1 = cvt_pk_bf16(P[BASE + 6], P[BASE + 7]);                              \
    auto r0 = __builtin_amdgcn_permlane32_swap(a0, b0, false, false); auto r1 = __builtin_amdgcn_permlane32_swap(a1, b1, false, false); \
    u32x4 w = {r0[0], r1[0], r0[1], r1[1]}; OUT = *reinterpret_cast<bf16x8*>(&w); } while (0)
    PK4(p0, 0, pa0); PK4(p0, 8, pa1); PK4(p1, 0, pa2); PK4(p1, 8, pa3);
#undef PK4
}

template <int DQK, bool WIN>
__device__ __forceinline__ void attn_unit(const bf16_t* __restrict__ Qb, int ldq, const bf16_t* __restrict__ Kn, int ldk, const bf16_t* __restrict__ Kr,
                                          const bf16_t* __restrict__ Vh, int ldv, const bf16_t* __restrict__ Zb, int ldz, bf16_t* __restrict__ Ob, int ldo,
                                          int t0, int NT, int qpos0, float slope2, float sink2, char* lds) {
    constexpr int ND0 = DQK / 16;
    int tid = threadIdx.x; asm volatile("" : "+v"(tid));
    const int wid = __builtin_amdgcn_readfirstlane(tid >> 6), lane = tid & 63, r32 = lane & 31, hi = lane >> 5;
    char* V_lds = lds + OFF_V; char* Kn_lds = lds + OFF_KN; char* Kr_lds = lds + OFF_KR;
    float* ws = (float*)(lds + OFF_WS) + wid * 64; float* li_l = ws; float* al_l = ws + 32;
    float m_reg = WIN ? sink2 : -1e30f, l_reg = WIN ? 1.f : 0.f; f32x16 o[2] = {}; bf16x8 qr[ND0];
    const bf16_t* Qw = Qb + (size_t)(wid * QBLK + r32) * ldq + hi * 8;
#pragma unroll
    for (int d0 = 0; d0 < ND0; ++d0) qr[d0] = *reinterpret_cast<const bf16x8*>(Qw + d0 * 16);
    const int sr = tid >> 3, sc = (tid & 7) * 8;
    const int vst = v_st(sr, sc), knst = sr * 128 + (((tid & 7) ^ ((sr >> 1) & 7)) << 4);
    const int rr_ = (tid >> 2) & 63, rc_ = tid & 3, krst = rr_ * 64 + ((rc_ ^ ((rr_ >> 2) & 3)) << 4);
    const bool do_kr = (DQK == 96) && (wid < 4);
    const int vb0 = (int)(uintptr_t)V_lds + v_rd_base(lane);
    const int qposl = qpos0 + wid * QBLK + r32;
    struct { bf16x8 vs, ks, rs; } st_[2];
    const bf16_t* Vp = Vh + (size_t)t0 * KVBLK * ldv + (size_t)sr * ldv + sc;
    const bf16_t* Kp = Kn + (size_t)t0 * KVBLK * ldk + (size_t)sr * ldk + sc;
    const bf16_t* Rp = Kr + (size_t)t0 * KVBLK * 32 + (size_t)rr_ * 32 + rc_ * 8;
#define SLOAD(i, t) do { st_[i].vs = *reinterpret_cast<const bf16x8*>(Vp + (size_t)(t) * KVBLK * ldv); st_[i].ks = *reinterpret_cast<const bf16x8*>(Kp + (size_t)(t) * KVBLK * ldk); \
        if (do_kr) st_[i].rs = *reinterpret_cast<const bf16x8*>(Rp + (size_t)(t) * KVBLK * 32); } while (0)
#define SWRITE(b, i) do { *(bf16x8*)(V_lds + (b) * SHM_V + vst) = st_[i].vs; *(bf16x8*)(Kn_lds + (b) * SHM_KN + knst) = st_[i].ks; \
        if (do_kr) *(bf16x8*)(Kr_lds + (b) * SHM_KR + krst) = st_[i].rs; } while (0)
#define SWAIT() do { if (do_kr) asm volatile("s_waitcnt vmcnt(3)" ::: "memory"); else asm volatile("s_waitcnt vmcnt(2)" ::: "memory"); } while (0)
#define RESC(a) do { if (__any((a) < 1.f)) { if (hi == 0) al_l[r32] = (a); asm volatile("s_waitcnt lgkmcnt(0)" ::: "memory"); \
        _Pragma("unroll") for (int d = 0; d < 2; ++d) _Pragma("unroll") for (int r = 0; r < 16; ++r) o[d][r] *= al_l[crow(r, hi)]; } } while (0)
#define DREL(t) ((t0 + (t)) * KVBLK - qposl)
    f32x16 pA0, pA1, pB0, pB1; float alA = 1.f, alB = 1.f; bf16x8 pa0, pa1, pa2, pa3;
    const int wq_lo = qpos0 + wid * QBLK - 128, wq_hi = qpos0 + wid * QBLK + QBLK - 1 + 128;
#define ACT(t) (!WIN || (((t0 + (t)) * KVBLK + KVBLK - 1 >= wq_lo) && ((t0 + (t)) * KVBLK <= wq_hi)))
    SLOAD(0, 0); asm volatile("s_waitcnt vmcnt(0)" ::: "memory"); SWRITE(0, 0); __syncthreads();
    if (ACT(0)) { qkt<DQK>(pA0, pA1, Kn_lds, Kr_lds, qr, r32, hi); partialSM<WIN>(pA0, pA1, m_reg, alA, DREL(0), slope2, hi); }
    SLOAD(1, 1); if (2 < NT) SLOAD(0, 2);
    SWAIT(); SWRITE(1, 1); __syncthreads();
    for (int j = 1; j + 1 < NT; j += 2) {
        const bool a0 = ACT(j - 1), a1 = ACT(j), a2 = ACT(j + 1);
        SBAR(); if (a1) qkt<DQK>(pB0, pB1, Kn_lds + SHM_KN, Kr_lds + SHM_KR, qr, r32, hi);
        if (a0) finishSM(pA0, pA1, alA, l_reg, pa0, pa1, pa2, pa3); SBAR();
        SLOAD(1, j + 2); SBAR();
        if (a0) pv_d0(o, vb0, pa0, pa1, pa2, pa3); alB = 1.f; if (a1) partialSM<WIN>(pB0, pB1, m_reg, alB, DREL(j), slope2, hi);
        __syncthreads(); SWAIT(); SWRITE(0, 0);
        RESC(alB); __syncthreads();
        SBAR(); if (a2) qkt<DQK>(pA0, pA1, Kn_lds, Kr_lds, qr, r32, hi);
        if (a1) finishSM(pB0, pB1, alB, l_reg, pa0, pa1, pa2, pa3); SBAR();
        if (j + 3 < NT) SLOAD(0, j + 3); SBAR();
        if (a1) pv_d0(o, vb0 + SHM_V, pa0, pa1, pa2, pa3); alA = 1.f; if (a2) partialSM<WIN>(pA0, pA1, m_reg, alA, DREL(j + 1), slope2, hi);
        __syncthreads(); SWAIT(); SWRITE(1, 1);
        RESC(alA); __syncthreads();
    }
    { const bool a0 = ACT(NT - 2), a1 = ACT(NT - 1);
    SBAR(); if (a1) qkt<DQK>(pB0, pB1, Kn_lds + SHM_KN, Kr_lds + SHM_KR, qr, r32, hi);
    if (a0) finishSM(pA0, pA1, alA, l_reg, pa0, pa1, pa2, pa3); SBAR();
    if (a0) pv_d0(o, vb0, pa0, pa1, pa2, pa3); alB = 1.f; if (a1) partialSM<WIN>(pB0, pB1, m_reg, alB, DREL(NT - 1), slope2, hi);
    __syncthreads(); RESC(alB);
    if (a1) { finishSM(pB0, pB1, alB, l_reg, pa0, pa1, pa2, pa3); SBAR();
    pv_d0(o, vb0 + SHM_V, pa0, pa1, pa2, pa3); } }
#undef ACT
    if (hi == 0) li_l[r32] = l_reg; asm volatile("s_waitcnt lgkmcnt(0)" ::: "memory");
#pragma unroll
    for (int r = 0; r < 16; ++r) { const int orow = wid * QBLK + crow(r, hi); const float rl = __builtin_amdgcn_rcpf(li_l[crow(r, hi)]);
#pragma unroll
        for (int d0 = 0; d0 < 2; ++d0) { const float z = __uint_as_float((unsigned)Zb[(size_t)orow * ldz + d0 * 32 + r32] << 16);
            const unsigned w = cvt_pk_bf16(o[d0][r] * rl * z, 0.f); Ob[(size_t)orow * ldo + d0 * 32 + r32] = (bf16_t)(w & 0xffffu); } }
    __syncthreads();
#undef SLOAD
#undef SWRITE
#undef SWAIT
#undef RESC
#undef DREL
}
#undef SBAR
}

namespace mla {
constexpr int NW = 8, KSLOT = 12288, VSLOT = 8192, NKS = 4, NVS = 3;
constexpr int LDS_K = 0, LDS_V = NKS * KSLOT, LDS_WS = LDS_V + NVS * VSLOT, LDS_OST = LDS_WS + NW * 256, LDS_BYTES = LDS_OST + NW * 4096;
#define SBAR() __builtin_amdgcn_sched_barrier(0)
#define PIN(x) asm volatile("" : "+v"(x))
#define MFMA(a, b, c) __builtin_amdgcn_mfma_f32_32x32x16_bf16(a, b, c, 0, 0, 0)
#define WAIT_BAR(N) asm volatile("s_waitcnt vmcnt(" #N ") lgkmcnt(0)\n\ts_barrier" ::: "memory")
__device__ __forceinline__ int crow(int r, int hi) { return (r & 3) + 8 * (r >> 2) + 4 * hi; }
__device__ __forceinline__ unsigned cvtpk(float lo, float hi) { unsigned r; asm("v_cvt_pk_bf16_f32 %0, %1, %2" : "=v"(r) : "v"(lo), "v"(hi)); return r; }
__device__ __forceinline__ void glds16(const void* g, unsigned lds_base) {
    unsigned sv; asm volatile("s_mov_b32 %0, m0\n\ts_mov_b32 m0, %2\n\ts_nop 0\n\tglobal_load_lds_dwordx4 %1, off\n\ts_mov_b32 m0, %0" : "=&s"(sv) : "v"(g), "s"(lds_base) : "memory"); }
typedef __attribute__((address_space(3))) const char* lds_cptr;
typedef short v4i16_t __attribute__((ext_vector_type(4)));
__device__ __forceinline__ bf16x8 kld(lds_cptr p) { return *(const __attribute__((address_space(3))) bf16x8*)p; }
__device__ __forceinline__ s16x4 vtr(lds_cptr p) { return __builtin_bit_cast(s16x4, __builtin_amdgcn_ds_read_tr16_b64_v4i16((__attribute__((address_space(3))) v4i16_t*)p)); }

__device__ __forceinline__ void mla_unit(const bf16_t* __restrict__ Qu, const bf16_t* __restrict__ Knh, const bf16_t* __restrict__ Krs, const bf16_t* __restrict__ Vhh,
                                         const bf16_t* __restrict__ Zu, bf16_t* __restrict__ Ou, int NT, float kmax, char* lds) {
    int tid = threadIdx.x; asm volatile("" : "+v"(tid));
    const int lane = tid & 63, r32 = lane & 31, hi = lane >> 5; const int wid = __builtin_amdgcn_readfirstlane(tid >> 6); const bool wlow = wid < 4;
    const unsigned lds0 = (unsigned)(uintptr_t)lds; float* wsf = (float*)(lds + LDS_WS) + wid * 64;
    const bf16_t* ksrc = Knh + (size_t)lane * 512 + wid * 8;
    const bf16_t* rsrc = Krs + (size_t)lane * 32 + (wid & 3) * 8;
    const bf16_t* vsrc = Vhh + (size_t)(16 * (wid & 3) + (lane >> 2)) * 512 + (wid >> 2) * 32 + (lane & 3) * 8;
    const unsigned kdst = lds0 + LDS_K + wid * 1024, rdst = lds0 + LDS_K + (8 + (wid & 3)) * 1024, vdst = lds0 + LDS_V + wid * 1024;
#define DMA_K(t, slot) do { glds16(ksrc + (size_t)(t) * 64 * 512, (unsigned)__builtin_amdgcn_readfirstlane(kdst + (slot))); \
        if (wlow) glds16(rsrc + (size_t)(t) * 64 * 32, (unsigned)__builtin_amdgcn_readfirstlane(rdst + (slot))); } while (0)
#define DMA_V(t, slot) glds16(vsrc + (size_t)(t) * 64 * 512, (unsigned)__builtin_amdgcn_readfirstlane(vdst + (slot)))
#define WAITB(NHI, NLO) do { if (wlow) { WAIT_BAR(NLO); } else { WAIT_BAR(NHI); } } while (0)
    const lds_cptr vp0 = (lds_cptr)lds + LDS_V + ((lane >> 4) & 1) * 32 + (lane & 3) * 8 + (4 * hi + ((lane & 15) >> 2)) * 64;
    const lds_cptr kp0 = (lds_cptr)lds + LDS_K + hi * 1024 + r32 * 16;
    DMA_K(0, 0); DMA_V(0, 0); DMA_K(1, KSLOT);
    bf16x8 qr[6];
    const bf16_t* Qw = Qu + (size_t)(wid * 32 + r32) * 768 + hi * 8;
#pragma unroll
    for (int d0 = 0; d0 < 6; ++d0) qr[d0] = *reinterpret_cast<const bf16x8*>(Qw + d0 * 16);
    DMA_K(2, 2 * KSLOT);
    float qs = 0.f;
#pragma unroll
    for (int d0 = 0; d0 < 6; ++d0)
#pragma unroll
        for (int e = 0; e < 8; ++e) { const float v = __uint_as_float((unsigned)(unsigned short)qr[d0][e] << 16); qs += v * v; }
    { auto rr = __builtin_amdgcn_permlane32_swap(__float_as_uint(qs), __float_as_uint(qs), false, false); qs = __uint_as_float(rr[0]) + __uint_as_float(rr[1]); }
    const float mrow = sqrtf(qs) * kmax * 1.001f + 1e-3f;
    f32x16 negm;
#pragma unroll
    for (int r = 0; r < 16; ++r) negm[r] = -mrow;
    PIN(negm);
    float l_reg = 0.f; f32x16 o[2]; o[0] = f32x16{}; o[1] = f32x16{};
    f32x16 pA0, pA1, pB0, pB1; bf16x8 kf[12]; s16x4 vlo[8], vhi[8]; u32x4 pw0, pw1, pw2, pw3;
    int vs_prev = 0, vs_cur = 0, vs_next = VSLOT;
#define ROT() do { vs_prev = vs_cur; vs_cur = vs_next; vs_next = (vs_next == 2 * VSLOT) ? 0 : vs_next + VSLOT; } while (0)
#define KS(t) (((t) & 3) * KSLOT)
#define EX(v) __builtin_amdgcn_exp2f(v)
    WAITB(3, 5);
#pragma unroll
    for (int i = 0; i < 12; ++i) kf[i] = kld(kp0 + (i >> 1) * 2048 + (i & 1) * 512);
    pA0 = MFMA(kf[0], qr[0], negm); pA1 = MFMA(kf[1], qr[0], negm);
#pragma unroll
    for (int d0 = 1; d0 < 6; ++d0) { pA0 = MFMA(kf[2 * d0], qr[d0], pA0); pA1 = MFMA(kf[2 * d0 + 1], qr[d0], pA1); }
#pragma unroll
    for (int r = 0; r < 16; ++r) { pA0[r] = EX(pA0[r]); pA1[r] = EX(pA1[r]); }
    WAIT_BAR(0);
    DMA_K(3, 3 * KSLOT); DMA_V(1, VSLOT); ROT();
    kf[0] = kld(kp0 + KS(1)); kf[1] = kld(kp0 + KS(1) + 512);
#define PKW(P, i) cvtpk(P[i], P[i + 1])
#define PAF(k) __builtin_bit_cast(bf16x8, pw##k)
#define VFR(i) (bf16x8){vlo[i][0], vlo[i][1], vlo[i][2], vlo[i][3], vhi[i][0], vhi[i][1], vhi[i][2], vhi[i][3]}
#define VRD(i) do { vlo[i] = vtr(vp_ + (((i) >> 2) * 4096 + ((i) & 3) * 1024)); vhi[i] = vtr(vp_ + (((i) >> 2) * 4096 + ((i) & 3) * 1024 + 512)); } while (0)
#define KRD(i) do { kf[i] = kld(kp_ + ((i) >> 1) * 2048 + ((i) & 1) * 512); } while (0)
#define GAPA3(MF, a0, a1, a2, W0, PW) do { MF; sacc += a0; sacc += a1; sacc += a2; W0; PIN(PW); PIN(sacc); SBAR(); } while (0)
#define GAPA2(MF, a0, a1, W0, W1, PW) do { MF; sacc += a0; sacc += a1; W0; W1; PIN(PW); PIN(sacc); SBAR(); } while (0)
#define GAPB(MF, X, i) do { MF; X[i] = EX(X[i]); X[i + 1] = EX(X[i + 1]); X[i + 2] = EX(X[i + 2]); X[i + 3] = EX(X[i + 3]); PIN(X); SBAR(); } while (0)
#define STEP(C0, C1, P0, P1, t, GK, GV, GL) do { SBAR(); \
    const lds_cptr kp_ = kp0 + KS(t); const lds_cptr vp_ = vp0 + vs_prev; float sacc = P0[0] + P0[1]; \
    KRD(2);  SBAR(); GAPA3(C0 = MFMA(kf[0],  qr[0], negm), P0[2],  P0[3],  P0[4],  pw0[0] = PKW(P0, 0),  pw0); \
    KRD(3);  SBAR(); GAPA3(C1 = MFMA(kf[1],  qr[0], negm), P0[5],  P0[6],  P0[7],  pw0[1] = PKW(P0, 2),  pw0); \
    KRD(4);  SBAR(); GAPA3(C0 = MFMA(kf[2],  qr[1], C0),   P0[8],  P0[9],  P0[10], pw0[2] = PKW(P0, 4),  pw0); \
    KRD(5);  SBAR(); GAPA3(C1 = MFMA(kf[3],  qr[1], C1),   P0[11], P0[12], P0[13], pw0[3] = PKW(P0, 6),  pw0); \
    KRD(6);  SBAR(); GAPA3(C0 = MFMA(kf[4],  qr[2], C0),   P0[14], P0[15], P1[0],  pw1[0] = PKW(P0, 8),  pw1); \
    KRD(7);  SBAR(); GAPA3(C1 = MFMA(kf[5],  qr[2], C1),   P1[1],  P1[2],  P1[3],  pw1[1] = PKW(P0, 10), pw1); \
    KRD(8);  SBAR(); GAPA3(C0 = MFMA(kf[6],  qr[3], C0),   P1[4],  P1[5],  P1[6],  pw1[2] = PKW(P0, 12), pw1); \
    KRD(9);  SBAR(); GAPA3(C1 = MFMA(kf[7],  qr[3], C1),   P1[7],  P1[8],  P1[9],  pw1[3] = PKW(P0, 14), pw1); \
    KRD(10); SBAR(); GAPA2(C0 = MFMA(kf[8],  qr[4], C0),   P1[10], P1[11], pw2[0] = PKW(P1, 0),  pw2[1] = PKW(P1, 2),  pw2); \
    KRD(11); SBAR(); GAPA2(C1 = MFMA(kf[9],  qr[4], C1),   P1[12], P1[13], pw2[2] = PKW(P1, 4),  pw2[3] = PKW(P1, 6),  pw2); \
    VRD(0);  SBAR(); GAPA2(C0 = MFMA(kf[10], qr[5], C0),   P1[14], P1[15], pw3[0] = PKW(P1, 8),  pw3[1] = PKW(P1, 10), pw3); \
    VRD(4);  SBAR(); GAPA2(C1 = MFMA(kf[11], qr[5], C1),   0.f,    0.f,    pw3[2] = PKW(P1, 12), pw3[3] = PKW(P1, 14), pw3); \
    l_reg += sacc; \
    if (GK) DMA_K((t) + 3, KS((t) + 3)); if (GV) DMA_V((t) + 1, vs_next); \
    SBAR(); \
    VRD(1); SBAR(); GAPB(o[0] = MFMA(PAF(0), VFR(0), o[0]), C0, 0); \
    VRD(5); SBAR(); GAPB(o[1] = MFMA(PAF(0), VFR(4), o[1]), C0, 4); \
    VRD(2); SBAR(); GAPB(o[0] = MFMA(PAF(1), VFR(1), o[0]), C0, 8); \
    VRD(6); SBAR(); GAPB(o[1] = MFMA(PAF(1), VFR(5), o[1]), C0, 12); \
    VRD(3); SBAR(); GAPB(o[0] = MFMA(PAF(2), VFR(2), o[0]), C1, 0); \
    VRD(7); SBAR(); GAPB(o[1] = MFMA(PAF(2), VFR(6), o[1]), C1, 4); \
    if (GL) { kf[0] = kld(kp0 + KS((t) + 1)); kf[1] = kld(kp0 + KS((t) + 1) + 512); } SBAR(); \
                    GAPB(o[0] = MFMA(PAF(3), VFR(3), o[0]), C1, 8); \
                    GAPB(o[1] = MFMA(PAF(3), VFR(7), o[1]), C1, 12); \
    } while (0)
    int t = 1;
    for (; t + 4 < NT; t += 2) {
        STEP(pB0, pB1, pA0, pA1, t, true, true, true);     WAITB(2, 3); ROT();
        STEP(pA0, pA1, pB0, pB1, t + 1, true, true, true); WAITB(2, 3); ROT();
    }
    STEP(pB0, pB1, pA0, pA1, t, false, true, true);      WAIT_BAR(1); ROT();
    STEP(pA0, pA1, pB0, pB1, t + 1, false, true, true);  WAIT_BAR(0); ROT();
    STEP(pB0, pB1, pA0, pA1, t + 2, false, false, false);
    { float sacc = pB0[0] + pB0[1];
#pragma unroll
      for (int r = 2; r < 16; ++r) sacc += pB0[r];
#pragma unroll
      for (int r = 0; r < 16; ++r) sacc += pB1[r];
      l_reg += sacc;
      pw0 = (u32x4){PKW(pB0, 0), PKW(pB0, 2), PKW(pB0, 4), PKW(pB0, 6)}; pw1 = (u32x4){PKW(pB0, 8), PKW(pB0, 10), PKW(pB0, 12), PKW(pB0, 14)};
      pw2 = (u32x4){PKW(pB1, 0), PKW(pB1, 2), PKW(pB1, 4), PKW(pB1, 6)}; pw3 = (u32x4){PKW(pB1, 8), PKW(pB1, 10), PKW(pB1, 12), PKW(pB1, 14)};
      const lds_cptr vp_ = vp0 + vs_cur; VRD(0); VRD(4); VRD(1); VRD(5); VRD(2); VRD(6); VRD(3); VRD(7);
      o[0] = MFMA(PAF(0), VFR(0), o[0]); o[1] = MFMA(PAF(0), VFR(4), o[1]); o[0] = MFMA(PAF(1), VFR(1), o[0]); o[1] = MFMA(PAF(1), VFR(5), o[1]);
      o[0] = MFMA(PAF(2), VFR(2), o[0]); o[1] = MFMA(PAF(2), VFR(6), o[1]); o[0] = MFMA(PAF(3), VFR(3), o[0]); o[1] = MFMA(PAF(3), VFR(7), o[1]); }
    { auto rr = __builtin_amdgcn_permlane32_swap(__float_as_uint(l_reg), __float_as_uint(l_reg), false, false); l_reg = __uint_as_float(rr[0]) + __uint_as_float(rr[1]); }
    if (hi == 0) wsf[32 + r32] = l_reg; asm volatile("s_waitcnt lgkmcnt(0)" ::: "memory");
    bf16_t* stg = (bf16_t*)(lds + LDS_OST) + wid * 2048;
    const bf16_t* Zw = Zu + (size_t)(wid * 32) * 1024; bf16_t* Ow = Ou + (size_t)(wid * 32) * 512;
#pragma unroll
    for (int r = 0; r < 16; ++r) { const int orow = crow(r, hi); const float rl = __builtin_amdgcn_rcpf(wsf[32 + orow]);
#pragma unroll
        for (int d0 = 0; d0 < 2; ++d0) { const float z = __uint_as_float((unsigned)Zw[(size_t)orow * 1024 + d0 * 32 + r32] << 16);
            stg[orow * 64 + d0 * 32 + r32] = (bf16_t)(cvtpk(o[d0][r] * rl * z, 0.f) & 0xffffu); } }
    asm volatile("s_waitcnt lgkmcnt(0)" ::: "memory");
#pragma unroll
    for (int i = 0; i < 4; ++i) { const int row = i * 8 + (lane >> 3), ch = lane & 7; *(u32x4*)(Ow + (size_t)row * 512 + ch * 8) = *(const u32x4*)(stg + row * 64 + ch * 8); }
    asm volatile("s_waitcnt lgkmcnt(0)\n\ts_barrier" ::: "memory");
#undef DMA_K
#undef DMA_V
#undef WAITB
#undef ROT
#undef KS
#undef EX
#undef PKW
#undef PAF
#undef VFR
#undef VRD
#undef KRD
#undef GAPA3
#undef GAPA2
#undef GAPB
#undef STEP
}

__device__ __forceinline__ void win_unit(const bf16_t* __restrict__ Qu, const bf16_t* __restrict__ Kh, const bf16_t* __restrict__ Vh, const bf16_t* __restrict__ Zu, bf16_t* __restrict__ Ou,
                                         int t0, int NT, int qpos0, float slope2, float sink2, float kmax, char* lds) {
    int tid = threadIdx.x; asm volatile("" : "+v"(tid));
    const int lane = tid & 63, r32 = lane & 31, hi = lane >> 5; const int wid = __builtin_amdgcn_readfirstlane(tid >> 6);
    const unsigned lds0 = (unsigned)(uintptr_t)lds; float* wsf = (float*)(lds + LDS_WS) + wid * 64;
    const bf16_t* ksrc = Kh + (size_t)(t0 * 64 + lane) * 768 + wid * 8;
    const bf16_t* vsrc = Vh + (size_t)(t0 * 64 + 16 * (wid & 3) + (lane >> 2)) * 768 + (wid >> 2) * 32 + (lane & 3) * 8;
    const unsigned kdst = lds0 + LDS_K + wid * 1024, vdst = lds0 + LDS_V + wid * 1024;
#define DMA_K(t, slot) glds16(ksrc + (size_t)(t) * 64 * 768, (unsigned)__builtin_amdgcn_readfirstlane(kdst + (slot)))
#define DMA_V(t, slot) glds16(vsrc + (size_t)(t) * 64 * 768, (unsigned)__builtin_amdgcn_readfirstlane(vdst + (slot)))
    const lds_cptr vp0 = (lds_cptr)lds + LDS_V + ((lane >> 4) & 1) * 32 + (lane & 3) * 8 + (4 * hi + ((lane & 15) >> 2)) * 64;
    const lds_cptr kp0 = (lds_cptr)lds + LDS_K + hi * 1024 + r32 * 16;
    DMA_K(0, 0); DMA_V(0, 0); DMA_K(1, KSLOT);
    bf16x8 qr[4];
    const bf16_t* Qw = Qu + (size_t)(wid * 32 + r32) * 768 + hi * 8;
#pragma unroll
    for (int d0 = 0; d0 < 4; ++d0) qr[d0] = *reinterpret_cast<const bf16x8*>(Qw + d0 * 16);
    DMA_K(2, 2 * KSLOT);
    float qs = 0.f;
#pragma unroll
    for (int d0 = 0; d0 < 4; ++d0)
#pragma unroll
        for (int e = 0; e < 8; ++e) { const float v = __uint_as_float((unsigned)(unsigned short)qr[d0][e] << 16); qs += v * v; }
    { auto rr = __builtin_amdgcn_permlane32_swap(__float_as_uint(qs), __float_as_uint(qs), false, false); qs = __uint_as_float(rr[0]) + __uint_as_float(rr[1]); }
    const float mrow = fmaxf(sink2, sqrtf(qs) * kmax * 1.001f + 1e-3f), negm = -mrow, nslope = -slope2;
    const int qposl = qpos0 + wid * 32 + r32;
    float l_reg = hi == 0 ? __builtin_amdgcn_exp2f(sink2 - mrow) : 0.f; f32x16 o[2]; o[0] = f32x16{}; o[1] = f32x16{};
    f32x16 pA0, pA1, pB0, pB1; bf16x8 kf[8]; s16x4 vlo[8], vhi[8]; u32x4 pw0, pw1, pw2, pw3;
    int vs_prev = 0, vs_cur = 0, vs_next = VSLOT;
#define ROT() do { vs_prev = vs_cur; vs_cur = vs_next; vs_next = (vs_next == 2 * VSLOT) ? 0 : vs_next + VSLOT; } while (0)
#define KS(t) (((t) & 3) * KSLOT)
#define EX(v) __builtin_amdgcn_exp2f(v)
#define BIAS(C0, C1, t) do { const float db_ = (float)((t0 + (t)) * 64 + 4 * hi - qposl); \
    _Pragma("unroll") for (int r = 0; r < 16; ++r) { const float d0_ = db_ + (float)((r & 3) + 8 * (r >> 2)), d1_ = d0_ + 32.f; const float a0_ = __builtin_fabsf(d0_), a1_ = __builtin_fabsf(d1_); \
        C0[r] = a0_ <= 128.f ? __builtin_fmaf(nslope, a0_, negm) : -1e30f; C1[r] = a1_ <= 128.f ? __builtin_fmaf(nslope, a1_, negm) : -1e30f; } } while (0)
    WAIT_BAR(3);
    BIAS(pA0, pA1, 0);
#pragma unroll
    for (int i = 0; i < 8; ++i) kf[i] = kld(kp0 + (i >> 1) * 2048 + (i & 1) * 512);
#pragma unroll
    for (int d0 = 0; d0 < 4; ++d0) { pA0 = MFMA(kf[2 * d0], qr[d0], pA0); pA1 = MFMA(kf[2 * d0 + 1], qr[d0], pA1); }
#pragma unroll
    for (int r = 0; r < 16; ++r) { pA0[r] = EX(pA0[r]); pA1[r] = EX(pA1[r]); }
    WAIT_BAR(0);
    DMA_K(3, 3 * KSLOT); DMA_V(1, VSLOT); ROT();
    kf[0] = kld(kp0 + KS(1)); kf[1] = kld(kp0 + KS(1) + 512);
#define PKW(P, i) cvtpk(P[i], P[i + 1])
#define PAF(k) __builtin_bit_cast(bf16x8, pw##k)
#define VFR(i) (bf16x8){vlo[i][0], vlo[i][1], vlo[i][2], vlo[i][3], vhi[i][0], vhi[i][1], vhi[i][2], vhi[i][3]}
#define VRD(i) do { vlo[i] = vtr(vp_ + (((i) >> 2) * 4096 + ((i) & 3) * 1024)); vhi[i] = vtr(vp_ + (((i) >> 2) * 4096 + ((i) & 3) * 1024 + 512)); } while (0)
#define KRD(i) do { kf[i] = kld(kp_ + ((i) >> 1) * 2048 + ((i) & 1) * 512); } while (0)
#define GAPA(MF, a0, a1, a2, a3, W0, W1, PW) do { MF; sacc += a0; sacc += a1; sacc += a2; sacc += a3; W0; W1; PIN(PW); PIN(sacc); SBAR(); } while (0)
#define GAPB(MF, X, i) do { MF; X[i] = EX(X[i]); X[i + 1] = EX(X[i + 1]); X[i + 2] = EX(X[i + 2]); X[i + 3] = EX(X[i + 3]); PIN(X); SBAR(); } while (0)
#define STEP(C0, C1, P0, P1, t, GK, GV, GL) do { SBAR(); \
    BIAS(C0, C1, t); PIN(C0); PIN(C1); SBAR(); \
    const lds_cptr kp_ = kp0 + KS(t); const lds_cptr vp_ = vp0 + vs_prev; float sacc = P0[0] + P0[1]; \
    KRD(2); SBAR(); GAPA(C0 = MFMA(kf[0], qr[0], C0), P0[2],  P0[3],  P0[4],  P0[5],  pw0[0] = PKW(P0, 0),  pw0[1] = PKW(P0, 2),  pw0); \
    KRD(3); SBAR(); GAPA(C1 = MFMA(kf[1], qr[0], C1), P0[6],  P0[7],  P0[8],  P0[9],  pw0[2] = PKW(P0, 4),  pw0[3] = PKW(P0, 6),  pw0); \
    KRD(4); SBAR(); GAPA(C0 = MFMA(kf[2], qr[1], C0), P0[10], P0[11], P0[12], P0[13], pw1[0] = PKW(P0, 8),  pw1[1] = PKW(P0, 10), pw1); \
    KRD(5); SBAR(); GAPA(C1 = MFMA(kf[3], qr[1], C1), P0[14], P0[15], P1[0],  P1[1],  pw1[2] = PKW(P0, 12), pw1[3] = PKW(P0, 14), pw1); \
    KRD(6); SBAR(); GAPA(C0 = MFMA(kf[4], qr[2], C0), P1[2],  P1[3],  P1[4],  P1[5],  pw2[0] = PKW(P1, 0),  pw2[1] = PKW(P1, 2),  pw2); \
    KRD(7); SBAR(); GAPA(C1 = MFMA(kf[5], qr[2], C1), P1[6],  P1[7],  P1[8],  P1[9],  pw2[2] = PKW(P1, 4),  pw2[3] = PKW(P1, 6),  pw2); \
    VRD(0); SBAR(); GAPA(C0 = MFMA(kf[6], qr[3], C0), P1[10], P1[11], P1[12], P1[13], pw3[0] = PKW(P1, 8),  pw3[1] = PKW(P1, 10), pw3); \
    VRD(4); SBAR(); GAPA(C1 = MFMA(kf[7], qr[3], C1), P1[14], P1[15], 0.f,    0.f,    pw3[2] = PKW(P1, 12), pw3[3] = PKW(P1, 14), pw3); \
    l_reg += sacc; \
    if (GK) DMA_K((t) + 3, KS((t) + 3)); if (GV) DMA_V((t) + 1, vs_next); \
    SBAR(); \
    VRD(1); SBAR(); GAPB(o[0] = MFMA(PAF(0), VFR(0), o[0]), C0, 0); \
    VRD(5); SBAR(); GAPB(o[1] = MFMA(PAF(0), VFR(4), o[1]), C0, 4); \
    VRD(2); SBAR(); GAPB(o[0] = MFMA(PAF(1), VFR(1), o[0]), C0, 8); \
    VRD(6); SBAR(); GAPB(o[1] = MFMA(PAF(1), VFR(5), o[1]), C0, 12); \
    VRD(3); SBAR(); GAPB(o[0] = MFMA(PAF(2), VFR(2), o[0]), C1, 0); \
    VRD(7); SBAR(); GAPB(o[1] = MFMA(PAF(2), VFR(6), o[1]), C1, 4); \
    if (GL) { kf[0] = kld(kp0 + KS((t) + 1)); kf[1] = kld(kp0 + KS((t) + 1) + 512); } SBAR(); \
                    GAPB(o[0] = MFMA(PAF(3), VFR(3), o[0]), C1, 8); \
                    GAPB(o[1] = MFMA(PAF(3), VFR(7), o[1]), C1, 12); \
    } while (0)
    int t = 1;
    for (; t + 4 < NT; t += 2) {
        STEP(pB0, pB1, pA0, pA1, t, true, true, true);     WAIT_BAR(2); ROT();
        STEP(pA0, pA1, pB0, pB1, t + 1, true, true, true); WAIT_BAR(2); ROT();
    }
    STEP(pB0, pB1, pA0, pA1, t, false, true, true);      WAIT_BAR(1); ROT();
    STEP(pA0, pA1, pB0, pB1, t + 1, false, true, true);  WAIT_BAR(0); ROT();
    STEP(pB0, pB1, pA0, pA1, t + 2, false, false, false);
    { float sacc = pB0[0] + pB0[1];
#pragma unroll
      for (int r = 2; r < 16; ++r) sacc += pB0[r];
#pragma unroll
      for (int r = 0; r < 16; ++r) sacc += pB1[r];
      l_reg += sacc;
      pw0 = (u32x4){PKW(pB0, 0), PKW(pB0, 2), PKW(pB0, 4), PKW(pB0, 6)}; pw1 = (u32x4){PKW(pB0, 8), PKW(pB0, 10), PKW(pB0, 12), PKW(pB0, 14)};
      pw2 = (u32x4){PKW(pB1, 0), PKW(pB1, 2), PKW(pB1, 4), PKW(pB1, 6)}; pw3 = (u32x4){PKW(pB1, 8), PKW(pB1, 10), PKW(pB1, 12), PKW(pB1, 14)};
      const lds_cptr vp_ = vp0 + vs_cur; VRD(0); VRD(4); VRD(1); VRD(5); VRD(2); VRD(6); VRD(3); VRD(7);
      o[0] = MFMA(PAF(0), VFR(0), o[0]); o[1] = MFMA(PAF(0), VFR(4), o[1]); o[0] = MFMA(PAF(1), VFR(1), o[0]); o[1] = MFMA(PAF(1), VFR(5), o[1]);
      o[0] = MFMA(PAF(2), VFR(2), o[0]); o[1] = MFMA(PAF(2), VFR(6), o[1]); o[0] = MFMA(PAF(3), VFR(3), o[0]); o[1] = MFMA(PAF(3), VFR(7), o[1]); }
    { auto rr = __builtin_amdgcn_permlane32_swap(__float_as_uint(l_reg), __float_as_uint(l_reg), false, false); l_reg = __uint_as_float(rr[0]) + __uint_as_float(rr[1]); }
    if (hi == 0) wsf[32 + r32] = l_reg; asm volatile("s_waitcnt lgkmcnt(0)" ::: "memory");
    bf16_t* stg = (bf16_t*)(lds + LDS_OST) + wid * 2048;
    const bf16_t* Zw = Zu + (size_t)(wid * 32) * 1024; bf16_t* Ow = Ou + (size_t)(wid * 32) * 512;
#pragma unroll
    for (int r = 0; r < 16; ++r) { const int orow = crow(r, hi); const float rl = __builtin_amdgcn_rcpf(wsf[32 + orow]);
#pragma unroll
        for (int d0 = 0; d0 < 2; ++d0) { const float z = __uint_as_float((unsigned)Zw[(size_t)orow * 1024 + d0 * 32 + r32] << 16);
            stg[orow * 64 + d0 * 32 + r32] = (bf16_t)(cvtpk(o[d0][r] * rl * z, 0.f) & 0xffffu); } }
    asm volatile("s_waitcnt lgkmcnt(0)" ::: "memory");
#pragma unroll
    for (int i = 0; i < 4; ++i) { const int row = i * 8 + (lane >> 3), ch = lane & 7; *(u32x4*)(Ow + (size_t)row * 512 + ch * 8) = *(const u32x4*)(stg + row * 64 + ch * 8); }
    asm volatile("s_waitcnt lgkmcnt(0)\n\ts_barrier" ::: "memory");
#undef DMA_K
#undef DMA_V
#undef ROT
#undef KS
#undef EX
#undef PKW
#undef PAF
#undef VFR
#undef VRD
#undef KRD
#undef GAPA
#undef BIAS
#undef GAPB
#undef STEP
}
#undef SBAR
#undef PIN
#undef MFMA
#undef WAIT_BAR
}

constexpr int NWAVES = 8;
constexpr int LDS_BYTES = 147456;
static_assert(pg8::STAGE_BYTES <= 131072 && att::LDS_BYTES <= 131072 && mla::LDS_BYTES <= 131072, "LDS map");


#define XB_TMO      128
#define XB_XCNT(j)  (256  + 64 * (j))
#define XB_XSUB(j)  (1280 + 64 * (j))
#define XB_XGEN(j)  (2304 + 64 * (j))
#define XB_TOP      3328
#define XB_TOPGEN   3392
#define XCD_BAR_WORDS 3456
#define XB_SPIN_CAP (1u << 18)
__device__ __forceinline__ unsigned xb_ld(unsigned* p)              { return __hip_atomic_load(p, __ATOMIC_RELAXED, __HIP_MEMORY_SCOPE_AGENT); }
__device__ __forceinline__ unsigned xb_add(unsigned* p, unsigned v) { return __hip_atomic_fetch_add(p, v, __ATOMIC_RELAXED, __HIP_MEMORY_SCOPE_AGENT); }
__device__ __forceinline__ unsigned xb_xcc_id() { return (unsigned)__builtin_amdgcn_s_getreg((3 << 11) | 20) & 0xFu; }
#define XB_SPIN(cond, bar) do { unsigned _sp = 0; while (cond) { __builtin_amdgcn_s_sleep(1); \
    if ((++_sp & 255u) == 0u) { if (xb_ld(&(bar)[XB_TMO])) break; if (_sp > XB_SPIN_CAP) { atomicAdd(&(bar)[XB_TMO], 1u); break; } } } } while (0)
struct XcdBarrier { unsigned* bar; unsigned x; volatile LAS unsigned* st; };
__device__ __forceinline__ XcdBarrier xcd_barrier_post(unsigned* bar, volatile LAS unsigned* st) {
    XcdBarrier b; b.bar = bar; b.x = xb_xcc_id(); b.st = st;
    if (threadIdx.x == 0) (void)xb_add(&bar[XB_XCNT(b.x)], 1u);
    return b;
}
__device__ __forceinline__ void xcd_barrier_complete(unsigned* bar, unsigned x, unsigned& nloc, unsigned& nx) {
    const unsigned G = gridDim.x * gridDim.y * gridDim.z;
    unsigned sum, cnt, mine, sp = 0u;
    for (;;) {
        sum = 0u; cnt = 0u; mine = 0u;
#pragma unroll
        for (unsigned j = 0; j < 16; ++j) { const unsigned c = xb_ld(&bar[XB_XCNT(j)]); sum += c; cnt += (c > 0u) ? 1u : 0u; mine = (j == x) ? c : mine; }
        if (sum == G) break;
        __builtin_amdgcn_s_sleep(1);
        if ((++sp & 255u) == 0u) { if (xb_ld(&bar[XB_TMO])) break; if (sp > XB_SPIN_CAP) { atomicAdd(&bar[XB_TMO], 1u); break; } }
    }
    nloc = mine > 0u ? mine : 1u; nx = cnt > 0u ? cnt : 1u;
}
__device__ __forceinline__ void xcd_barrier(const XcdBarrier& b) {
    asm volatile("s_waitcnt vmcnt(0)" ::: "memory");
    __syncthreads();
    if (threadIdx.x == 0) {
        unsigned* bar = b.bar;
        __builtin_amdgcn_s_waitcnt(0);
        unsigned nloc = b.st[0], nx = b.st[1];
        if (nloc == 0u) { xcd_barrier_complete(bar, b.x, nloc, nx); b.st[0] = nloc; b.st[1] = nx; }
        const unsigned old = xb_add(&bar[XB_XSUB(b.x)], 1u);
        const unsigned gen = old / nloc;
        if (old + 1u == (gen + 1u) * nloc) {
            __builtin_amdgcn_fence(__ATOMIC_RELEASE, "agent");
            asm volatile("s_waitcnt vmcnt(0)" ::: "memory");
            const unsigned og = xb_add(&bar[XB_TOP], 1u);
            const unsigned tg = og / nx;
            if (og + 1u == (tg + 1u) * nx) xb_add(&bar[XB_TOPGEN], 1u);
            else XB_SPIN(xb_ld(&bar[XB_TOPGEN]) == tg, bar);
            __builtin_amdgcn_fence(__ATOMIC_ACQUIRE, "agent");
            xb_add(&bar[XB_XGEN(b.x)], 1u);
            asm volatile("s_waitcnt vmcnt(0)" ::: "memory");
        } else {
            XB_SPIN(xb_ld(&bar[XB_XGEN(b.x)]) == gen, bar);
            __builtin_amdgcn_fence(__ATOMIC_ACQUIRE, "agent");
            asm volatile("s_waitcnt vmcnt(0)" ::: "memory");
        }
    }
    __syncthreads();
}

struct Params { const float* in[17]; float* out; unsigned char* ws; int ph_lo, ph_hi; };

__device__ const double ROPE_INV[16] = {1.0, 0.5623413251903491, 0.31622776601683794, 0.1778279410038923, 0.1, 0.05623413251903491, 0.03162277660168379, 0.01778279410038923,
                                        0.01, 0.005623413251903491, 0.0031622776601683794, 0.0017782794100389228, 0.001, 0.0005623413251903491, 0.00031622776601683794, 0.00017782794100389227};

__device__ __forceinline__ unsigned f2bf(float f) { unsigned u = __builtin_bit_cast(unsigned, f); return (u + 0x7fffu + ((u >> 16) & 1u)) >> 16; }
__device__ __forceinline__ unsigned pk2(float lo, float hi) { return f2bf(lo) | (f2bf(hi) << 16); }

__device__ __forceinline__ int wsrc_col(int kind, int n, float& cs) {
    cs = 1.f;
    if (kind == 0) {
        if (n < 1280) { if (n < 512) cs = QA_SCALE; return n; }
        if (n < 1792) return n - 1280 + 1952;
        if (n < 2432) return n - 1792 + 1280;
        if (n < 2464) { const int j = n - 2432; return 1920 + (j >> 1) + 16 * (j & 1); }
        if (n < 2560) return -1;
        return n - 2560 + 2464;
    } else if (kind == 1) {
        cs = QB_SCALE; const int h = n / 96, d = n % 96;
        if (d < 64) return h * 96 + d;
        const int j = d - 64; return h * 96 + 64 + (j >> 1) + 16 * (j & 1);
    } else if (kind == 2) {
        if (n < 512) return (n >> 6) * 128 + (n & 63);
        const int q = n - 512; return (q >> 6) * 128 + 64 + (q & 63);
    }
    return n;
}
__device__ __forceinline__ void transpose_item(const float* W, int K, int Nsrc, int Ndst, int kind, const float* kgain, bf16_t* WT, LAS float* scr, int item, int lane) {
    const int nblk = Ndst / 32, kb = item / nblk, nb = item % nblk, k0 = 64 * kb, n0 = 32 * nb;
    float cs; const int src = wsrc_col(kind, n0 + (lane & 31), cs);
#pragma unroll 8
    for (int i = 0; i < 32; ++i) { const int kk = 2 * i + (lane >> 5); float v = 0.f;
        if (src >= 0) { v = W[(size_t)(k0 + kk) * Nsrc + src] * cs; if (kgain) v *= kgain[k0 + kk]; }
        scr[kk * 33 + (lane & 31)] = v; }
    asm volatile("s_waitcnt lgkmcnt(0)" ::: "memory");
    const int c = lane & 7;
#pragma unroll
    for (int j = 0; j < 4; ++j) { const int n = (lane >> 3) + 8 * j; const LAS float* s = scr + (8 * c) * 33 + n;
        u32x4 o; o.x = pk2(s[0 * 33], s[1 * 33]); o.y = pk2(s[2 * 33], s[3 * 33]); o.z = pk2(s[4 * 33], s[5 * 33]); o.w = pk2(s[6 * 33], s[7 * 33]);
        *(u32x4*)(WT + (size_t)(n0 + n) * K + k0 + 8 * c) = o; }
    asm volatile("s_waitcnt lgkmcnt(0)" ::: "memory");
}

__global__ void __launch_bounds__(NWAVES * 64, 2) mk_fwd(Params p) {
    extern __shared__ __attribute__((aligned(16))) unsigned char lds[];
    cg::grid_group grid = cg::this_grid();
    volatile LAS unsigned* bst = (volatile LAS unsigned*)((LAS unsigned char*)lds + LDS_BYTES - 64);
    if (threadIdx.x < 16) bst[threadIdx.x] = 0u;
    __syncthreads();
    const XcdBarrier xbar = xcd_barrier_post((unsigned*)(p.ws + WS_BAR), bst);
    const int G = gridDim.x, bx = blockIdx.x;
    const int vcu = (G % 8 == 0) ? (bx % 8) * (G / 8) + bx / 8 : bx;
    const int NGW = G * NWAVES;
    typedef const __attribute__((address_space(4))) Params* KP;
    const KP PP = (KP)__builtin_amdgcn_kernarg_segment_ptr();
#define PHASE_PTRS() KP q_ = PP; asm volatile("" : "+s"(q_)); unsigned char* ws = q_->ws; (void)ws; \
    const float *x_p = q_->in[0], *x_s = q_->in[1], *c_p = q_->in[2], *c_s = q_->in[3], *w_ada = q_->in[4], *b_ada = q_->in[5], *g_norm = q_->in[6], *w_in = q_->in[7], *g_q = q_->in[8], *w_uq = q_->in[9], \
                *g_kv = q_->in[10], *w_ukv = q_->in[11], *sink = q_->in[12], *w_oa = q_->in[13], *w_ob = q_->in[14], *w_out = q_->in[15], *g_final = q_->in[16]; float* outp = q_->out; \
    (void)x_p; (void)x_s; (void)c_p; (void)c_s; (void)w_ada; (void)b_ada; (void)g_norm; (void)w_in; (void)g_q; (void)w_uq; (void)g_kv; (void)w_ukv; (void)sink; (void)w_oa; (void)w_ob; (void)w_out; (void)g_final; (void)outp; \
    int tid = threadIdx.x; asm volatile("" : "+v"(tid)); const int lane = tid & 63, wave = __builtin_amdgcn_readfirstlane(tid >> 6), gw = vcu * NWAVES + wave; (void)lane; (void)wave; (void)gw; \
    float* mod = (float*)(ws + WS_MOD); f32x2* rope = (f32x2*)(ws + WS_ROPE); (void)mod; (void)rope; \
    bf16_t *Win_t = (bf16_t*)(ws + WS_WIN), *Wuq_t = (bf16_t*)(ws + WS_WUQ), *Wukv_t = (bf16_t*)(ws + WS_WUKV), *Woa_t = (bf16_t*)(ws + WS_WOA), *Wob_t = (bf16_t*)(ws + WS_WOB), *Wout_t = (bf16_t*)(ws + WS_WOUT); \
    (void)Win_t; (void)Wuq_t; (void)Wukv_t; (void)Woa_t; (void)Wob_t; (void)Wout_t; \
    float *SSQ = (float*)(ws + WS_SSQ), *SSKV = (float*)(ws + WS_SSKV); unsigned *KMX = (unsigned*)(ws + WS_KMX), *KMR = (unsigned*)(ws + WS_KMR), *KMA = (unsigned*)(ws + WS_KMA); (void)SSQ; (void)SSKV; (void)KMX; (void)KMR; (void)KMA; \
    bf16_t *HB = (bf16_t*)(ws + WS_QB), *YA = (bf16_t*)(ws + WS_YA), *YB = (bf16_t*)(ws + WS_PA); (void)HB; (void)YA; (void)YB; \
    bf16_t *PA = (bf16_t*)(ws + WS_PA), *QB = (bf16_t*)(ws + WS_QB); (void)PA; (void)QB; \
    bf16_t *PZ = (bf16_t*)(ws + WS_PZ), *TM = (bf16_t*)(ws + WS_PZ); (void)PZ; (void)TM; \
    bf16_t *PC = (bf16_t*)(ws + WS_PC), *KN = (bf16_t*)(ws + WS_KN), *VB = (bf16_t*)(ws + WS_VB), *KR = (bf16_t*)(ws + WS_KR); (void)PC; (void)KN; (void)VB; (void)KR; \
    bf16_t* PG = (bf16_t*)outp; (void)PG;
    const int lo = p.ph_lo, hi = p.ph_hi;
    if (hi < lo) grid.sync();
#ifndef PH_MASK
#define PH_MASK 0x3ff
#endif
#define IN(k) (((PH_MASK >> (k)) & 1) && lo <= (k) && (k) < hi)
#define GBAR() xcd_barrier(xbar)
#define SEAM(k) do { if (IN(k) && IN((k) + 1)) GBAR(); } while (0)
#ifndef REP_MASK
#define REP_MASK 0
#endif
#define REPS(k) (1 + ((REP_MASK >> (k)) & 1))
#define REPSYNC() do { if (rep_) GBAR(); } while (0)

    if (IN(0)) { PHASE_PTRS();
        LAS float* scr = (LAS float*)((LAS unsigned char*)lds + wave * 16384);
        constexpr int I_IN = (DM / 64) * (N_IN / 32), I_UQ = (384 / 64) * (768 / 32), I_UKV = (256 / 64) * (1024 / 32), I_OA = (512 / 64) * (1024 / 32), I_OUT = (1024 / 64) * (1024 / 32);
        constexpr int NITEMS = I_IN + I_UQ + I_UKV + 2 * I_OA + I_OUT;
        for (int it = gw; it < NITEMS; it += NGW) {
            int r = it;
            if (r < I_IN) { transpose_item(w_in, DM, D_IN, N_IN, 0, nullptr, Win_t, scr, r, lane); continue; } r -= I_IN;
            if (r < I_UQ) { transpose_item(w_uq, 384, 768, 768, 1, g_q, Wuq_t, scr, r, lane); continue; } r -= I_UQ;
            if (r < I_UKV) { transpose_item(w_ukv, 256, 1024, 1024, 2, g_kv, Wukv_t, scr, r, lane); continue; } r -= I_UKV;
            if (r < I_OA) { transpose_item(w_oa, 512, 1024, 1024, 3, nullptr, Woa_t, scr, r, lane); continue; } r -= I_OA;
            if (r < I_OA) { transpose_item(w_ob, 512, 1024, 1024, 3, nullptr, Wob_t, scr, r, lane); continue; } r -= I_OA;
            transpose_item(w_out, 1024, 1024, 1024, 3, nullptr, Wout_t, scr, r, lane);
        }
        for (int it = gw; it < 16 * 48; it += NGW) { const int ks = it / 48, cgp = it % 48, col = cgp * 64 + lane; float a[NBATCH];
#pragma unroll
            for (int b = 0; b < NBATCH; ++b) a[b] = 0.f;
            for (int k = ks * 64; k < ks * 64 + 64; ++k) { const float w = w_ada[(size_t)k * 3 * DM + col];
#pragma unroll
                for (int b = 0; b < NBATCH; ++b) { const float c = (b < NB_P) ? c_p[b * DM + k] : c_s[(b - NB_P) * DM + k]; a[b] += c * sigmoidf_fast(c) * w; } }
#pragma unroll
            for (int b = 0; b < NBATCH; ++b) atomicAdd(mod + b * 3 * DM + col, a[b]);
        }
        for (int e = gw * 64 + lane; e < S_S * 16; e += NGW * 64) { const int pos = e >> 4, i = e & 15;
            const double ang = (double)pos * ROPE_INV[i]; const double n = rint(ang * 0.6366197723675814);
            const double r = (ang - n * 1.5707963267948966) - n * 6.123233995736766e-17; const double r2 = r * r;
            const double sn = r * (1.0 + r2 * (-1.0 / 6 + r2 * (1.0 / 120 + r2 * (-1.0 / 5040 + r2 * (1.0 / 362880 + r2 * (-1.0 / 39916800 + r2 * (1.0 / 6227020800.0)))))));
            const double cn = 1.0 + r2 * (-0.5 + r2 * (1.0 / 24 + r2 * (-1.0 / 720 + r2 * (1.0 / 40320 + r2 * (-1.0 / 3628800 + r2 * (1.0 / 479001600.0))))));
            const int q = (int)((long long)n & 3); double cs_, sn_;
            if (q == 0) { cs_ = cn; sn_ = sn; } else if (q == 1) { cs_ = -sn; sn_ = cn; } else if (q == 2) { cs_ = -cn; sn_ = -sn; } else { cs_ = sn; sn_ = -cn; }
            rope[e] = (f32x2){(float)cs_, (float)sn_}; }
    }
    SEAM(0);
    for (int rep_ = 0; rep_ < REPS(1); ++rep_) { REPSYNC();
    if (IN(1)) { PHASE_PTRS();
        constexpr int RPW = 24;
        for (int base = gw * RPW; base < M; base += NGW * RPW) {
            int cb = -1; f32x4 ga[4], sh[4];
            for (int row = base; row < base + RPW && row < M; row += 2) {
                const int b = batch_of_row(row);
                if (b != cb) { cb = b;
#pragma unroll
                    for (int j = 0; j < 4; ++j) { const int c = 4 * lane + 256 * j;
                        const f32x4 sc = *(const f32x4*)(mod + b * 3 * DM + DM + c) + *(const f32x4*)(b_ada + DM + c);
                        sh[j] = *(const f32x4*)(mod + b * 3 * DM + c) + *(const f32x4*)(b_ada + c);
                        ga[j] = *(const f32x4*)(g_norm + c) * (sc + 1.0f); } }
                const float* xr = row < M_P ? x_p + (size_t)row * DM : x_s + (size_t)(row - M_P) * DM;
                f32x4 v[2][4]; float s0 = 0.f, s1 = 0.f;
#pragma unroll
                for (int j = 0; j < 4; ++j) { v[0][j] = *(const f32x4*)(xr + 4 * lane + 256 * j); v[1][j] = *(const f32x4*)(xr + DM + 4 * lane + 256 * j); }
#pragma unroll
                for (int j = 0; j < 4; ++j) { s0 += (v[0][j].x * v[0][j].x + v[0][j].y * v[0][j].y) + (v[0][j].z * v[0][j].z + v[0][j].w * v[0][j].w);
                                              s1 += (v[1][j].x * v[1][j].x + v[1][j].y * v[1][j].y) + (v[1][j].z * v[1][j].z + v[1][j].w * v[1][j].w); }
                const float r0 = 1.0f / sqrtf(wave_sum(s0) * (1.f / DM) + EPS), r1 = 1.0f / sqrtf(wave_sum(s1) * (1.f / DM) + EPS);
#pragma unroll
                for (int j = 0; j < 4; ++j) { const f32x4 h0 = v[0][j] * r0 * ga[j] + sh[j], h1 = v[1][j] * r1 * ga[j] + sh[j]; u32x2 w0, w1;
                    w0.x = cvt_pk_bf16(h0.x, h0.y); w0.y = cvt_pk_bf16(h0.z, h0.w); w1.x = cvt_pk_bf16(h1.x, h1.y); w1.y = cvt_pk_bf16(h1.z, h1.w);
                    *(u32x2*)(HB + (size_t)row * DM + 4 * lane + 256 * j) = w0; *(u32x2*)(HB + (size_t)(row + 1) * DM + 4 * lane + 256 * j) = w1; }
            }
        }
    }
    }
    SEAM(1);
    for (int rep_ = 0; rep_ < REPS(2); ++rep_) { REPSYNC();
    if (IN(2)) { PHASE_PTRS();
        pg8::Gemm g{HB, Win_t, M, N_IN, DM, DM}; pg8::StaticOrder S; S.init(M, N_IN, G, bx);
        pg8::EpiProj E{PA, PZ, PC, PG, KR, SSQ, SSKV, KMR, KMA, rope};
        pg8::gemm_phase<pg8::EpiProj, 1024, 1024>((LAS unsigned char*)lds, g, S, E);
    }
    }
    SEAM(2);
    for (int rep_ = 0; rep_ < REPS(3); ++rep_) { REPSYNC();
    if (IN(3)) { PHASE_PTRS();
        for (int U = vcu; U < (M / 256) * 8; U += G) { const int rb = U >> 3, h = U & 7, kvh = h >> 2; const int row0 = rb * 256;
            const int S = row0 < M_P ? S_P : S_S; const int qpos0 = pos_of_row(row0); const int seq0 = row0 - qpos0;
            const int ks = qpos0 - 128 < 0 ? 0 : qpos0 - 128, ke = qpos0 + 384 > S ? S : qpos0 + 384;
            const float slope2 = exp2f(-(float)(h + 1)) * LOG2E, sink2 = sink[h] * LOG2E;
            const int bb = batch_of_row(row0);
            const float kmaxa = sqrtf(1.02f * (__uint_as_float(__hip_atomic_load(KMA + bb * 4 + 2 * kvh, __ATOMIC_RELAXED, __HIP_MEMORY_SCOPE_AGENT)) + __uint_as_float(__hip_atomic_load(KMA + bb * 4 + 2 * kvh + 1, __ATOMIC_RELAXED, __HIP_MEMORY_SCOPE_AGENT))));
            mla::win_unit(PA + (size_t)row0 * 768 + h * 64, PA + (size_t)seq0 * 768 + 512 + kvh * 64, PA + (size_t)seq0 * 768 + 640 + kvh * 64,
                          PZ + (size_t)row0 * 1024 + h * 64, YA + (size_t)row0 * 512 + h * 64, ks / 64, (ke - ks) / 64, qpos0, slope2, sink2, kmaxa, (char*)lds);
        }
#ifndef NO_Q
        { pg8::Gemm g{PC, Wuq_t, M, 768, 384, 768}; pg8::StaticOrder S; S.init(M, 768, G, bx); pg8::EpiQ E{QB, SSQ, rope};
          pg8::gemm_phase<pg8::EpiQ, 384, 768>((LAS unsigned char*)lds, g, S, E); }
#endif
#ifndef NO_KV
        { pg8::Gemm g{PC + 384, Wukv_t, M, 1024, 256, 768}; pg8::StaticOrder S; S.init(M, 1024, G, bx); pg8::EpiKV E{KN, VB, SSKV, KMX};
          pg8::gemm_phase<pg8::EpiKV, 256, 768>((LAS unsigned char*)lds, g, S, E); }
#endif
    }
    }
    SEAM(3);
    for (int rep_ = 0; rep_ < REPS(5); ++rep_) { REPSYNC();
    if (IN(5)) { PHASE_PTRS();
        for (int U = vcu; U < 1536; U += G) {
            int row0, seq0, S, h, b;
            if (U < 1024) { const int i = U >> 8, v = U & 255, xcd = v >> 5, c = v & 31; const int bh = 2 * xcd + (i >> 1), qb = (i & 1) * 32 + c; b = bh >> 3; h = bh & 7;
                S = S_S; seq0 = M_P + b * S_S; row0 = seq0 + qb * 256; b += NB_P; }
            else { const int U2 = U - 1024; const int j = U2 >> 8, v = U2 & 255, xcd = v >> 5, c = v & 31; const int bh = 4 * xcd + 2 * j + (c >> 4), qb = c & 15; b = bh >> 3; h = bh & 7;
                S = S_P; seq0 = b * S_P; row0 = seq0 + qb * 256; }
            const float kmax = sqrtf(1.02f * (__uint_as_float(__hip_atomic_load(KMX + b * 16 + 2 * h, __ATOMIC_RELAXED, __HIP_MEMORY_SCOPE_AGENT)) + __uint_as_float(__hip_atomic_load(KMX + b * 16 + 2 * h + 1, __ATOMIC_RELAXED, __HIP_MEMORY_SCOPE_AGENT))
                                             + __uint_as_float(__hip_atomic_load(KMR + b, __ATOMIC_RELAXED, __HIP_MEMORY_SCOPE_AGENT))));
            mla::mla_unit(QB + (size_t)row0 * 768 + h * 96, KN + (size_t)seq0 * 512 + h * 64, KR + (size_t)seq0 * 32, VB + (size_t)seq0 * 512 + h * 64,
                          PZ + (size_t)row0 * 1024 + 512 + h * 64, YB + (size_t)row0 * 512 + h * 64, S / 64, kmax, (char*)lds);
        }
    }
    }
    SEAM(5);
    for (int rep_ = 0; rep_ < REPS(6); ++rep_) { REPSYNC();
    if (IN(6)) { PHASE_PTRS(); pg8::Gemm g{YA, Woa_t, M, 1024, 512, 512}; pg8::StaticOrder S; S.init(M, 1024, G, bx); pg8::EpiGate<true> E{TM, PG, 0};
        pg8::gemm_phase<pg8::EpiGate<true>, 512, 512>((LAS unsigned char*)lds, g, S, E); }
    SEAM(6);
    if (IN(7)) { PHASE_PTRS(); pg8::Gemm g{YB, Wob_t, M, 1024, 512, 512}; pg8::StaticOrder S; S.init(M, 1024, G, bx); pg8::EpiGate<false> E{TM, PG, 1024};
        pg8::gemm_phase<pg8::EpiGate<false>, 512, 512>((LAS unsigned char*)lds, g, S, E); }
    SEAM(7);
    }
    for (int rep_ = 0; rep_ < REPS(8); ++rep_) { REPSYNC();
    if (IN(8)) { PHASE_PTRS(); pg8::Gemm g{TM, Wout_t, M, 1024, 1024, 1024}; pg8::StaticOrder S; S.init(M, 1024, G, bx); pg8::EpiOut E{x_p, x_s, outp, mod, b_ada};
        pg8::gemm_phase<pg8::EpiOut, 1024, 1024>((LAS unsigned char*)lds, g, S, E); }
    SEAM(8);
    if (IN(9)) { PHASE_PTRS();
        f32x4 gf[4];
#pragma unroll
        for (int j = 0; j < 4; ++j) gf[j] = *(const f32x4*)(g_final + 4 * lane + 256 * j);
        for (int row = 2 * gw; row < M; row += 2 * NGW) { float* orow = outp + (size_t)row * DM; f32x4 v[2][4]; float s0 = 0.f, s1 = 0.f;
#pragma unroll
            for (int j = 0; j < 4; ++j) { v[0][j] = *(const f32x4*)(orow + 4 * lane + 256 * j); v[1][j] = *(const f32x4*)(orow + DM + 4 * lane + 256 * j); }
#pragma unroll
            for (int j = 0; j < 4; ++j) { s0 += (v[0][j].x * v[0][j].x + v[0][j].y * v[0][j].y) + (v[0][j].z * v[0][j].z + v[0][j].w * v[0][j].w);
                                          s1 += (v[1][j].x * v[1][j].x + v[1][j].y * v[1][j].y) + (v[1][j].z * v[1][j].z + v[1][j].w * v[1][j].w); }
            const float r0 = 1.0f / sqrtf(wave_sum(s0) * (1.f / DM) + EPS), r1 = 1.0f / sqrtf(wave_sum(s1) * (1.f / DM) + EPS);
#pragma unroll
            for (int j = 0; j < 4; ++j) { *(f32x4*)(orow + 4 * lane + 256 * j) = v[0][j] * r0 * gf[j]; *(f32x4*)(orow + DM + 4 * lane + 256 * j) = v[1][j] * r1 * gf[j]; }
        }
    }
    }
#undef IN
#undef SEAM
#undef PHASE_PTRS
}

extern "C" void kernel_launch(void* const* d_in, const int* in_sizes, int n_in, void* d_out, int out_size, void* d_ws, size_t ws_size, hipStream_t stream) {
    static int grid = 0;
    if (grid == 0) {
        if (n_in != 17 || out_size != M * DM || ws_size < WS_END) { fprintf(stderr, "kernel_launch: unexpected shapes: n_in %d out %d ws %zu (need %zu)\n", n_in, out_size, ws_size, (size_t)WS_END); grid = -1; return; }
        int dev = 0, cus = 0, per_cu = 0;
        hipGetDevice(&dev); hipDeviceGetAttribute(&cus, hipDeviceAttributeMultiprocessorCount, dev);
        if (hipFuncSetAttribute((const void*)mk_fwd, hipFuncAttributeMaxDynamicSharedMemorySize, LDS_BYTES) != hipSuccess) { fprintf(stderr, "kernel_launch: hipFuncSetAttribute failed\n"); grid = -1; return; }
        if (hipOccupancyMaxActiveBlocksPerMultiprocessor(&per_cu, (const void*)mk_fwd, NWAVES * 64, LDS_BYTES) != hipSuccess || per_cu < 1) { fprintf(stderr, "kernel_launch: occupancy query says %d\n", per_cu); per_cu = 1; }
        (void)hipGetLastError();
        grid = cus;
    }
    if (grid < 0) return;
    hipMemsetAsync((char*)d_ws + WS_MOD, 0, ZERO_BYTES, stream);
    Params p{};
    for (int i = 0; i < 17; ++i) p.in[i] = (const float*)d_in[i];
    p.out = (float*)d_out; p.ws = (unsigned char*)d_ws;
#if MK_N_LAUNCHES == 1
    p.ph_lo = 0; p.ph_hi = 10;
    void* args[] = {&p};
    hipError_t e = hipLaunchCooperativeKernel((const void*)mk_fwd, dim3(grid), dim3(NWAVES * 64), args, LDS_BYTES, stream);
    if (e != hipSuccess) fprintf(stderr, "cooperative launch failed: %s (grid %d)\n", hipGetErrorString(e), grid);
#else
    for (int ph = 0; ph < 10; ++ph) { p.ph_lo = ph; p.ph_hi = ph + 1; hipLaunchKernelGGL(mk_fwd, dim3(grid), dim3(NWAVES * 64), LDS_BYTES, stream, p); }
#endif
}
```
